# Optimizing an MI355X kernel written in HIP

```python
import math
import jax
import jax.numpy as jnp
from jax import lax
import numpy as np

D_MODEL = 2048
BATCH = 16
SEQ = 2048
DEPTH = 1

BLK = 128
NEG_INF = -1e30
RMS_EPS = 1e-6
SUBLN_EPS = 1e-5
N_BUCKETS = 32
MAX_DISTANCE = 2048
A_HEADS = 8
A_HEAD_DIM = 128
DILATED_GROUPS = ((128, 1), (512, 4), (2048, 16))
N_DGROUPS = 3
B_HEADS_PER_GROUP = 8
B_HEAD_DIM = 64
N_BIAS_HEADS = A_HEADS + N_DGROUPS * B_HEADS_PER_GROUP
A_QK_WIDTH = A_HEADS * 2 * A_HEAD_DIM
A_V_WIDTH = A_HEADS * 2 * A_HEAD_DIM
B_WIDTH = N_DGROUPS * B_HEADS_PER_GROUP * B_HEAD_DIM
IN_WIDTH = 2 * A_QK_WIDTH + A_V_WIDTH + 3 * B_WIDTH
A_OUT_WIDTH = A_V_WIDTH
B_OUT_WIDTH = B_HEADS_PER_GROUP * B_HEAD_DIM
N_EXPERT_GROUPS = 4
EXPERTS_PER_GROUP = 8
N_EXPERTS = N_EXPERT_GROUPS * EXPERTS_PER_GROUP
TOP_K_FINE = 2
D_EXPERT = D_MODEL // 2
PLE_DIM = 256

kernel_name = 'hybrid_diffattn_dilated_hmoe_block'


def rmsnorm(x, g, eps=RMS_EPS):
    xf = x.astype(jnp.float32)
    y = xf * lax.rsqrt(jnp.mean(xf * xf, axis=-1, keepdims=True) + eps)
    return (y * g.astype(jnp.float32)).astype(x.dtype)


def t5_bucket(dist):
    dist = jnp.maximum(dist, 0)
    max_exact = N_BUCKETS // 2
    d_f = jnp.maximum(dist, 1).astype(jnp.float32)
    large = max_exact + (jnp.log(d_f / max_exact) / math.log(MAX_DISTANCE / max_exact)
                         * (N_BUCKETS - max_exact)).astype(jnp.int32)
    large = jnp.minimum(large, N_BUCKETS - 1)
    return jnp.where(dist < max_exact, dist, large)


def diff_attention(q, k, v, lam, bias_tab):
    S_ = q.shape[1]
    scale = A_HEAD_DIM ** -0.5
    outs = []
    for blk in range(S_ // BLK):
        s0 = blk * BLK
        kv_len = s0 + BLK
        qb = q[:, s0:s0 + BLK]
        kb = k[:, :kv_len]
        vb = v[:, :kv_len]
        s = jnp.einsum('bqhmd,bkhmd->bhmqk', qb, kb).astype(jnp.float32) * scale
        dist = (s0 + jnp.arange(BLK))[:, None] - jnp.arange(kv_len)[None, :]
        bias = bias_tab[t5_bucket(dist)].astype(jnp.float32).transpose(2, 0, 1)
        s = jnp.where((dist >= 0)[None, None, None], s + bias[None, :, None], NEG_INF)
        a = jax.nn.softmax(s, axis=-1)
        w = a[:, :, 0] - lam * a[:, :, 1]
        outs.append(jnp.einsum('bhqk,bkhe->bqhe', w.astype(v.dtype), vb))
    return jnp.concatenate(outs, axis=1)


def dilated_group(q, k, v, window, dilation, bias_tab):
    Bsz, S_, H, E = q.shape
    band = window // dilation
    L = S_ // dilation
    nq = -(-L // BLK)
    Lq = nq * BLK

    def streams(a):
        return a.reshape(Bsz, L, dilation, H, E).transpose(0, 2, 1, 3, 4)

    qs = jnp.pad(streams(q), ((0, 0), (0, 0), (0, Lq - L), (0, 0), (0, 0)))
    qs = qs.reshape(Bsz, dilation, nq, BLK, H, E)

    def windows(a):
        ap = jnp.pad(streams(a), ((0, 0), (0, 0), (BLK, Lq - L), (0, 0), (0, 0)))
        ap = ap.reshape(Bsz, dilation, nq + 1, BLK, H, E)
        return jnp.concatenate([ap[:, :, :-1], ap[:, :, 1:]], axis=3)

    kw = windows(k)
    vw = windows(v)
    s = jnp.einsum('bcnihe,bcnjhe->bcnhij', qs, kw).astype(jnp.float32) * (E ** -0.5)
    i = jnp.arange(BLK)[:, None]
    j = jnp.arange(2 * BLK)[None, :]
    rel = i - j + BLK
    kj = jnp.arange(nq)[:, None, None] * BLK + j[None] - BLK
    valid = (rel >= 0)[None] & (rel <= band)[None] & (kj >= 0) & (kj < L)
    bias = bias_tab[t5_bucket(rel * dilation)].astype(jnp.float32).transpose(2, 0, 1)
    s = jnp.where(valid[None, None, :, None], s + bias[None, None, None], NEG_INF)
    m = jnp.max(s, axis=-1, keepdims=True)
    e = jnp.exp(s - m)
    den = jnp.sum(e, axis=-1, keepdims=True)
    pr = e / den
    lse = (m + jnp.log(den))[..., 0]
    o = jnp.einsum('bcnhij,bcnjhe->bcnihe', pr.astype(v.dtype), vw)
    o = o.reshape(Bsz, dilation, Lq, H, E)[:, :, :L]
    o = o.transpose(0, 2, 1, 3, 4).reshape(Bsz, S_, H, E)
    lse = lse.transpose(0, 1, 2, 4, 3).reshape(Bsz, dilation, Lq, H)[:, :, :L]
    lse = lse.transpose(0, 2, 1, 3).reshape(Bsz, S_, H)
    return o, lse


def hier_moe(t, w_coarse, w_fine, w1, w3, w2):
    T, D = t.shape
    coarse = (t @ w_coarse).astype(jnp.float32)
    p_group = jax.nn.softmax(coarse, axis=-1)
    g_sel = jnp.argmax(coarse, axis=-1)
    pg_sel = jnp.take_along_axis(p_group, g_sel[:, None], axis=1)[:, 0]
    fine = jnp.einsum('td,gde->tge', t, w_fine).astype(jnp.float32)
    fine = jnp.take_along_axis(fine, g_sel[:, None, None], axis=1)[:, 0]
    top_v, top_i = lax.top_k(fine, TOP_K_FINE)
    gate = pg_sel[:, None] * jax.nn.softmax(top_v, axis=-1)
    expert_id = (g_sel[:, None] * EXPERTS_PER_GROUP + top_i).astype(jnp.int32)

    TK = T * TOP_K_FINE
    flat_e = expert_id.reshape(TK)
    flat_tok = jnp.repeat(jnp.arange(T, dtype=jnp.int32), TOP_K_FINE)
    flat_w = gate.reshape(TK).astype(t.dtype)
    order = jnp.argsort(flat_e)
    se = flat_e[order]
    counts = jnp.bincount(flat_e, length=N_EXPERTS)
    starts = jnp.cumsum(counts) - counts
    pcounts = ((counts + BLK - 1) // BLK) * BLK
    pends = jnp.cumsum(pcounts)
    pstarts = pends - pcounts
    dest = pstarts[se] + (jnp.arange(TK) - starts[se])
    n_blocks = TK // BLK + N_EXPERTS
    n_rows = n_blocks * BLK
    row_tok = jnp.full((n_rows,), T, jnp.int32).at[dest].set(flat_tok[order])
    row_w = jnp.zeros((n_rows,), t.dtype).at[dest].set(flat_w[order])
    blk_e = jnp.searchsorted(pends, jnp.arange(n_blocks) * BLK, side='right')
    blk_e = jnp.minimum(blk_e, N_EXPERTS - 1).astype(jnp.int32)
    t_pad = jnp.concatenate([t, jnp.zeros((1, D), t.dtype)], axis=0)
    xin = t_pad[row_tok].reshape(n_blocks, BLK, D)

    def expert_block(args):
        xb, e = args
        hdn = jax.nn.silu(xb @ w1[e]) * (xb @ w3[e])
        return hdn @ w2[e]

    yb = lax.map(expert_block, (xin, blk_e)).reshape(n_rows, D)
    y = jax.ops.segment_sum(yb * row_w[:, None], row_tok, num_segments=T + 1)[:T]
    return y


def setup_inputs(seed: int = 0) -> dict:
    key = jax.random.key(seed)
    ks = jax.random.split(key, 24)
    f32 = jnp.float32

    def nrm(k, shape, scale):
        return jax.random.normal(k, shape, f32) * scale

    def gain(k, shape):
        return 1.0 + 0.01 * jax.random.normal(k, shape, f32)

    return {
        'x': nrm(ks[0], (BATCH, SEQ, D_MODEL), 1.0),
        'p': nrm(ks[1], (DEPTH, BATCH, SEQ, PLE_DIM), 1.0),
        'rel_bias': nrm(ks[2], (N_BUCKETS, N_BIAS_HEADS), 0.2),
        'norm_mix_g': gain(ks[3], (DEPTH, D_MODEL)),
        'w_in': nrm(ks[4], (DEPTH, D_MODEL, IN_WIDTH), D_MODEL ** -0.5),
        'w_gate': nrm(ks[5], (DEPTH, D_MODEL, 2 * D_MODEL), D_MODEL ** -0.5),
        'lambda_q1': nrm(ks[6], (DEPTH, A_HEAD_DIM), 0.1),
        'lambda_k1': nrm(ks[7], (DEPTH, A_HEAD_DIM), 0.1),
        'lambda_q2': nrm(ks[8], (DEPTH, A_HEAD_DIM), 0.1),
        'lambda_k2': nrm(ks[9], (DEPTH, A_HEAD_DIM), 0.1),
        'subln_g': gain(ks[10], (DEPTH, 2 * A_HEAD_DIM)),
        'w_proj_a': nrm(ks[11], (DEPTH, A_OUT_WIDTH, D_MODEL), A_OUT_WIDTH ** -0.5),
        'w_proj_b': nrm(ks[12], (DEPTH, B_OUT_WIDTH, D_MODEL), B_OUT_WIDTH ** -0.5),
        'w_out': nrm(ks[13], (DEPTH, D_MODEL, D_MODEL), D_MODEL ** -0.5),
        'norm_ffn_g': gain(ks[14], (DEPTH, D_MODEL)),
        'w_coarse': nrm(ks[15], (DEPTH, D_MODEL, N_EXPERT_GROUPS), D_MODEL ** -0.5),
        'w_fine': nrm(ks[16], (DEPTH, N_EXPERT_GROUPS, D_MODEL, EXPERTS_PER_GROUP), D_MODEL ** -0.5),
        'w1': nrm(ks[17], (DEPTH, N_EXPERTS, D_MODEL, D_EXPERT), D_MODEL ** -0.5),
        'w3': nrm(ks[18], (DEPTH, N_EXPERTS, D_MODEL, D_EXPERT), D_MODEL ** -0.5),
        'w2': nrm(ks[19], (DEPTH, N_EXPERTS, D_EXPERT, D_MODEL), D_EXPERT ** -0.5),
        'norm_ple_g': gain(ks[20], (DEPTH, D_MODEL)),
        'w_ple_gate': nrm(ks[21], (DEPTH, D_MODEL, D_MODEL), D_MODEL ** -0.5),
        'w_ple_proj': nrm(ks[22], (DEPTH, PLE_DIM, D_MODEL), PLE_DIM ** -0.5),
        'final_norm_g': gain(ks[23], (D_MODEL,)),
    }


def reference(x, p, rel_bias, norm_mix_g, w_in, w_gate, lambda_q1, lambda_k1, lambda_q2,
              lambda_k2, subln_g, w_proj_a, w_proj_b, w_out, norm_ffn_g, w_coarse, w_fine,
              w1, w3, w2, norm_ple_g, w_ple_gate, w_ple_proj, final_norm_g):
    Bsz, S_, D = x.shape
    bias_a = rel_bias[:, :A_HEADS]
    for layer in range(DEPTH):
        h = rmsnorm(x, norm_mix_g[layer])
        z = h @ w_in[layer]
        o0 = 0
        qa = z[..., o0:o0 + A_QK_WIDTH].reshape(Bsz, S_, A_HEADS, 2, A_HEAD_DIM); o0 += A_QK_WIDTH
        ka = z[..., o0:o0 + A_QK_WIDTH].reshape(Bsz, S_, A_HEADS, 2, A_HEAD_DIM); o0 += A_QK_WIDTH
        va = z[..., o0:o0 + A_V_WIDTH].reshape(Bsz, S_, A_HEADS, 2 * A_HEAD_DIM); o0 += A_V_WIDTH
        qb = z[..., o0:o0 + B_WIDTH].reshape(Bsz, S_, N_DGROUPS, B_HEADS_PER_GROUP, B_HEAD_DIM); o0 += B_WIDTH
        kb = z[..., o0:o0 + B_WIDTH].reshape(Bsz, S_, N_DGROUPS, B_HEADS_PER_GROUP, B_HEAD_DIM); o0 += B_WIDTH
        vb = z[..., o0:o0 + B_WIDTH].reshape(Bsz, S_, N_DGROUPS, B_HEADS_PER_GROUP, B_HEAD_DIM)

        lam_init = 0.8 - 0.6 * math.exp(-0.3 * layer)
        lam = (jnp.exp(jnp.sum(lambda_q1[layer] * lambda_k1[layer]))
               - jnp.exp(jnp.sum(lambda_q2[layer] * lambda_k2[layer])) + lam_init).astype(jnp.float32)
        oa = diff_attention(qa, ka, va, lam, bias_a)
        oa = (rmsnorm(oa, subln_g[layer], SUBLN_EPS) * (1.0 - lam_init)).reshape(Bsz, S_, A_OUT_WIDTH)

        o_list = []
        lse_list = []
        for g, (window, dilation) in enumerate(DILATED_GROUPS):
            c0 = A_HEADS + g * B_HEADS_PER_GROUP
            og, lg = dilated_group(qb[:, :, g], kb[:, :, g], vb[:, :, g], window, dilation,
                                   rel_bias[:, c0:c0 + B_HEADS_PER_GROUP])
            o_list.append(og)
            lse_list.append(lg)
        alpha = jax.nn.softmax(jnp.stack(lse_list, axis=0), axis=0)
        ob = jnp.sum(alpha[..., None].astype(x.dtype) * jnp.stack(o_list, axis=0), axis=0)
        ob = ob.reshape(Bsz, S_, B_OUT_WIDTH)

        gates = jax.nn.sigmoid(h @ w_gate[layer])
        merged = gates[..., :D] * (oa @ w_proj_a[layer]) + gates[..., D:] * (ob @ w_proj_b[layer])
        x = x + merged @ w_out[layer]

        h2 = rmsnorm(x, norm_ffn_g[layer]).reshape(Bsz * S_, D)
        y = hier_moe(h2, w_coarse[layer], w_fine[layer], w1[layer], w3[layer], w2[layer])
        x = x + y.reshape(Bsz, S_, D)

        ple_gate = jax.nn.sigmoid(rmsnorm(x, norm_ple_g[layer]) @ w_ple_gate[layer])
        x = x + ple_gate * (p[layer] @ w_ple_proj[layer])
    return rmsnorm(x, final_norm_g)
```

```cpp
#include <hip/hip_runtime.h>
#include <cstdio>
#include <cstdint>
namespace pg8 {
#define PG8_LAS __attribute__((address_space(3)))
typedef unsigned short bf16_t;
typedef short bf16x8 __attribute__((ext_vector_type(8)));
typedef float f32x4 __attribute__((ext_vector_type(4)));
typedef unsigned u32x4 __attribute__((ext_vector_type(4)));
constexpr int BM = 256, BK = 64, HALF = 128, HTB = HALF * BK * 2  , STAGE_BYTES = 8 * HTB, NXCD = 8, WGM = 8;

__host__ __device__ __forceinline__ int lds_byte(int r, int c) { const int st = (r >> 4) * 2 + (c >> 5), rr = r & 15, cc = c & 31, ob = rr * 64 + cc * 2; return st * 1024 + (ob ^ (((ob >> 9) & 1) << 5)); }
__host__ __device__ __forceinline__ void stage_rc(int b, int& R, int& C) { const int st = b / 1024, sb = b % 1024, swz = sb ^ (((sb >> 9) & 1) << 5); R = (st >> 1) * 16 + swz / 64; C = (st & 1) * 32 + (swz % 64) / 2; }
__host__ __device__ __forceinline__ int perm32(int rho) { const int n = rho >> 4, i = rho & 15; return 8 * (i >> 2) + 4 * n + (i & 3); }

__device__ __forceinline__ int fresh_tid(int wave) { int l; asm volatile("v_mbcnt_lo_u32_b32 %0, -1, 0\n\tv_mbcnt_hi_u32_b32 %0, -1, %0" : "=v"(l)); return wave * 64 + l; }
struct Unit { int pm, pn; };
struct Gemm { const bf16_t* A; const bf16_t* Bt; int M, N, K; };

struct StaticOrder {
    int nM, nN, nwg, G, c;
    __host__ __device__ void init(int M, int N, int G_, int c_) { nM = M / BM; nN = N / BM; nwg = nM * nN; G = G_; c = c_; }
    __host__ __device__ bool next(int i, Unit& u) const {
        const long L = (long)i * G + c; if (L >= nwg) return false;
        int wgid = (int)L; { const int q = nwg / NXCD, r = nwg % NXCD, xcd = wgid % NXCD, off = wgid / NXCD; wgid = (xcd < r ? xcd * (q + 1) : r * (q + 1) + (xcd - r) * q) + off; }
        const int nig = WGM * nN, gid = wgid / nig, fm = gid * WGM, gsz = (nM - fm) < WGM ? (nM - fm) : WGM;
        u.pm = fm + ((wgid % nig) % gsz); u.pn = (wgid % nig) / gsz; return true;
    }
    __device__ __forceinline__ void a_ready(const Unit&) const {}
    __device__ __forceinline__ void done(const Unit&) const {}
};


__device__ __forceinline__ unsigned cvt_pk_bf16(float lo, float hi) { unsigned r; asm volatile("v_cvt_pk_bf16_f32 %0, %1, %2" : "=v"(r) : "v"(lo), "v"(hi)); return r; }
__device__ __forceinline__ float sigm(float x) { return __builtin_amdgcn_rcpf(1.0f + __builtin_amdgcn_exp2f(-1.4426950408889634f * x)); }
__device__ __forceinline__ f32x4 sigm4(f32x4 v) { return (f32x4){sigm(v[0]), sigm(v[1]), sigm(v[2]), sigm(v[3])}; }
__device__ __forceinline__ float bflo(unsigned w) { return __uint_as_float(w << 16); }
__device__ __forceinline__ float bfhi(unsigned w) { return __uint_as_float(w & 0xffff0000u); }
struct F8 { f32x4 a, b; };
__device__ __forceinline__ F8 unpk8(u32x4 w) { F8 r; r.a = (f32x4){bflo(w.x), bfhi(w.x), bflo(w.y), bfhi(w.y)}; r.b = (f32x4){bflo(w.z), bfhi(w.z), bflo(w.w), bfhi(w.w)}; return r; }
__device__ __forceinline__ u32x4 pk8(f32x4 a, f32x4 b) { u32x4 w; w.x = cvt_pk_bf16(a[0], a[1]); w.y = cvt_pk_bf16(a[2], a[3]); w.z = cvt_pk_bf16(b[0], b[1]); w.w = cvt_pk_bf16(b[2], b[3]); return w; }

struct EpiZG {
    static constexpr bool PERM = true, AFTER_DRAIN = false;
    bf16_t* Z; bf16_t* G;
    __device__ __forceinline__ void operator()(const f32x4 (&acc)[2][2][4][2], const Unit& u, int wr, int wc, int fr, int fq) const {
        const bool isg = u.pn >= 42; bf16_t* base = isg ? G : Z; const int ldc = isg ? 4096 : 10752; const int colt = (isg ? u.pn - 42 : u.pn) * BM;
        const int row0 = u.pm * BM + wr * 64 + fr, col0 = colt + wc * 32 + 8 * fq;
#pragma unroll
        for (int ai = 0; ai < 2; ++ai)
#pragma unroll
            for (int m = 0; m < 4; ++m) { bf16_t* rowp = base + (size_t)(row0 + ai * HALF + m * 16) * ldc + col0;
#pragma unroll
                for (int bj = 0; bj < 2; ++bj) { f32x4 v0 = acc[ai][bj][m][0], v1 = acc[ai][bj][m][1];
                    if (isg) { v0 = sigm4(v0); v1 = sigm4(v1); }
                    *(u32x4*)(rowp + bj * HALF) = pk8(v0, v1); } }
    }
};
struct EpiGateA {
    static constexpr bool PERM = true, AFTER_DRAIN = false;
    const bf16_t* G; float* T1;
    __device__ __forceinline__ void operator()(const f32x4 (&acc)[2][2][4][2], const Unit& u, int wr, int wc, int fr, int fq) const {
        const int row0 = u.pm * BM + wr * 64 + fr, col0 = u.pn * BM + wc * 32 + 8 * fq;
#pragma unroll
        for (int ai = 0; ai < 2; ++ai)
#pragma unroll
            for (int m = 0; m < 4; ++m) { const size_t r = (size_t)(row0 + ai * HALF + m * 16);
#pragma unroll
                for (int bj = 0; bj < 2; ++bj) { const F8 g = unpk8(*(const u32x4*)(G + r * 4096 + col0 + bj * HALF));
                    float* o = T1 + r * 2048 + col0 + bj * HALF;
                    *(f32x4*)o = acc[ai][bj][m][0] * g.a; *(f32x4*)(o + 4) = acc[ai][bj][m][1] * g.b; }
                asm volatile("" ::: "memory"); }
    }
};
struct EpiMerge {
    static constexpr bool PERM = true, AFTER_DRAIN = false;
    const bf16_t* G; const float* T1; bf16_t* O;
    __device__ __forceinline__ void operator()(const f32x4 (&acc)[2][2][4][2], const Unit& u, int wr, int wc, int fr, int fq) const {
        const int row0 = u.pm * BM + wr * 64 + fr, col0 = u.pn * BM + wc * 32 + 8 * fq;
#pragma unroll
        for (int ai = 0; ai < 2; ++ai)
#pragma unroll
            for (int m = 0; m < 4; ++m) { const size_t r = (size_t)(row0 + ai * HALF + m * 16);
#pragma unroll
                for (int bj = 0; bj < 2; ++bj) { const F8 g = unpk8(*(const u32x4*)(G + r * 4096 + 2048 + col0 + bj * HALF));
                    const float* t = T1 + r * 2048 + col0 + bj * HALF;
                    const f32x4 v0 = *(const f32x4*)t + acc[ai][bj][m][0] * g.a, v1 = *(const f32x4*)(t + 4) + acc[ai][bj][m][1] * g.b;
                    *(u32x4*)(O + r * 2048 + col0 + bj * HALF) = pk8(v0, v1); }
                asm volatile("" ::: "memory"); }
    }
};
struct EpiRes {
    static constexpr bool PERM = false, AFTER_DRAIN = false;
    const float* X; float* O;
    __device__ __forceinline__ void operator()(const f32x4 (&acc)[2][2][4][2], const Unit& u, int wr, int wc, int fr, int fq) const {
        const int row0 = u.pm * BM + wr * 64 + fr, col0 = u.pn * BM + wc * 32 + 4 * fq;
#pragma unroll
        for (int ai = 0; ai < 2; ++ai)
#pragma unroll
            for (int m = 0; m < 4; ++m) { const size_t off = (size_t)(row0 + ai * HALF + m * 16) * 2048 + col0;
#pragma unroll
                for (int bj = 0; bj < 2; ++bj)
#pragma unroll
                    for (int n = 0; n < 2; ++n) *(f32x4*)(O + off + bj * HALF + n * 16) = *(const f32x4*)(X + off + bj * HALF + n * 16) + acc[ai][bj][m][n];
                if (m & 1) asm volatile("" ::: "memory"); }
    }
};
struct EpiSwiGLU {
    static constexpr bool PERM = true, AFTER_DRAIN = false;
    bf16_t* Hd;
    __device__ __forceinline__ void operator()(const f32x4 (&acc)[2][2][4][2], const Unit& u, int wr, int wc, int fr, int fq) const {
        const int row0 = u.pm * BM + wr * 64 + fr, col0 = (u.pn & 7) * HALF + wc * 32 + 8 * fq;
#pragma unroll
        for (int ai = 0; ai < 2; ++ai)
#pragma unroll
            for (int m = 0; m < 4; ++m) { const size_t r = (size_t)(row0 + ai * HALF + m * 16);
                const f32x4 a0 = acc[ai][0][m][0], a1 = acc[ai][0][m][1], b0 = acc[ai][1][m][0], b1 = acc[ai][1][m][1];
                const f32x4 v0 = a0 * sigm4(a0) * b0, v1 = a1 * sigm4(a1) * b1;
                *(u32x4*)(Hd + r * 1024 + col0) = pk8(v0, v1); }
    }
};
struct EpiScatter {
    static constexpr bool PERM = false, AFTER_DRAIN = false;
    const int* row_tok; const float* row_w; float* X;
    __device__ __forceinline__ void operator()(const f32x4 (&acc)[2][2][4][2], const Unit& u, int wr, int wc, int fr, int fq) const {
        const int row0 = u.pm * BM + wr * 64 + fr, col0 = (u.pn & 7) * BM + wc * 32 + 4 * fq;
#pragma unroll
        for (int ai = 0; ai < 2; ++ai)
#pragma unroll
            for (int m = 0; m < 4; ++m) { const int r = row0 + ai * HALF + m * 16; const int tok = row_tok[r]; const float w = row_w[r];
                if (tok >= 0) { float* o = X + (size_t)tok * 2048 + col0;
#pragma unroll
                    for (int bj = 0; bj < 2; ++bj)
#pragma unroll
                        for (int n = 0; n < 2; ++n)
#pragma unroll
                            for (int i = 0; i < 4; ++i) unsafeAtomicAdd(o + bj * HALF + n * 16 + i, w * acc[ai][bj][m][n][i]); } }
    }
};
struct EpiF32 {
    static constexpr bool PERM = false, AFTER_DRAIN = false;
    float* O;
    __device__ __forceinline__ void operator()(const f32x4 (&acc)[2][2][4][2], const Unit& u, int wr, int wc, int fr, int fq) const {
        const int row0 = u.pm * BM + wr * 64 + fr, col0 = u.pn * BM + wc * 32 + 4 * fq;
#pragma unroll
        for (int ai = 0; ai < 2; ++ai)
#pragma unroll
            for (int m = 0; m < 4; ++m) { const size_t off = (size_t)(row0 + ai * HALF + m * 16) * 2048 + col0;
#pragma unroll
                for (int bj = 0; bj < 2; ++bj)
#pragma unroll
                    for (int n = 0; n < 2; ++n) *(f32x4*)(O + off + bj * HALF + n * 16) = acc[ai][bj][m][n]; }
    }
};
struct EpiPle {
    static constexpr bool PERM = false, AFTER_DRAIN = false;
    const float* E; float* X;
    __device__ __forceinline__ void operator()(const f32x4 (&acc)[2][2][4][2], const Unit& u, int wr, int wc, int fr, int fq) const {
        const int row0 = u.pm * BM + wr * 64 + fr, col0 = u.pn * BM + wc * 32 + 4 * fq;
#pragma unroll
        for (int ai = 0; ai < 2; ++ai)
#pragma unroll
            for (int m = 0; m < 4; ++m) { const size_t off = (size_t)(row0 + ai * HALF + m * 16) * 2048 + col0;
#pragma unroll
                for (int bj = 0; bj < 2; ++bj)
#pragma unroll
                    for (int n = 0; n < 2; ++n) { float* x = X + off + bj * HALF + n * 16;
                        *(f32x4*)x = *(const f32x4*)x + sigm4(acc[ai][bj][m][n]) * *(const f32x4*)(E + off + bj * HALF + n * 16); }
                asm volatile("" ::: "memory"); }
    }
};
struct MoeOrder {
    const int* tile_e; int n8, G, c;
    __device__ __forceinline__ bool next(int i, Unit& u) const {
        const long L = (long)i * G + c; if (L >= n8) return false;
        u.pm = (int)(L >> 3);
        const int e = __builtin_amdgcn_readfirstlane(__hip_atomic_load(tile_e + u.pm, __ATOMIC_RELAXED, __HIP_MEMORY_SCOPE_AGENT));
        u.pn = e * 8 + (int)(L & 7); return true;
    }
    __device__ __forceinline__ void a_ready(const Unit&) const {}
    __device__ __forceinline__ void done(const Unit&) const {}
};
template <class Epi, class Sched, bool ALIGN_EPI = false, bool SP2 = false>
__device__ __forceinline__ void gemm_phase(PG8_LAS unsigned char* lds, const Gemm g, const Sched& S, const Epi& E, const int wave) {
    const int tid = fresh_tid(wave), wid = wave, lane = tid & 63, wr = wid >> 2, wc = wid & 3, fr = lane & 15, fq = lane >> 4;
    const int K = g.K, nt = K / BK;
    unsigned voffA[2], voffB[2];
#pragma unroll
    for (int i = 0; i < 2; ++i) { int R, C; stage_rc(tid * 16 + i * 8192, R, C); const int Rb = Epi::PERM ? ((R & ~31) + perm32(R & 31)) : R;
        voffA[i] = (unsigned)(R * K + C) * 2u; voffB[i] = (unsigned)(Rb * K + C) * 2u; }
    const size_t kstep = (size_t)(BK * 2);
    const size_t hstep = (size_t)HALF * K * 2;
    const size_t tstep = 2 * hstep;
    const unsigned ldsw = (unsigned)wid * 1024u;
    const int aoff = lds_byte(wr * 64 + fr, fq * 8), boff = lds_byte(wc * 32 + fr, fq * 8);
#define PG8_SA(b, h) (((b) * 2 + (h)) * HTB)
#define PG8_SB(b, h) ((4 + (b) * 2 + (h)) * HTB)
#define PG8_STAGE(bufoff, gbase, voff) do { _Pragma("unroll") for (int _i = 0; _i < 2; ++_i) \
        __builtin_amdgcn_global_load_lds((const unsigned*)((const char*)(gbase) + (voff)[_i]), (PG8_LAS unsigned*)(lds + (bufoff) + ldsw + _i * 8192), 16, 0, 0); } while (0)
#define PG8_LDA(dst, b, h) do { _Pragma("unroll") for (int m = 0; m < 4; ++m) _Pragma("unroll") for (int k = 0; k < 2; ++k) dst[m][k] = *(const PG8_LAS bf16x8*)(lds + PG8_SA(b, h) + aoff + m * 2048 + k * 1024); } while (0)
#define PG8_LDB(dst, b, h) do { _Pragma("unroll") for (int n = 0; n < 2; ++n) _Pragma("unroll") for (int k = 0; k < 2; ++k) dst[n][k] = *(const PG8_LAS bf16x8*)(lds + PG8_SB(b, h) + boff + n * 2048 + k * 1024); } while (0)
#define PG8_MMA(ai, bj, At, Bt) do { __builtin_amdgcn_s_setprio(1); _Pragma("unroll") for (int m = 0; m < 4; ++m) _Pragma("unroll") for (int n = 0; n < 2; ++n) _Pragma("unroll") for (int k = 0; k < 2; ++k) \
        acc[ai][bj][m][n] = __builtin_amdgcn_mfma_f32_16x16x32_bf16(Bt[n][k], At[m][k], acc[ai][bj][m][n], 0, 0, 0); __builtin_amdgcn_s_setprio(0); } while (0)
#define PG8_WAIT_V(n) asm volatile("s_waitcnt vmcnt(" #n ")" ::: "memory")
#define PG8_WAIT_L(n) asm volatile("s_waitcnt lgkmcnt(" #n ")" ::: "memory")
#define PG8_BAR __builtin_amdgcn_s_barrier()
#define PG8_SCHED __builtin_amdgcn_sched_barrier(0)
    Unit cur, nxt; int ui = 0;
    if (!S.next(0, cur)) return;
    f32x4 acc[2][2][4][2];
#pragma unroll
    for (int a = 0; a < 2; ++a)
#pragma unroll
        for (int b = 0; b < 2; ++b)
#pragma unroll
            for (int m = 0; m < 4; ++m)
#pragma unroll
                for (int n = 0; n < 2; ++n) acc[a][b][m][n] = (f32x4){0.f, 0.f, 0.f, 0.f};
    bf16x8 At[4][2], B0[2][2], B1[2][2];
    const char* cA = (const char*)g.A + (size_t)cur.pm * tstep; const char* cB = (const char*)g.Bt + (size_t)cur.pn * tstep;
    S.a_ready(cur);
    if constexpr (SP2) {
        PG8_STAGE(PG8_SB(0, 0), cB, voffB); PG8_STAGE(PG8_SB(0, 1), cB + hstep, voffB); PG8_STAGE(PG8_SA(0, 0), cA, voffA); PG8_STAGE(PG8_SA(0, 1), cA + hstep, voffA);
        if (wr == 1) PG8_BAR;
        PG8_WAIT_V(2); PG8_BAR;
        PG8_STAGE(PG8_SB(1, 0), cB + kstep, voffB); PG8_STAGE(PG8_SA(1, 0), cA + kstep, voffA); PG8_STAGE(PG8_SB(1, 1), cB + hstep + kstep, voffB);
        PG8_WAIT_V(6); PG8_BAR;
    } else {
        PG8_STAGE(PG8_SB(0, 0), cB, voffB); PG8_STAGE(PG8_SA(0, 0), cA, voffA); PG8_STAGE(PG8_SB(0, 1), cB + hstep, voffB); PG8_STAGE(PG8_SA(0, 1), cA + hstep, voffA);
        if (wr == 1) PG8_BAR;
        PG8_WAIT_V(4); PG8_BAR;
        PG8_STAGE(PG8_SB(1, 0), cB + kstep, voffB); PG8_STAGE(PG8_SA(1, 0), cA + kstep, voffA); PG8_STAGE(PG8_SB(1, 1), cB + hstep + kstep, voffB);
        PG8_WAIT_V(6); PG8_BAR;
    }
    for (;;) {
        const bool has_next = S.next(ui + 1, nxt);
        const char* nA = has_next ? (const char*)g.A + (size_t)nxt.pm * tstep : cA; const char* nB = has_next ? (const char*)g.Bt + (size_t)nxt.pn * tstep : cB;
        for (int t = 0; t < nt; t += 2) {
            const bool last = (t == nt - 2);
            const char* a1 = cA + (size_t)(t + 1) * kstep;
            const char* a2 = last ? nA : cA + (size_t)(t + 2) * kstep; const char* b2 = last ? nB : cB + (size_t)(t + 2) * kstep;
            const char* a3 = a2 + kstep; const char* b3 = b2 + kstep;
            if (last && has_next) S.a_ready(nxt);
            if constexpr (SP2) {
            PG8_LDB(B0, 0, 0); PG8_LDB(B1, 0, 1); PG8_SCHED; PG8_LDA(At, 0, 0); PG8_STAGE(PG8_SA(1, 1), a1 + hstep, voffA);
            PG8_WAIT_V(8); PG8_WAIT_L(0); PG8_BAR; PG8_MMA(0, 0, At, B0); PG8_MMA(0, 1, At, B1); PG8_BAR; PG8_SCHED;
            PG8_LDA(At, 0, 1); PG8_STAGE(PG8_SB(0, 0), b2, voffB); PG8_STAGE(PG8_SB(0, 1), b2 + hstep, voffB); PG8_STAGE(PG8_SA(0, 0), a2, voffA);
            PG8_WAIT_V(8); PG8_WAIT_L(0); PG8_BAR; PG8_MMA(1, 0, At, B0); PG8_MMA(1, 1, At, B1); PG8_BAR; PG8_SCHED;
            PG8_LDB(B0, 1, 0); PG8_LDB(B1, 1, 1); PG8_SCHED; PG8_LDA(At, 1, 0); PG8_STAGE(PG8_SA(0, 1), a2 + hstep, voffA);
            PG8_WAIT_V(8); PG8_WAIT_L(0); PG8_BAR; PG8_MMA(0, 0, At, B0); PG8_MMA(0, 1, At, B1); PG8_BAR; PG8_SCHED;
            PG8_LDA(At, 1, 1); PG8_STAGE(PG8_SB(1, 0), b3, voffB); PG8_STAGE(PG8_SB(1, 1), b3 + hstep, voffB); PG8_STAGE(PG8_SA(1, 0), a3, voffA);
            PG8_WAIT_V(8); PG8_WAIT_L(0); PG8_BAR; PG8_MMA(1, 0, At, B0); PG8_MMA(1, 1, At, B1); PG8_BAR; PG8_SCHED;
            } else {
            PG8_LDB(B0, 0, 0); PG8_SCHED; PG8_LDA(At, 0, 0); PG8_STAGE(PG8_SA(1, 1), a1 + hstep, voffA);
            PG8_WAIT_L(8); PG8_BAR; PG8_WAIT_L(0); PG8_MMA(0, 0, At, B0); PG8_BAR; PG8_SCHED;
            PG8_LDB(B1, 0, 1); PG8_STAGE(PG8_SB(0, 0), b2, voffB);
            PG8_BAR; PG8_WAIT_L(0); PG8_MMA(0, 1, At, B1); PG8_BAR;
            PG8_LDA(At, 0, 1); PG8_STAGE(PG8_SA(0, 0), a2, voffA);
            PG8_BAR; PG8_WAIT_L(0); PG8_MMA(1, 0, At, B0); PG8_BAR; PG8_SCHED;
            PG8_STAGE(PG8_SB(0, 1), b2 + hstep, voffB);
            PG8_WAIT_V(6); PG8_BAR; PG8_MMA(1, 1, At, B1); PG8_BAR;
            PG8_LDB(B0, 1, 0); PG8_SCHED; PG8_LDA(At, 1, 0); PG8_STAGE(PG8_SA(0, 1), a2 + hstep, voffA);
            PG8_WAIT_L(8); PG8_BAR; PG8_WAIT_L(0); PG8_MMA(0, 0, At, B0); PG8_BAR; PG8_SCHED;
            PG8_LDB(B1, 1, 1); PG8_STAGE(PG8_SB(1, 0), b3, voffB);
            PG8_BAR; PG8_WAIT_L(0); PG8_MMA(0, 1, At, B1); PG8_BAR;
            PG8_LDA(At, 1, 1); PG8_STAGE(PG8_SA(1, 0), a3, voffA);
            PG8_BAR; PG8_WAIT_L(0); PG8_MMA(1, 0, At, B0); PG8_BAR; PG8_SCHED;
            PG8_STAGE(PG8_SB(1, 1), b3 + hstep, voffB);
            PG8_WAIT_V(6); PG8_BAR; PG8_MMA(1, 1, At, B1); PG8_BAR;
            }
        }
        if constexpr (ALIGN_EPI) { if (wr == 0) PG8_BAR; }
        if constexpr (!Epi::AFTER_DRAIN) { E(acc, cur, wr, wc, fr, fq); S.done(cur); }
        if (!has_next) break;
#pragma unroll
        for (int a = 0; a < 2; ++a)
#pragma unroll
            for (int b = 0; b < 2; ++b)
#pragma unroll
                for (int m = 0; m < 4; ++m)
#pragma unroll
                    for (int n = 0; n < 2; ++n) acc[a][b][m][n] = (f32x4){0.f, 0.f, 0.f, 0.f};
        cur = nxt; cA = nA; cB = nB; ++ui;
        if constexpr (ALIGN_EPI) { if (wr == 1) PG8_BAR; }
    }
    PG8_WAIT_V(0);
    if constexpr (!ALIGN_EPI) { if (wr == 0) PG8_BAR; }
    PG8_BAR;
    if constexpr (Epi::AFTER_DRAIN) { E.fused(acc, cur, wr, wc, fr, fq, lds, wid, lane); S.done(cur); }
#undef PG8_SA
#undef PG8_SB
#undef PG8_STAGE
#undef PG8_LDA
#undef PG8_LDB
#undef PG8_MMA
#undef PG8_WAIT_V
#undef PG8_WAIT_L
#undef PG8_BAR
#undef PG8_SCHED
}
}

namespace att {
typedef unsigned short bf16_t;
typedef short bf16x8 __attribute__((ext_vector_type(8)));
typedef short s16x4 __attribute__((ext_vector_type(4)));
typedef float f32x16 __attribute__((ext_vector_type(16)));
typedef float f32x4 __attribute__((ext_vector_type(4)));
typedef unsigned u32x4 __attribute__((ext_vector_type(4)));
constexpr int LDZ = 10752;
constexpr int WS_OFF = 65536, TAB_OFF = 67584, TAB_N = 2304, ATT_LDS = TAB_OFF + TAB_N * 4;
constexpr float THR = 8.f;
#define SBAR() __builtin_amdgcn_sched_barrier(0)
__device__ __forceinline__ int crow(int r, int hi) { return (r & 3) + 8 * (r >> 2) + 4 * hi; }
__device__ __forceinline__ unsigned cvtpk(float lo, float hi) { unsigned r; asm volatile("v_cvt_pk_bf16_f32 %0, %1, %2" : "=v"(r) : "v"(lo), "v"(hi)); return r; }
template <int DH> __device__ __forceinline__ int kswz(int row, int colB) { return row * (DH * 2) + (colB ^ ((row & 7) << 4)); }
template <int DH> __device__ __forceinline__ int v_st(int k, int c) { const int kk = (k & ~0xC) | ((k & 4) << 1) | ((k & 8) >> 1); return ((kk >> 3) * (DH / 32) + (c >> 5)) * 512 + ((kk & 7) * 32 + (c & 31)) * 2; }
__device__ __forceinline__ int v_rd_base(int lane) { return ((lane & 3) << 3) | (((lane >> 2) & 3) << 6) | (((lane >> 4) & 1) << 5) | (((lane >> 5) & 1) << 8); }
__device__ __forceinline__ bf16x8 ld8(const bf16_t* p) { return *reinterpret_cast<const bf16x8*>(p); }
__device__ __forceinline__ size_t vrow_off(int v, int dil, int lgL) { return (size_t)((v & ((1 << lgL) - 1)) * dil + (v >> lgL)) * LDZ; }
__device__ __forceinline__ int vrow_tok(int v, int dil, int lgL) { return (v & ((1 << lgL) - 1)) * dil + (v >> lgL); }

__device__ __forceinline__ void bias_tile(f32x16& p0, f32x16& p1, const float* tb) {
#pragma unroll
    for (int r = 0; r < 16; ++r) { const int c = (r & 3) + 8 * (r >> 2); p0[r] += tb[59 - c]; p1[r] += tb[27 - c]; }
}
__device__ __forceinline__ void mask_tile(f32x16& p0, f32x16& p1, int dq, unsigned W) {
    const float NEG = -__builtin_inff();
#pragma unroll
    for (int r = 0; r < 16; ++r) { const int c = (r & 3) + 8 * (r >> 2);
        if ((unsigned)(dq - c) >= W) p0[r] = NEG;
        if ((unsigned)(dq - c - 32) >= W) p1[r] = NEG; }
}
template <int DH>
__device__ __forceinline__ void partialSM(f32x16& p0, f32x16& p1, float& m_reg, float& mn, float& alpha) {
    constexpr float SCALE = DH == 128 ? 0.08838834764831845f : 0.125f;
    float pmax = p0[0];
#pragma unroll
    for (int r = 1; r < 16; ++r) pmax = fmaxf(pmax, p0[r]);
#pragma unroll
    for (int r = 0; r < 16; ++r) pmax = fmaxf(pmax, p1[r]);
    { auto rr = __builtin_amdgcn_permlane32_swap(__float_as_uint(pmax), __float_as_uint(pmax), false, false);
      pmax = fmaxf(__uint_as_float(rr[0]), __uint_as_float(rr[1])); }
    constexpr float C2 = 1.4426950408889634f * SCALE;
    if (__builtin_expect(__all((pmax - m_reg) * SCALE <= THR), 1)) { mn = m_reg; alpha = 1.f; }
    else { mn = fmaxf(m_reg, pmax); alpha = __builtin_amdgcn_exp2f((m_reg - mn) * C2); m_reg = mn; }
    const float mnL = -mn * C2;
#pragma unroll
    for (int r = 0; r < 16; ++r) p0[r] = fmaf(p0[r], C2, mnL);
#pragma unroll
    for (int r = 0; r < 16; ++r) p1[r] = fmaf(p1[r], C2, mnL);
#pragma unroll
    for (int r = 0; r < 16; ++r) p0[r] = __builtin_amdgcn_exp2f(p0[r]);
}
__device__ __forceinline__ void finishSM(f32x16& p0, f32x16& p1, float alpha, float& l_reg, bf16x8& pa0, bf16x8& pa1, bf16x8& pa2, bf16x8& pa3) {
#pragma unroll
    for (int r = 0; r < 16; ++r) p1[r] = __builtin_amdgcn_exp2f(p1[r]);
    float ps = 0;
#pragma unroll
    for (int r = 0; r < 16; ++r) ps += p0[r];
#pragma unroll
    for (int r = 0; r < 16; ++r) ps += p1[r];
    { auto rr = __builtin_amdgcn_permlane32_swap(__float_as_uint(ps), __float_as_uint(ps), false, false);
      ps = __uint_as_float(rr[0]) + __uint_as_float(rr[1]); }
    l_reg = l_reg * alpha + ps;
#define PK4(P, B_, OUT) do { unsigned a0 = cvtpk(P[B_+0], P[B_+1]), a1 = cvtpk(P[B_+2], P[B_+3]);                          \
        unsigned b0 = cvtpk(P[B_+4], P[B_+5]), b1 = cvtpk(P[B_+6], P[B_+7]);                                             \
        auto r0 = __builtin_amdgcn_permlane32_swap(a0, b0, false, false); auto r1 = __builtin_amdgcn_permlane32_swap(a1, b1, false, false); \
        u32x4 w = {r0[0], r1[0], r0[1], r1[1]}; OUT = *reinterpret_cast<bf16x8*>(&w); } while (0)
    PK4(p0, 0, pa0); PK4(p0, 8, pa1); PK4(p1, 0, pa2); PK4(p1, 8, pa3);
#undef PK4
}
template <int DH, int KB, bool SK>
__device__ __forceinline__ void qkt(f32x16& p0, f32x16& p1, const char* K_lds, int r32, int hi, const bf16x8* qr, bool act) {
    constexpr int SHM = 64 * DH * 2;
    if (SK && !act) { const float NEG = -__builtin_inff();
#pragma unroll
        for (int r = 0; r < 16; ++r) { p0[r] = NEG; p1[r] = NEG; } return; }
    p0 = f32x16{}; p1 = f32x16{};
    const char* kb[4];
    if constexpr (DH == 128) {
#pragma unroll
        for (int dd = 0; dd < 4; ++dd) kb[dd] = K_lds + KB * SHM + kswz<DH>(r32, (dd * 16 + hi * 8) * 2);
#pragma unroll
        for (int d0 = 0; d0 < 8; ++d0) { const char* a = kb[d0 & 3] + (d0 >> 2) * 128;
            bf16x8 b0 = *reinterpret_cast<const bf16x8*>(a);
            bf16x8 b1 = *reinterpret_cast<const bf16x8*>(a + 32 * 256);
            p0 = __builtin_amdgcn_mfma_f32_32x32x16_bf16(b0, qr[d0], p0, 0, 0, 0);
            p1 = __builtin_amdgcn_mfma_f32_32x32x16_bf16(b1, qr[d0], p1, 0, 0, 0); }
    } else {
#pragma unroll
        for (int dd = 0; dd < 4; ++dd) kb[dd] = K_lds + KB * SHM + kswz<DH>(r32, (dd * 16 + hi * 8) * 2);
#pragma unroll
        for (int d0 = 0; d0 < 4; ++d0) { const char* a = kb[d0];
            bf16x8 b0 = *reinterpret_cast<const bf16x8*>(a);
            bf16x8 b1 = *reinterpret_cast<const bf16x8*>(a + 32 * 128);
            p0 = __builtin_amdgcn_mfma_f32_32x32x16_bf16(b0, qr[d0], p0, 0, 0, 0);
            p1 = __builtin_amdgcn_mfma_f32_32x32x16_bf16(b1, qr[d0], p1, 0, 0, 0); }
    }
}
template <int DH, int VB, bool SK>
__device__ __forceinline__ void pv_tile(f32x16* o, int vb0, bf16x8 pa0, bf16x8 pa1, bf16x8 pa2, bf16x8 pa3, bool act) {
    constexpr int SHM = 64 * DH * 2, HF = (DH / 32) * 512, KS = 2 * HF;
    if (SK && !act) return;
#define TRRD(dst, off) asm volatile("ds_read_b64_tr_b16 %0, %1 offset:%2" : "=&v"(dst) : "v"(vb0), "i"(off) : "memory")
#define PV_D0(d0) do { s16x4 l0, l1, l2, l3, h0, h1, h2, h3; constexpr int b_ = VB * SHM + (d0) * 512; \
        TRRD(l0, b_); TRRD(h0, b_ + HF); TRRD(l1, b_ + KS); TRRD(h1, b_ + KS + HF); TRRD(l2, b_ + 2 * KS); TRRD(h2, b_ + 2 * KS + HF); TRRD(l3, b_ + 3 * KS); TRRD(h3, b_ + 3 * KS + HF); \
        asm volatile("s_waitcnt lgkmcnt(0)" ::: "memory"); SBAR();   \
        o[d0] = __builtin_amdgcn_mfma_f32_32x32x16_bf16(pa0, (bf16x8){l0[0], l0[1], l0[2], l0[3], h0[0], h0[1], h0[2], h0[3]}, o[d0], 0, 0, 0);   \
        o[d0] = __builtin_amdgcn_mfma_f32_32x32x16_bf16(pa1, (bf16x8){l1[0], l1[1], l1[2], l1[3], h1[0], h1[1], h1[2], h1[3]}, o[d0], 0, 0, 0);   \
        o[d0] = __builtin_amdgcn_mfma_f32_32x32x16_bf16(pa2, (bf16x8){l2[0], l2[1], l2[2], l2[3], h2[0], h2[1], h2[2], h2[3]}, o[d0], 0, 0, 0);   \
        o[d0] = __builtin_amdgcn_mfma_f32_32x32x16_bf16(pa3, (bf16x8){l3[0], l3[1], l3[2], l3[3], h3[0], h3[1], h3[2], h3[3]}, o[d0], 0, 0, 0); } while (0)
    PV_D0(0); PV_D0(1);
    if constexpr (DH == 128) { PV_D0(2); PV_D0(3); }
#undef PV_D0
#undef TRRD
}

struct BlockRef { const bf16_t* Q; const bf16_t* K; const bf16_t* V; float* scr; bf16_t* O; float* lse; int P0, dil, lgL, mode, ldo, head; float lam; };
template <int DH> struct Seam { bf16x8 qr[DH / 16]; bf16x8 st_v0, st_v1, st_k0, st_k1; };

template <bool BANDED> __device__ __forceinline__ int blk_lowk(int P0, int lgL) { const int ss = P0 & ~((1 << lgL) - 1); int lk = BANDED ? P0 - 128 : 0; return lk < ss ? ss : lk; }

#define VMW() asm volatile("s_waitcnt vmcnt(0)" ::: "memory")
#define VMWN(n) asm volatile("s_waitcnt vmcnt(%0)" :: "i"(n) : "memory")
#define TBASE(v0, dl, lg) ((size_t)(BANDED ? vrow_tok((v0), (dl), (lg)) : (v0)) * LDZ)
#define LOFF(rr, dl) ((unsigned)((rr) * (BANDED ? (dl) : 1) * LDZ + sc))
#define SLOAD_H(Kp, Vp, k0, dl, lg) do { const bf16_t* kp_ = (Kp) + TBASE(k0, dl, lg); const bf16_t* vp_ = (Vp) + TBASE(k0, dl, lg); const unsigned l0_ = LOFF(sr, dl); \
        S.st_v0 = ld8(vp_ + l0_); if constexpr (DH == 128) S.st_v1 = ld8(vp_ + LOFF(32 + sr, dl)); \
        S.st_k0 = ld8(kp_ + l0_); if constexpr (DH == 128) S.st_k1 = ld8(kp_ + LOFF(32 + sr, dl)); } while (0)
#define SWRITE_HK(bf) do { *(bf16x8*)(K_lds + (bf) * SHM + kws) = S.st_k0; if constexpr (DH == 128) *(bf16x8*)(K_lds + (bf) * SHM + kws + 32 * 256) = S.st_k1; } while (0)
#define SWRITE_HV(bf) do { *(bf16x8*)(V_lds + (bf) * SHM + vst0) = S.st_v0; if constexpr (DH == 128) *(bf16x8*)(V_lds + (bf) * SHM + vst1) = S.st_v1; } while (0)
#define SWRITE_H(bf) do { SWRITE_HV(bf); SWRITE_HK(bf); } while (0)
#define STAGE_IDX() int sr, sc, vst0, vst1, kws; \
    if constexpr (DH == 128) { sr = tid >> 4; sc = (tid & 15) * 8; vst0 = v_st<DH>(sr, sc); vst1 = v_st<DH>(32 + sr, sc); kws = kswz<DH>(sr, sc * 2); } \
    else { sr = tid >> 3; sc = (tid & 7) * 8; vst0 = v_st<DH>(sr, sc); vst1 = 0; kws = kswz<DH>(sr, sc * 2); } (void)vst1

#ifdef NO_BIAS
#define BIAS_CALL(a,b,c) do {} while (0)
#else
#define BIAS_CALL(a,b,c) bias_tile(a,b,c)
#endif
template <int DH, bool BANDED>
__device__ __forceinline__ void attn_prime(const BlockRef& cur, char* lds, Seam<DH>& S, const int tid) {
    constexpr int SHM = 64 * DH * 2;
    const int wid = __builtin_amdgcn_readfirstlane(tid >> 6), lane = tid & 63, r32 = lane & 31, hi = lane >> 5;
    STAGE_IDX(); (void)vst0;
    char* K_lds = lds + 2 * SHM;
    const int kb0 = blk_lowk<BANDED>(cur.P0, cur.lgL) & ~63;
    const bf16_t* qp = cur.Q + TBASE(cur.P0 + wid * 32, cur.dil, cur.lgL) + (unsigned)(r32 * (BANDED ? cur.dil : 1) * LDZ + hi * 8);
#pragma unroll
    for (int d0 = 0; d0 < DH / 16; ++d0) S.qr[d0] = ld8(qp + d0 * 16);
    SLOAD_H(cur.K, cur.V, kb0, cur.dil, cur.lgL); VMW(); SWRITE_HK(0);
    __syncthreads();
}
template <int DH, bool BANDED>
__device__ __forceinline__ void attn_block(const BlockRef& cur, const BlockRef& nxt, char* lds, Seam<DH>& S, const int tid) {
    constexpr int SHM = 64 * DH * 2, NQ = DH / 16, ND = DH / 32;
    constexpr float SCALE = DH == 128 ? 0.08838834764831845f : 0.125f;
    constexpr bool SK = BANDED;
    const int wid = __builtin_amdgcn_readfirstlane(tid >> 6), lane = tid & 63, r32 = lane & 31, hi = lane >> 5;
    const int dil = cur.dil, lgL = cur.lgL, Lm = (1 << lgL) - 1;
    const int j_lo = blk_lowk<BANDED>(cur.P0, lgL) >> 6;
    const int NT = (cur.P0 >> 6) + 4 - j_lo;
    const int kbn = blk_lowk<BANDED>(nxt.P0, nxt.lgL) & ~63;
    const int qlo = cur.P0 + wid * 32, qv = qlo + r32, qm = qv - 4 * hi;
    unsigned Wl = 0x40000000u; int wlow = 0;
    if constexpr (BANDED) { const int l1 = (qv & Lm) + 1; Wl = (unsigned)(l1 < 129 ? l1 : 129); wlow = qlo - 128; const int ss = qlo & ~Lm; if (wlow < ss) wlow = ss; }
    char* V_lds = lds; char* K_lds = lds + 2 * SHM;
    float* ws = (float*)(lds + WS_OFF) + wid * 64; float* li_l = ws; float* al_l = ws + 32;
    const float* tab = (const float*)(lds + TAB_OFF) + (256 - 59);
    float m_reg = -1e30f, l_reg = 0; f32x16 o[ND];
#pragma unroll
    for (int d_ = 0; d_ < ND; ++d_) o[d_] = f32x16{};
    STAGE_IDX();
    const int vb0 = (int)(uintptr_t)V_lds + v_rd_base(lane);
    const bf16_t* Kh = cur.K; const bf16_t* Vh = cur.V;
#define RESC(a) do { if (__any((a) < 1.f)) { if (hi == 0) al_l[r32] = (a); asm volatile("s_waitcnt lgkmcnt(0)" ::: "memory");              \
                     _Pragma("unroll") for (int d_ = 0; d_ < ND; ++d_) _Pragma("unroll") for (int r = 0; r < 16; ++r) o[d_][r] *= al_l[crow(r, hi)]; } } while (0)
#define KBASE(t) ((j_lo + (t)) * 64)
#define ACT(t) (KBASE(t) <= qlo + 31 && KBASE(t) + 63 >= wlow)
#define MASKT(P0_, P1_, t) do { const int kb_ = KBASE(t); if (!SK || ACT(t)) { BIAS_CALL(P0_, P1_, tab + (qm - kb_)); \
        if (BANDED || kb_ + 63 > qlo) mask_tile(P0_, P1_, qm - kb_, Wl); } } while (0)
#define SEAM_K0() do { VMWN(NQ); SWRITE_HK(0); SBAR(); } while (0)
    f32x16 pA0, pA1, pB0, pB1; float mnA, mnB, alA, alB; bf16x8 pa0, pa1, pa2, pa3;
    SWRITE_HV(0); SBAR();
    if (NT > 1) SLOAD_H(Kh, Vh, KBASE(1), dil, lgL);
    SBAR(); qkt<DH, 0, SK>(pA0, pA1, K_lds, r32, hi, S.qr, ACT(0));
    MASKT(pA0, pA1, 0); partialSM<DH>(pA0, pA1, m_reg, mnA, alA);
    if (NT > 1) { VMW(); SWRITE_H(1); }
    __syncthreads();
#define HALF_STEP(PX0, PX1, mnX, alX, PY0, PY1, alY, t, KB, VB, SB) do {                                                      \
        SBAR(); qkt<DH, KB, SK>(PX0, PX1, K_lds, r32, hi, S.qr, ACT(t));                                                        \
        finishSM(PY0, PY1, alY, l_reg, pa0, pa1, pa2, pa3); SBAR();                                                           \
        if ((t) + 1 < NT) { SLOAD_H(Kh, Vh, KBASE((t) + 1), dil, lgL); SBAR(); }                                              \
        pv_tile<DH, VB, SK>(o, vb0, pa0, pa1, pa2, pa3, ACT((t) - 1)); MASKT(PX0, PX1, (t)); partialSM<DH>(PX0, PX1, m_reg, mnX, alX); \
        __syncthreads();                                                                                                      \
        if ((t) + 1 < NT) { VMW(); SWRITE_H(SB); }                                                                            \
        RESC(alX); __syncthreads(); } while (0)
    for (int t = 1; t + 1 < NT; t += 2) {
        HALF_STEP(pB0, pB1, mnB, alB, pA0, pA1, alA, t, 1, 0, 0);
        HALF_STEP(pA0, pA1, mnA, alA, pB0, pB1, alB, t + 1, 0, 1, 1);
    }
    const bool even = (NT & 1) == 0;
    if (even) { SBAR(); qkt<DH, 1, SK>(pB0, pB1, K_lds, r32, hi, S.qr, ACT(NT - 1)); SBAR(); }
    SLOAD_H(nxt.K, nxt.V, kbn, nxt.dil, nxt.lgL); SBAR();
    { const bf16_t* qp = nxt.Q + TBASE(nxt.P0 + wid * 32, nxt.dil, nxt.lgL) + (unsigned)(r32 * (BANDED ? nxt.dil : 1) * LDZ + hi * 8);
#pragma unroll
      for (int d0 = 0; d0 < NQ; ++d0) S.qr[d0] = ld8(qp + d0 * 16); }
    SBAR();
    finishSM(pA0, pA1, alA, l_reg, pa0, pa1, pa2, pa3); SBAR();
    pv_tile<DH, 0, SK>(o, vb0, pa0, pa1, pa2, pa3, ACT(even ? NT - 2 : NT - 1));
    if (even) { MASKT(pB0, pB1, NT - 1); partialSM<DH>(pB0, pB1, m_reg, mnB, alB); __syncthreads(); RESC(alB);
        finishSM(pB0, pB1, alB, l_reg, pa0, pa1, pa2, pa3); SBAR(); pv_tile<DH, 1, SK>(o, vb0, pa0, pa1, pa2, pa3, ACT(NT - 1)); }
    SBAR(); SEAM_K0();
    if (hi == 0) li_l[r32] = l_reg; asm volatile("s_waitcnt lgkmcnt(0)" ::: "memory");
    float rli[16];
#pragma unroll
    for (int r = 0; r < 16; ++r) rli[r] = __builtin_amdgcn_rcpf(li_l[crow(r, hi)]);
    int lo_ = r32, hh_ = hi, ln_ = lane; asm volatile("" : "+v"(lo_), "+v"(hh_), "+v"(ln_));
    if constexpr (BANDED) {
        bf16_t* ob = cur.O + lo_;
#pragma unroll
        for (int r = 0; r < 16; ++r) { const int tokr = vrow_tok(qlo + (r & 3) + 8 * (r >> 2) + 4 * hh_, dil, lgL); bf16_t* op = ob + (size_t)tokr * cur.ldo;
            const float v0 = o[0][r] * rli[r], v1 = o[1][r] * rli[r]; const float n0 = __shfl_xor(v0, 1), n1 = __shfl_xor(v1, 1);
            if ((lo_ & 1) == 0) { *(unsigned*)(op) = cvtpk(v0, n0); *(unsigned*)(op + 32) = cvtpk(v1, n1); } }
        if (hh_ == 0) cur.lse[(size_t)vrow_tok(qlo + lo_, dil, lgL) * 24] = m_reg * SCALE + 0.6931471805599453f * __builtin_amdgcn_logf(l_reg);
    } else {
        float* sw = cur.scr + (size_t)(wid * 32) * DH + ln_;
        if (cur.mode == 0) {
#pragma unroll
            for (int r = 0; r < 16; ++r)
#pragma unroll
                for (int d0 = 0; d0 < ND; ++d0) sw[(r * ND + d0) * 64] = o[d0][r] * rli[r];
        } else {
            const float lam = cur.lam; bf16_t* ob = cur.O + (size_t)(qlo + 4 * hh_) * cur.ldo + lo_;
#pragma unroll
            for (int r = 0; r < 16; ++r) { bf16_t* op = ob + (size_t)((r & 3) + 8 * (r >> 2)) * cur.ldo;
                float v[ND], n[ND];
#pragma unroll
                for (int d0 = 0; d0 < ND; ++d0) { v[d0] = sw[(r * ND + d0) * 64] - lam * (o[d0][r] * rli[r]); n[d0] = __shfl_xor(v[d0], 1); }
                if ((lo_ & 1) == 0) {
#pragma unroll
                    for (int d0 = 0; d0 < ND; ++d0) *(unsigned*)(op + d0 * 32) = cvtpk(v[d0], n[d0]); }
                if (r & 1) asm volatile("" ::: "memory"); }
        }
    }
    __syncthreads();
#undef RESC
#undef KBASE
#undef ACT
#undef MASKT
#undef SEAM_K0
#undef HALF_STEP
}
#undef VMW
#undef VMWN
#undef TBASE
#undef LOFF
#undef SLOAD_H
#undef SWRITE_HK
#undef SWRITE_HV
#undef SWRITE_H
#undef STAGE_IDX
#undef SBAR
}
#define GAS __attribute__((address_space(1)))
#define LAS __attribute__((address_space(3)))
typedef unsigned short bf16;
typedef unsigned v4u __attribute__((ext_vector_type(4)));
typedef float f32x4 __attribute__((ext_vector_type(4)));
typedef short bf16x8 __attribute__((ext_vector_type(8)));
typedef GAS unsigned gu32;
typedef GAS unsigned long long gu64;
#define RLX_AGENT __ATOMIC_RELAXED, __HIP_MEMORY_SCOPE_AGENT
#define LDS_WAIT() asm volatile("s_waitcnt lgkmcnt(0)" ::: "memory")
#define VM_WAIT() asm volatile("s_waitcnt vmcnt(0)" ::: "memory")
__device__ __forceinline__ unsigned long long rt() { return __builtin_amdgcn_s_memrealtime(); }
__device__ __forceinline__ unsigned f2bf(float f) { unsigned u = __builtin_bit_cast(unsigned, f); return (u + 0x7fffu + ((u >> 16) & 1u)) >> 16; }
__device__ __forceinline__ unsigned pk2(float lo, float hi) { return f2bf(lo) | (f2bf(hi) << 16); }

#define XB_TMO      128
#define XB_XCNT(j)  (256  + 64 * (j))
#define XB_XSUB(j)  (1280 + 64 * (j))
#define XB_XGEN(j)  (2304 + 64 * (j))
#define XB_TOP      3328
#define XB_TOPGEN   3392
#define XCD_BAR_WORDS 3456
#define XB_SPIN_CAP (1u << 18)

__device__ __forceinline__ unsigned xb_ld(unsigned* p)              { return __hip_atomic_load(p, __ATOMIC_RELAXED, __HIP_MEMORY_SCOPE_AGENT); }
__device__ __forceinline__ unsigned xb_add(unsigned* p, unsigned v) { return __hip_atomic_fetch_add(p, v, __ATOMIC_RELAXED, __HIP_MEMORY_SCOPE_AGENT); }
__device__ __forceinline__ unsigned xb_xcc_id() { return (unsigned)__builtin_amdgcn_s_getreg((3 << 11) | 20) & 0xFu; }
#define XB_SPIN(cond, bar) do { unsigned _sp = 0; while (cond) { __builtin_amdgcn_s_sleep(1); \
    if ((++_sp & 255u) == 0u) { if (xb_ld(&(bar)[XB_TMO])) break; if (_sp > XB_SPIN_CAP) { atomicAdd(&(bar)[XB_TMO], 1u); break; } } } } while (0)

struct XcdBarrier {
    unsigned* bar; unsigned x;
    volatile LAS unsigned* st;
};

__device__ __forceinline__ XcdBarrier xcd_barrier_post(unsigned* bar, volatile LAS unsigned* st) {
    XcdBarrier b; b.bar = bar; b.x = xb_xcc_id(); b.st = st;
    if (threadIdx.x == 0) (void)xb_add(&bar[XB_XCNT(b.x)], 1u);
    return b;
}
__device__ __forceinline__ void xcd_barrier_complete(unsigned* bar, unsigned x, unsigned& nloc, unsigned& nx) {
    const unsigned G = gridDim.x * gridDim.y * gridDim.z;
    unsigned sum, cnt, mine, sp = 0u;
    for (;;) {
        sum = 0u; cnt = 0u; mine = 0u;
#pragma unroll
        for (unsigned j = 0; j < 16; ++j) { const unsigned c = xb_ld(&bar[XB_XCNT(j)]); sum += c; cnt += (c > 0u) ? 1u : 0u; mine = (j == x) ? c : mine; }
        if (sum == G) break;
        __builtin_amdgcn_s_sleep(1);
        if ((++sp & 255u) == 0u) { if (xb_ld(&bar[XB_TMO])) break; if (sp > XB_SPIN_CAP) { atomicAdd(&bar[XB_TMO], 1u); break; } }
    }
    nloc = mine > 0u ? mine : 1u; nx = cnt > 0u ? cnt : 1u;
}

__device__ __forceinline__ void xcd_barrier(const XcdBarrier& b) {
    asm volatile("s_waitcnt vmcnt(0)" ::: "memory");
    __syncthreads();
    if (threadIdx.x == 0) {
        unsigned* bar = b.bar;
        __builtin_amdgcn_s_waitcnt(0);
        unsigned nloc = b.st[0], nx = b.st[1];
        if (nloc == 0u) { xcd_barrier_complete(bar, b.x, nloc, nx); b.st[0] = nloc; b.st[1] = nx; }
        const unsigned old = xb_add(&bar[XB_XSUB(b.x)], 1u);
        const unsigned gen = old / nloc;
        if (old + 1u == (gen + 1u) * nloc) {
            __builtin_amdgcn_fence(__ATOMIC_RELEASE, "agent");
            asm volatile("s_waitcnt vmcnt(0)" ::: "memory");
            const unsigned og = xb_add(&bar[XB_TOP], 1u);
            const unsigned tg = og / nx;
            if (og + 1u == (tg + 1u) * nx) xb_add(&bar[XB_TOPGEN], 1u);
            else XB_SPIN(xb_ld(&bar[XB_TOPGEN]) == tg, bar);
            __builtin_amdgcn_fence(__ATOMIC_ACQUIRE, "agent");
            xb_add(&bar[XB_XGEN(b.x)], 1u);
            asm volatile("s_waitcnt vmcnt(0)" ::: "memory");
        } else {
            XB_SPIN(xb_ld(&bar[XB_XGEN(b.x)]) == gen, bar);
            __builtin_amdgcn_fence(__ATOMIC_ACQUIRE, "agent");
            asm volatile("s_waitcnt vmcnt(0)" ::: "memory");
        }
    }
    __syncthreads();
}


constexpr int NWAVES = 8;
#ifndef MK_N_LAUNCHES
#define MK_N_LAUNCHES 0
#endif
constexpr int NPH = 13;
constexpr int T = 32768, DM = 2048, SEQ = 2048, NZ = 10752, NCAT = 14848, PLED = 256, NEXP = 32, DE = 1024, MAXROWS = 2 * T + NEXP * 256;
constexpr size_t MiB = 1u << 20;
constexpr size_t WS_CTL = 0, CTL_ZERO_BYTES = 1 * MiB;
constexpr size_t WS_TAB = 1 * MiB, WS_LAM = WS_TAB + 512 * 1024;
constexpr size_t WS_TOKE = 2 * MiB, WS_TOKW = WS_TOKE + 256 * 1024, WS_ROWT = WS_TOKE + 512 * 1024, WS_ROWW = WS_TOKE + 832 * 1024, WS_TILE = WS_TOKE + 1152 * 1024;
constexpr size_t WS_WCAT = 4 * MiB, WS_PA = 62 * MiB, WS_PB = 70 * MiB, WS_WOUT = 72 * MiB, WS_WPG = 80 * MiB, WS_WPP = 88 * MiB;
constexpr size_t WS_PBF = 90 * MiB;
constexpr size_t WS_R1 = 106 * MiB;
constexpr size_t WS_R2 = 234 * MiB;
constexpr size_t WS_OG = WS_R2, WS_LSE = WS_R2 + 96 * MiB, WS_SCRA = WS_R2 + 100 * MiB, WS_HDN = WS_R2;
constexpr size_t WS_R3 = 378 * MiB;
constexpr size_t WS_OA = WS_R3, WS_OB = WS_R3 + 128 * MiB;
constexpr size_t WS_Z = 538 * MiB;
constexpr size_t WS_WE13 = WS_Z, WS_WE2 = WS_Z + 256 * MiB, WS_SP = WS_Z + 384 * MiB;
constexpr size_t WS_END = 1210 * MiB;
constexpr int CW_BAR = 4096, CW_CNT = 16384, CW_CUR = 16384 + 64;
constexpr int RING_OFF = 0, RING_BYTES = 131072, LDSCTL_OFF = RING_BYTES, MISC_OFF = LDSCTL_OFF + 320, LDS_BYTES = 147456;
static_assert(att::ATT_LDS <= RING_BYTES, "attention LDS");

struct Frame { LAS unsigned char* lds; volatile LAS unsigned* MISC; gu32* ctl; int tid, lane, wave, vcu, G; };

__device__ __forceinline__ float wave_sum(float v) {
#pragma unroll
    for (int o = 1; o < 64; o <<= 1) v += __shfl_xor(v, o);
    return v;
}
__device__ __forceinline__ float dot4(f32x4 a, f32x4 b) { return (a.x * b.x + a.y * b.y) + (a.z * b.z + a.w * b.w); }
__device__ __forceinline__ void transpose_item(const float* W, int ldw, int k0, int n0, bf16* WT, int ldt, size_t orow, LAS float* scr, int lane) {
#pragma unroll 8
    for (int i = 0; i < 32; ++i) { const int kk = 2 * i + (lane >> 5); scr[kk * 33 + (lane & 31)] = W[(size_t)(k0 + kk) * ldw + n0 + (lane & 31)]; }
    LDS_WAIT(); asm volatile("" ::: "memory");
    const int c = lane & 7;
#pragma unroll
    for (int j = 0; j < 4; ++j) { const int n = (lane >> 3) + 8 * j; const LAS float* s = scr + (8 * c) * 33 + n;
        v4u o; o.x = pk2(s[0 * 33], s[1 * 33]); o.y = pk2(s[2 * 33], s[3 * 33]); o.z = pk2(s[4 * 33], s[5 * 33]); o.w = pk2(s[6 * 33], s[7 * 33]);
        *(GAS v4u*)(WT + (orow + n) * ldt + k0 + 8 * c) = o; }
    LDS_WAIT(); asm volatile("" ::: "memory");
}
__device__ __forceinline__ void transpose_mat(const float* W, int K, int N, bf16* WT, size_t row_off, int item, LAS float* scr, int lane) {
    const int nblk = N / 32, kb = item / nblk, nb = item % nblk;
    transpose_item(W, N, 64 * kb, 32 * nb, WT, K, row_off + 32 * nb, scr, lane);
}
__device__ __forceinline__ void rms_row_bf16(const float* xrow, const f32x4 (&g)[8], bf16* orow, float eps, int lane) {
    const GAS f32x4* xr = (const GAS f32x4*)xrow + lane;
    f32x4 v[8]; float s = 0.f;
#pragma unroll
    for (int j = 0; j < 8; ++j) { v[j] = xr[64 * j]; s += dot4(v[j], v[j]); }
    const float r = 1.0f / sqrtf(wave_sum(s) * (1.f / 2048.f) + eps);
    GAS unsigned long long* o8 = (GAS unsigned long long*)orow + lane;
#pragma unroll
    for (int j = 0; j < 8; ++j) { const f32x4 y = v[j] * r * g[j]; o8[64 * j] = (unsigned long long)pk2(y.x, y.y) | ((unsigned long long)pk2(y.z, y.w) << 32); }
}
__device__ __forceinline__ int t5_bucket(int d) {
    if (d < 16) return d;
    return 16 + (d >= 22) + (d >= 30) + (d >= 40) + (d >= 54) + (d >= 73) + (d >= 99) + (d >= 134) + (d >= 182) + (d >= 246) + (d >= 332) + (d >= 450) + (d >= 609) + (d >= 825) + (d >= 1117) + (d >= 1513);
}

struct Args { const float* in[24]; float* out; unsigned char* ws; int ph_lo, ph_hi; };
enum { I_X = 0, I_P, I_RELB, I_NMIXG, I_WIN, I_WGATE, I_LQ1, I_LK1, I_LQ2, I_LK2, I_SUBLN, I_WPA, I_WPB, I_WOUT, I_NFFNG, I_WCOARSE, I_WFINE, I_W1, I_W3, I_W2, I_NPLEG, I_WPLEG, I_WPLEP, I_FNG };

__device__ __forceinline__ void p0_prologue(Frame& F, const Args& a) {
    unsigned char* ws = a.ws;
    LAS float* scr = (LAS float*)(F.lds + RING_OFF + F.wave * 16384);
    const int gw = F.vcu * NWAVES + F.wave, NGW = F.G * NWAVES;
    constexpr int I_IN = 32 * (NZ / 32), I_G = 32 * (4096 / 32), I_PA = 32 * 64, I_PB = 8 * 64, I_OUT = 32 * 64, I_PG = 32 * 64, I_PP = 4 * 64;
    constexpr int NITEMS = I_IN + I_G + I_PA + I_PB + I_OUT + I_PG + I_PP;
    for (int it = gw; it < NITEMS; it += NGW) {
        int r = it;
        if (r < I_IN) { transpose_mat(a.in[I_WIN], DM, NZ, (bf16*)(ws + WS_WCAT), 0, r, scr, F.lane); continue; } r -= I_IN;
        if (r < I_G) { transpose_mat(a.in[I_WGATE], DM, 4096, (bf16*)(ws + WS_WCAT), NZ, r, scr, F.lane); continue; } r -= I_G;
        if (r < I_PA) { transpose_mat(a.in[I_WPA], DM, DM, (bf16*)(ws + WS_PA), 0, r, scr, F.lane); continue; } r -= I_PA;
        if (r < I_PB) { transpose_mat(a.in[I_WPB], 512, DM, (bf16*)(ws + WS_PB), 0, r, scr, F.lane); continue; } r -= I_PB;
        if (r < I_OUT) { transpose_mat(a.in[I_WOUT], DM, DM, (bf16*)(ws + WS_WOUT), 0, r, scr, F.lane); continue; } r -= I_OUT;
        if (r < I_PG) { transpose_mat(a.in[I_WPLEG], DM, DM, (bf16*)(ws + WS_WPG), 0, r, scr, F.lane); continue; } r -= I_PG;
        transpose_mat(a.in[I_WPLEP], PLED, DM, (bf16*)(ws + WS_WPP), 0, r, scr, F.lane);
    }
    { f32x4 g[8];
#pragma unroll
      for (int j = 0; j < 8; ++j) g[j] = ((const f32x4*)a.in[I_NMIXG])[F.lane + 64 * j];
      for (int m = gw; m < T; m += NGW) rms_row_bf16(a.in[I_X] + (size_t)m * DM, g, (bf16*)(ws + WS_R1) + (size_t)m * DM, 1e-6f, F.lane); }
    { const f32x4* p4 = (const f32x4*)a.in[I_P]; v4u* o = (v4u*)(ws + WS_PBF); const size_t n8 = (size_t)T * PLED / 8;
      for (size_t i = (size_t)gw * 64 + F.lane; i < n8; i += (size_t)NGW * 64) { const f32x4 u0 = p4[2 * i], u1 = p4[2 * i + 1]; v4u w; w.x = pk2(u0.x, u0.y); w.y = pk2(u0.z, u0.w); w.z = pk2(u1.x, u1.y); w.w = pk2(u1.z, u1.w); o[i] = w; } }
    { float* tabs = (float*)(ws + WS_TAB); const float* rb = a.in[I_RELB];
      for (int e = (F.vcu * NWAVES * 64) + F.tid; e < 32 * att::TAB_N; e += F.G * NWAVES * 64) {
          const int head = e / att::TAB_N, d = e % att::TAB_N - 256; float v = 0.f;
          if (head < 8) { if (d >= 0 && d < 2048) v = rb[t5_bucket(d) * 32 + head] * 11.313708498984761f; }
          else { const int g = (head - 8) >> 3, dil = g == 0 ? 1 : (g == 1 ? 4 : 16); if (d >= 0 && d <= 128) v = rb[t5_bucket(d * dil) * 32 + head] * 8.0f; }
          tabs[e] = v; } }
    if (F.vcu == 0 && F.wave == 0) {
        const float* q1 = a.in[I_LQ1]; const float* k1 = a.in[I_LK1]; const float* q2 = a.in[I_LQ2]; const float* k2 = a.in[I_LK2];
        const float s1 = wave_sum(q1[F.lane] * k1[F.lane] + q1[F.lane + 64] * k1[F.lane + 64]), s2 = wave_sum(q2[F.lane] * k2[F.lane] + q2[F.lane + 64] * k2[F.lane + 64]);
        if (F.lane == 0) *(float*)(ws + WS_LAM) = expf(s1) - expf(s2) + 0.2f;
    }
}
__device__ __forceinline__ void p3_post_attn(Frame& F, const Args& a) {
    unsigned char* ws = a.ws;
    const int gw = F.vcu * NWAVES + F.wave, NGW = F.G * NWAVES, lane = F.lane;
    const bf16* Cb = (const bf16*)(ws + WS_R1); const bf16* OG = (const bf16*)(ws + WS_OG); const float* LSE = (const float*)(ws + WS_LSE);
    bf16* OA = (bf16*)(ws + WS_OA); bf16* OB = (bf16*)(ws + WS_OB);
    const f32x4 ga = ((const f32x4*)a.in[I_SUBLN])[2 * (lane & 31)], gb = ((const f32x4*)a.in[I_SUBLN])[2 * (lane & 31) + 1];
    for (int row = gw; row < T; row += NGW) {
        const v4u* cp = (const v4u*)(Cb + (size_t)row * DM); v4u* op = (v4u*)(OA + (size_t)row * DM);
        v4u w[4];
#pragma unroll
        for (int j = 0; j < 4; ++j) w[j] = cp[lane + 64 * j];
#pragma unroll
        for (int j = 0; j < 4; ++j) { const pg8::F8 v = pg8::unpk8(w[j]); float s = dot4(v.a, v.a) + dot4(v.b, v.b);
            s += __shfl_xor(s, 1); s += __shfl_xor(s, 2); s += __shfl_xor(s, 4); s += __shfl_xor(s, 8); s += __shfl_xor(s, 16);
            const float r = 0.8f / sqrtf(s * (1.f / 256.f) + 1e-5f);
            op[lane + 64 * j] = pg8::pk8(v.a * r * ga, v.b * r * gb); }
        const int hh = lane >> 3; const float l0 = LSE[(size_t)row * 24 + hh], l1 = LSE[(size_t)row * 24 + 8 + hh], l2 = LSE[(size_t)row * 24 + 16 + hh];
        const float mx = fmaxf(l0, fmaxf(l1, l2)); const float e0 = __expf(l0 - mx), e1 = __expf(l1 - mx), e2 = __expf(l2 - mx); const float inv = 1.f / (e0 + e1 + e2);
        const v4u* gp = (const v4u*)(OG + (size_t)row * 1536);
        const pg8::F8 o0 = pg8::unpk8(gp[lane]), o1 = pg8::unpk8(gp[64 + lane]), o2 = pg8::unpk8(gp[128 + lane]);
        const float a0 = e0 * inv, a1 = e1 * inv, a2 = e2 * inv;
        ((v4u*)(OB + (size_t)row * 512))[lane] = pg8::pk8(o0.a * a0 + o1.a * a1 + o2.a * a2, o0.b * a0 + o1.b * a1 + o2.b * a2);
    }
    LAS float* scr = (LAS float*)(F.lds + RING_OFF + F.wave * 16384);
    for (int it = gw; it < NEXP * 3072; it += NGW) {
        const int e = it / 3072, r = it % 3072;
        if (r < 2048) { const int rr = r & 1023, kb = rr >> 5, nb = rr & 31, n0 = 32 * nb;
            const float* W = (r < 1024 ? a.in[I_W1] : a.in[I_W3]) + (size_t)e * DM * DE;
            transpose_item(W, DE, 64 * kb, n0, (bf16*)(ws + WS_WE13), DM, (size_t)e * 2048 + (n0 >> 7) * 256 + (n0 & 127) + (r < 1024 ? 0 : 128), scr, lane); }
        else { const int rr = r - 2048, kb = rr >> 6, nb = rr & 63;
            transpose_item(a.in[I_W2] + (size_t)e * DE * DM, DM, 64 * kb, 32 * nb, (bf16*)(ws + WS_WE2), DE, (size_t)e * 2048 + 32 * nb, scr, lane); }
    }
}
__device__ __forceinline__ void p6_route(Frame& F, const Args& a) {
    unsigned char* ws = a.ws;
    const int gw = F.vcu * NWAVES + F.wave, NGW = F.G * NWAVES, lane = F.lane;
    f32x4 g[8];
#pragma unroll
    for (int j = 0; j < 8; ++j) g[j] = ((const f32x4*)a.in[I_NFFNG])[lane + 64 * j];
    const f32x4* wc4 = (const f32x4*)a.in[I_WCOARSE];
    int* toke = (int*)(ws + WS_TOKE); float* tokw = (float*)(ws + WS_TOKW); unsigned* cnt = (unsigned*)(F.ctl + CW_CNT);
    for (int m = gw; m < T; m += NGW) {
        const GAS f32x4* xr = (const GAS f32x4*)(a.out + (size_t)m * DM) + lane;
        f32x4 h[8]; float s = 0.f;
#pragma unroll
        for (int j = 0; j < 8; ++j) { h[j] = xr[64 * j]; s += dot4(h[j], h[j]); }
        const float r = 1.0f / sqrtf(wave_sum(s) * (1.f / 2048.f) + 1e-6f);
        GAS unsigned long long* o8 = (GAS unsigned long long*)((bf16*)(ws + WS_R1) + (size_t)m * DM) + lane;
        f32x4 ca = {0.f, 0.f, 0.f, 0.f};
#pragma unroll
        for (int j = 0; j < 8; ++j) { h[j] = h[j] * r * g[j]; o8[64 * j] = (unsigned long long)pk2(h[j].x, h[j].y) | ((unsigned long long)pk2(h[j].z, h[j].w) << 32);
            const f32x4* wk = wc4 + 4 * (lane + 64 * j);
            ca += wk[0] * h[j].x; ca += wk[1] * h[j].y; ca += wk[2] * h[j].z; ca += wk[3] * h[j].w; }
        const float c0 = wave_sum(ca.x), c1 = wave_sum(ca.y), c2 = wave_sum(ca.z), c3 = wave_sum(ca.w);
        float cm = c0; int gs = 0; if (c1 > cm) { cm = c1; gs = 1; } if (c2 > cm) { cm = c2; gs = 2; } if (c3 > cm) { cm = c3; gs = 3; }
        gs = __builtin_amdgcn_readfirstlane(gs);
        const float pg = 1.0f / (expf(c0 - cm) + expf(c1 - cm) + expf(c2 - cm) + expf(c3 - cm));
        const f32x4* wf4 = (const f32x4*)(a.in[I_WFINE] + (size_t)gs * DM * 8);
        f32x4 fa = {0.f, 0.f, 0.f, 0.f}, fb = {0.f, 0.f, 0.f, 0.f};
#pragma unroll
        for (int j = 0; j < 8; ++j) { const f32x4* wk = wf4 + 8 * (lane + 64 * j);
            fa += wk[0] * h[j].x; fb += wk[1] * h[j].x; fa += wk[2] * h[j].y; fb += wk[3] * h[j].y; fa += wk[4] * h[j].z; fb += wk[5] * h[j].z; fa += wk[6] * h[j].w; fb += wk[7] * h[j].w; }
        const float f0 = wave_sum(fa.x), f1 = wave_sum(fa.y), f2 = wave_sum(fa.z), f3 = wave_sum(fa.w), f4 = wave_sum(fb.x), f5 = wave_sum(fb.y), f6 = wave_sum(fb.z), f7 = wave_sum(fb.w);
        float v0 = f0; int i0 = 0;
        if (f1 > v0) { v0 = f1; i0 = 1; } if (f2 > v0) { v0 = f2; i0 = 2; } if (f3 > v0) { v0 = f3; i0 = 3; } if (f4 > v0) { v0 = f4; i0 = 4; } if (f5 > v0) { v0 = f5; i0 = 5; } if (f6 > v0) { v0 = f6; i0 = 6; } if (f7 > v0) { v0 = f7; i0 = 7; }
        float v1 = -3.0e38f; int i1 = 0;
        if (i0 != 0 && f0 > v1) { v1 = f0; i1 = 0; } if (i0 != 1 && f1 > v1) { v1 = f1; i1 = 1; } if (i0 != 2 && f2 > v1) { v1 = f2; i1 = 2; } if (i0 != 3 && f3 > v1) { v1 = f3; i1 = 3; }
        if (i0 != 4 && f4 > v1) { v1 = f4; i1 = 4; } if (i0 != 5 && f5 > v1) { v1 = f5; i1 = 5; } if (i0 != 6 && f6 > v1) { v1 = f6; i1 = 6; } if (i0 != 7 && f7 > v1) { v1 = f7; i1 = 7; }
        const float ee = expf(v1 - v0), w0 = pg / (1.f + ee), w1 = pg * ee / (1.f + ee);
        if (lane == 0) { const int e0 = gs * 8 + i0, e1 = gs * 8 + i1; toke[2 * m] = e0; toke[2 * m + 1] = e1; tokw[2 * m] = w0; tokw[2 * m + 1] = w1;
            __hip_atomic_fetch_add(cnt + e0, 1u, RLX_AGENT); __hip_atomic_fetch_add(cnt + e1, 1u, RLX_AGENT); }
    }
}
__device__ __forceinline__ void p7_sort(Frame& F, const Args& a) {
    unsigned char* ws = a.ws;
    const int gw = F.vcu * NWAVES + F.wave, NGW = F.G * NWAVES, lane = F.lane;
    LAS int* ps = (LAS int*)(F.lds + RING_OFF); LAS int* pc = ps + 32; LAS int* cn = ps + 64;
    unsigned* cnt = (unsigned*)(F.ctl + CW_CNT); unsigned* cur = (unsigned*)(F.ctl + CW_CUR);
    int* tile_e = (int*)(ws + WS_TILE); int* rowt = (int*)(ws + WS_ROWT); float* roww = (float*)(ws + WS_ROWW);
    const int* toke = (const int*)(ws + WS_TOKE); const float* tokw = (const float*)(ws + WS_TOKW);
    const bf16* H2 = (const bf16*)(ws + WS_R1); bf16* XIN = (bf16*)(ws + WS_SP);
    if (F.tid == 0) { int acc = 0;
        for (int e = 0; e < NEXP; ++e) { const int c = (int)__hip_atomic_load(cnt + e, RLX_AGENT); const int p = (c + 255) & ~255; cn[e] = c; ps[e] = acc; pc[e] = p;
            if (blockIdx.x == 0) for (int t = acc >> 8; t < (acc + p) >> 8; ++t) tile_e[t] = e;
            acc += p; }
        if (blockIdx.x == 0) tile_e[511] = acc >> 8; }
    __syncthreads();
    for (int m = gw; m < T; m += NGW) {
        int p0 = 0, p1 = 0;
        if (lane == 0) { const int e0 = toke[2 * m], e1 = toke[2 * m + 1];
            p0 = ps[e0] + (int)__hip_atomic_fetch_add(cur + e0, 1u, RLX_AGENT); p1 = ps[e1] + (int)__hip_atomic_fetch_add(cur + e1, 1u, RLX_AGENT);
            rowt[p0] = m; rowt[p1] = m; roww[p0] = tokw[2 * m]; roww[p1] = tokw[2 * m + 1]; }
        p0 = __builtin_amdgcn_readfirstlane(p0); p1 = __builtin_amdgcn_readfirstlane(p1);
        const v4u* src = (const v4u*)(H2 + (size_t)m * DM); v4u* d0 = (v4u*)(XIN + (size_t)p0 * DM); v4u* d1 = (v4u*)(XIN + (size_t)p1 * DM);
#pragma unroll
        for (int j = 0; j < 4; ++j) { const v4u v = src[lane + 64 * j]; d0[lane + 64 * j] = v; d1[lane + 64 * j] = v; }
    }
    if (blockIdx.x < NEXP) { const int e = blockIdx.x;
        for (int rr = ps[e] + cn[e] + F.wave; rr < ps[e] + pc[e]; rr += NWAVES) {
            if (lane == 0) { rowt[rr] = -1; roww[rr] = 0.f; }
            v4u* d = (v4u*)(XIN + (size_t)rr * DM); const v4u z = {0u, 0u, 0u, 0u};
#pragma unroll
            for (int j = 0; j < 4; ++j) d[lane + 64 * j] = z; } }
    __syncthreads();
}
__device__ __forceinline__ void p12_final(Frame& F, const Args& a) {
    const int gw = F.vcu * NWAVES + F.wave, NGW = F.G * NWAVES, lane = F.lane;
    f32x4 g[8];
#pragma unroll
    for (int j = 0; j < 8; ++j) g[j] = ((const f32x4*)a.in[I_FNG])[lane + 64 * j];
    for (int m = gw; m < T; m += NGW) {
        GAS f32x4* xr = (GAS f32x4*)(a.out + (size_t)m * DM) + lane;
        f32x4 v[8]; float s = 0.f;
#pragma unroll
        for (int j = 0; j < 8; ++j) { v[j] = xr[64 * j]; s += dot4(v[j], v[j]); }
        const float r = 1.0f / sqrtf(wave_sum(s) * (1.f / 2048.f) + 1e-6f);
#pragma unroll
        for (int j = 0; j < 8; ++j) xr[64 * j] = v[j] * r * g[j];
    }
}
__device__ __forceinline__ att::BlockRef ref_a(const Args& a, int vcu, int bi, float lam) {
    const int u = vcu * 4 + (bi >> 2), k = bi & 3, bh = u >> 3, b = bh >> 3, h = bh & 7, sub = u & 7, vh = sub >> 2, y = sub & 3;
    const int qb = (k < 2) ? y : 7 - y, map = k & 1;
    const att::bf16_t* Z = (const att::bf16_t*)(a.ws + WS_Z) + (size_t)b * SEQ * NZ;
    att::BlockRef r;
    r.Q = Z + h * 256 + map * 128; r.K = Z + 2048 + h * 256 + map * 128; r.V = Z + 4096 + h * 256 + vh * 128;
    r.scr = (float*)(a.ws + WS_SCRA) + (size_t)blockIdx.x * 256 * 128;
    r.O = (att::bf16_t*)(a.ws + WS_R1) + (size_t)b * SEQ * DM + h * 256 + vh * 128; r.lse = nullptr;
    r.P0 = qb * 256; r.dil = 1; r.lgL = 11; r.mode = map; r.ldo = DM; r.head = h; r.lam = lam;
    return r;
}
__device__ __forceinline__ att::BlockRef ref_b(const Args& a, int vcu, int bi) {
    const int u = vcu * 12 + bi, qb = u & 7, bgh = u >> 3, hh = bgh & 7, bg = bgh >> 3, g = bg % 3, b = bg / 3;
    const att::bf16_t* Z = (const att::bf16_t*)(a.ws + WS_Z) + (size_t)b * SEQ * NZ;
    att::BlockRef r;
    r.Q = Z + 6144 + g * 512 + hh * 64; r.K = Z + 7680 + g * 512 + hh * 64; r.V = Z + 9216 + g * 512 + hh * 64;
    r.scr = nullptr; r.O = (att::bf16_t*)(a.ws + WS_OG) + (size_t)b * SEQ * 1536 + g * 512 + hh * 64; r.lse = (float*)(a.ws + WS_LSE) + (size_t)b * SEQ * 24 + g * 8 + hh;
    r.P0 = qb * 256; r.dil = g == 0 ? 1 : (g == 1 ? 4 : 16); r.lgL = g == 0 ? 11 : (g == 1 ? 9 : 7); r.mode = 2; r.ldo = 1536; r.head = 8 + g * 8 + hh; r.lam = 0.f;
    return r;
}
__device__ __forceinline__ void fill_tab(const Args& a, char* lds, int head, int tid) {
    const float* src = (const float*)(a.ws + WS_TAB) + (size_t)head * att::TAB_N; float* dst = (float*)(lds + att::TAB_OFF);
    for (int i = tid; i < att::TAB_N; i += NWAVES * 64) dst[i] = src[i];
}

__global__ void __launch_bounds__(NWAVES * 64, 2) mk_fwd(Args args) {
    extern __shared__ __attribute__((aligned(16))) unsigned char lds[];
    Frame F;
    F.lds = (LAS unsigned char*)lds;
    F.MISC = (volatile LAS unsigned*)(F.lds + MISC_OFF);
    F.tid = threadIdx.x; F.lane = F.tid & 63; F.wave = __builtin_amdgcn_readfirstlane(F.tid >> 6);
    F.G = gridDim.x; { const int bx = blockIdx.x; F.vcu = (F.G % 8 == 0) ? (bx % 8) * (F.G / 8) + bx / 8 : bx; }
    unsigned char* ws = args.ws;
    F.ctl = (gu32*)(ws + WS_CTL);
    for (int u = F.tid; u < (LDS_BYTES - LDSCTL_OFF) / 4; u += NWAVES * 64) ((LAS unsigned*)(F.lds + LDSCTL_OFF))[u] = 0u;
    __syncthreads();
    XcdBarrier bar; bar.bar = (unsigned*)(F.ctl + CW_BAR); bar.x = 0; bar.st = nullptr;
    if (MK_N_LAUNCHES == 1) bar = xcd_barrier_post((unsigned*)(F.ctl + CW_BAR), F.MISC + 8);
    const int lo = args.ph_lo, hi = args.ph_hi;
#ifndef PHMASK
#define PHMASK 0x1fff
#endif
#define IN(k) (((PHMASK >> (k)) & 1) && lo <= (k) && (k) < hi)
#define SEAM(k) do { if (IN(k) && IN((k) + 1)) xcd_barrier(bar); } while (0)
    const int G = F.G, bx = (int)blockIdx.x;

    if (IN(0)) { F.tid = pg8::fresh_tid(F.wave); F.lane = F.tid & 63; p0_prologue(F, args); SEAM(0); }

    if (IN(1)) {
        pg8::Gemm g{(const pg8::bf16_t*)(ws + WS_R1), (const pg8::bf16_t*)(ws + WS_WCAT), T, NCAT, DM}; pg8::StaticOrder S; S.init(T, NCAT, G, bx);
        pg8::EpiZG E{(pg8::bf16_t*)(ws + WS_Z), (pg8::bf16_t*)args.out};
        pg8::gemm_phase<pg8::EpiZG, pg8::StaticOrder, true, true>(F.lds + RING_OFF, g, S, E, F.wave);
        SEAM(1);
    }
    if (IN(2)) {
        char* al = (char*)lds + RING_OFF;
        const float lam = *(const float*)(ws + WS_LAM);
        if (G == 256) {
#ifndef NO_ATT_A
            { const int ta = pg8::fresh_tid(F.wave); att::Seam<128> S; att::BlockRef cur = ref_a(args, F.vcu, 0, lam);
              fill_tab(args, al, cur.head, ta); __syncthreads();
              att::attn_prime<128, false>(cur, al, S, ta);
              for (int bi = 0; bi < 16; ++bi) { const att::BlockRef nxt = (bi + 1 < 16) ? ref_a(args, F.vcu, bi + 1, lam) : cur;
                  att::attn_block<128, false>(cur, nxt, al, S, ta); cur = nxt; } }
#endif
            __syncthreads();
#ifndef NO_ATT_B
            { const int tb = pg8::fresh_tid(F.wave);
              att::Seam<64> S; att::BlockRef cur = ref_b(args, F.vcu, 0); int head = cur.head;
              fill_tab(args, al, head, tb); __syncthreads();
              att::attn_prime<64, true>(cur, al, S, tb);
              for (int bi = 0; bi < 12; ++bi) { const att::BlockRef nxt = (bi + 1 < 12) ? ref_b(args, F.vcu, bi + 1) : cur;
                  att::attn_block<64, true>(cur, nxt, al, S, tb);
                  if (nxt.head != head) { head = nxt.head; fill_tab(args, al, head, tb); __syncthreads(); }
                  cur = nxt; } }
#endif
        }
        SEAM(2);
    }
    if (IN(3)) { F.tid = pg8::fresh_tid(F.wave); F.lane = F.tid & 63; p3_post_attn(F, args); SEAM(3); }
    if (IN(4)) {
        { pg8::Gemm g{(const pg8::bf16_t*)(ws + WS_OA), (const pg8::bf16_t*)(ws + WS_PA), T, DM, DM}; pg8::StaticOrder S; S.init(T, DM, G, bx);
          pg8::EpiGateA E{(const pg8::bf16_t*)args.out, (float*)(ws + WS_SP)};
          pg8::gemm_phase<pg8::EpiGateA, pg8::StaticOrder, true, true>(F.lds + RING_OFF, g, S, E, F.wave); }
        { pg8::Gemm g{(const pg8::bf16_t*)(ws + WS_OB), (const pg8::bf16_t*)(ws + WS_PB), T, DM, 512}; pg8::StaticOrder S; S.init(T, DM, G, bx);
          pg8::EpiMerge E{(const pg8::bf16_t*)args.out, (const float*)(ws + WS_SP), (pg8::bf16_t*)(ws + WS_R1)};
          pg8::gemm_phase<pg8::EpiMerge, pg8::StaticOrder, true, true>(F.lds + RING_OFF, g, S, E, F.wave); }
        SEAM(4);
    }
    if (IN(5)) {
        pg8::Gemm g{(const pg8::bf16_t*)(ws + WS_R1), (const pg8::bf16_t*)(ws + WS_WOUT), T, DM, DM}; pg8::StaticOrder S; S.init(T, DM, G, bx);
        pg8::EpiRes E{args.in[I_X], args.out};
        pg8::gemm_phase<pg8::EpiRes, pg8::StaticOrder, true, true>(F.lds + RING_OFF, g, S, E, F.wave);
        SEAM(5);
    }
    if (IN(6)) { F.tid = pg8::fresh_tid(F.wave); F.lane = F.tid & 63; p6_route(F, args); SEAM(6); }
    if (IN(7)) { F.tid = pg8::fresh_tid(F.wave); F.lane = F.tid & 63; p7_sort(F, args); SEAM(7); }
    if (IN(8)) {
        const int nt = __builtin_amdgcn_readfirstlane(__hip_atomic_load((const int*)(ws + WS_TILE) + 511, RLX_AGENT));
        pg8::Gemm g{(const pg8::bf16_t*)(ws + WS_SP), (const pg8::bf16_t*)(ws + WS_WE13), nt * 256, 2048, DM}; pg8::MoeOrder S{(const int*)(ws + WS_TILE), nt * 8, G, bx};
        pg8::EpiSwiGLU E{(pg8::bf16_t*)(ws + WS_HDN)};
        pg8::gemm_phase<pg8::EpiSwiGLU, pg8::MoeOrder, true, true>(F.lds + RING_OFF, g, S, E, F.wave);
        SEAM(8);
    }
    if (IN(9)) {
        const int nt = __builtin_amdgcn_readfirstlane(__hip_atomic_load((const int*)(ws + WS_TILE) + 511, RLX_AGENT));
        pg8::Gemm g{(const pg8::bf16_t*)(ws + WS_HDN), (const pg8::bf16_t*)(ws + WS_WE2), nt * 256, 2048, DE}; pg8::MoeOrder S{(const int*)(ws + WS_TILE), nt * 8, G, bx};
        pg8::EpiScatter E{(const int*)(ws + WS_ROWT), (const float*)(ws + WS_ROWW), args.out};
        pg8::gemm_phase<pg8::EpiScatter, pg8::MoeOrder, true, true>(F.lds + RING_OFF, g, S, E, F.wave);
        SEAM(9);
    }
    if (IN(10)) {
        F.tid = pg8::fresh_tid(F.wave); F.lane = F.tid & 63;
        const int gw = F.vcu * NWAVES + F.wave, NGW = G * NWAVES; f32x4 gg[8];
#pragma unroll
        for (int j = 0; j < 8; ++j) gg[j] = ((const f32x4*)args.in[I_NPLEG])[F.lane + 64 * j];
        for (int m = gw; m < T; m += NGW) rms_row_bf16(args.out + (size_t)m * DM, gg, (bf16*)(ws + WS_R1) + (size_t)m * DM, 1e-6f, F.lane);
        SEAM(10);
    }
    if (IN(11)) {
        { pg8::Gemm g{(const pg8::bf16_t*)(ws + WS_PBF), (const pg8::bf16_t*)(ws + WS_WPP), T, DM, PLED}; pg8::StaticOrder S; S.init(T, DM, G, bx);
          pg8::EpiF32 E{(float*)(ws + WS_SP)};
          pg8::gemm_phase<pg8::EpiF32, pg8::StaticOrder, true, true>(F.lds + RING_OFF, g, S, E, F.wave); }
        { pg8::Gemm g{(const pg8::bf16_t*)(ws + WS_R1), (const pg8::bf16_t*)(ws + WS_WPG), T, DM, DM}; pg8::StaticOrder S; S.init(T, DM, G, bx);
          pg8::EpiPle E{(const float*)(ws + WS_SP), args.out};
          pg8::gemm_phase<pg8::EpiPle, pg8::StaticOrder, true, true>(F.lds + RING_OFF, g, S, E, F.wave); }
        SEAM(11);
    }
    if (IN(12)) { F.tid = pg8::fresh_tid(F.wave); F.lane = F.tid & 63; p12_final(F, args); }
#undef IN
#undef SEAM
}

extern "C" void kernel_launch(void* const* d_in, const int* in_sizes, int n_in, void* d_out, int out_size, void* d_ws, size_t ws_size, hipStream_t stream) {
    static int grid = 0;
    if (grid == 0) {
        if (n_in != 24 || out_size != T * DM || ws_size < WS_END) { fprintf(stderr, "kernel_launch: unexpected shapes (n_in %d, out %d, ws %zu)\n", n_in, out_size, ws_size); grid = -1; return; }
        int dev = 0, cus = 0, per_cu = 0;
        if (hipGetDevice(&dev) != hipSuccess || hipDeviceGetAttribute(&cus, hipDeviceAttributeMultiprocessorCount, dev) != hipSuccess) { grid = -1; return; }
        if (hipFuncSetAttribute((const void*)mk_fwd, hipFuncAttributeMaxDynamicSharedMemorySize, LDS_BYTES) != hipSuccess) { fprintf(stderr, "kernel_launch: hipFuncSetAttribute failed\n"); grid = -1; return; }
        if (hipOccupancyMaxActiveBlocksPerMultiprocessor(&per_cu, (const void*)mk_fwd, NWAVES * 64, LDS_BYTES) != hipSuccess || per_cu < 1) fprintf(stderr, "kernel_launch: occupancy query reports %d\n", per_cu);
        (void)hipGetLastError();
        grid = cus;
    }
    if (grid < 0) return;
    if (hipMemsetAsync((char*)d_ws + WS_CTL, 0, CTL_ZERO_BYTES, stream) != hipSuccess) return;
    Args a{};
    for (int i = 0; i < 24; ++i) a.in[i] = (const float*)d_in[i];
    a.out = (float*)d_out; a.ws = (unsigned char*)d_ws;
    if (MK_N_LAUNCHES == 1) { a.ph_lo = 0; a.ph_hi = NPH; hipLaunchKernelGGL(mk_fwd, dim3(grid), dim3(NWAVES * 64), LDS_BYTES, stream, a); }
    else for (int p = 0; p < NPH; ++p) { a.ph_lo = p; a.ph_hi = p + 1; hipLaunchKernelGGL(mk_fwd, dim3(grid), dim3(NWAVES * 64), LDS_BYTES, stream, a); }
}
```

```cpp
#include <hip/hip_runtime.h>
#include <cstdio>
#include <cstdint>
#ifndef PG8_RELAX
#define PG8_RELAX 0x142
#endif
#ifndef PG8_WGM
#define PG8_WGM 8
#endif
namespace pg8 {
#define PG8_LAS __attribute__((address_space(3)))
typedef unsigned short bf16_t;
typedef short bf16x8 __attribute__((ext_vector_type(8)));
typedef float f32x4 __attribute__((ext_vector_type(4)));
typedef unsigned u32x4 __attribute__((ext_vector_type(4)));
typedef int i32x8_t __attribute__((ext_vector_type(8)));
typedef int i32x4_t __attribute__((ext_vector_type(4)));
typedef short bf16x16_t __attribute__((ext_vector_type(16)));
constexpr int BM = 256, BK = 64, HALF = 128, HTB = HALF * BK * 2  , STAGE_BYTES = 8 * HTB, NXCD = 8, WGM = PG8_WGM;

__host__ __device__ __forceinline__ int lds_byte(int r, int c) { const int st = (r >> 4) * 2 + (c >> 5), rr = r & 15, cc = c & 31, ob = rr * 64 + cc * 2; return st * 1024 + (ob ^ (((ob >> 9) & 1) << 5)); }
__host__ __device__ __forceinline__ void stage_rc(int b, int& R, int& C) { const int st = b / 1024, sb = b % 1024, swz = sb ^ (((sb >> 9) & 1) << 5); R = (st >> 1) * 16 + swz / 64; C = (st & 1) * 32 + (swz % 64) / 2; }
__host__ __device__ __forceinline__ int perm32(int rho) { const int n = rho >> 4, i = rho & 15; return 8 * (i >> 2) + 4 * n + (i & 3); }

__device__ __forceinline__ int fresh_tid(int wave) { int l; asm volatile("v_mbcnt_lo_u32_b32 %0, -1, 0\n\tv_mbcnt_hi_u32_b32 %0, -1, %0" : "=v"(l)); return wave * 64 + l; }
struct Unit { int pm, pn, arow0, nvalid; };
struct Gemm { const bf16_t* A; const bf16_t* Bt; int M, N, K; };

struct StaticOrder {
    static constexpr bool PURE = true;
    int nM, nN, nwg, G, c, i0 = 0, cnt = 0x7fffffff;
    __host__ __device__ void init(int M, int N, int G_, int c_) { nM = M / BM; nN = N / BM; nwg = nM * nN; G = G_; c = c_; }
    __host__ __device__ bool next(int i, Unit& u) const {
        const long L = (long)(i + i0) * G + c; if (i >= cnt || L >= nwg) return false;
        int wgid = (int)L; { const int q = nwg / NXCD, r = nwg % NXCD, xcd = wgid % NXCD, off = wgid / NXCD; wgid = (xcd < r ? xcd * (q + 1) : r * (q + 1) + (xcd - r) * q) + off; }
        const int nig = WGM * nN, gid = wgid / nig, fm = gid * WGM, gsz = (nM - fm) < WGM ? (nM - fm) : WGM;
        u.pm = fm + ((wgid % nig) % gsz); u.pn = (wgid % nig) / gsz; return true;
    }
    __device__ __forceinline__ void a_ready(const Unit&) const {}
    __device__ __forceinline__ void done(const Unit&) const {}
};


__device__ __forceinline__ unsigned cvt_pk_bf16(float lo, float hi) { unsigned r; asm volatile("v_cvt_pk_bf16_f32 %0, %1, %2" : "=v"(r) : "v"(lo), "v"(hi)); return r; }
__device__ __forceinline__ float sigm(float x) { return __builtin_amdgcn_rcpf(1.0f + __builtin_amdgcn_exp2f(-1.4426950408889634f * x)); }
__device__ __forceinline__ f32x4 sigm4(f32x4 v) { return (f32x4){sigm(v[0]), sigm(v[1]), sigm(v[2]), sigm(v[3])}; }
__device__ __forceinline__ float bflo(unsigned w) { return __uint_as_float(w << 16); }
__device__ __forceinline__ float bfhi(unsigned w) { return __uint_as_float(w & 0xffff0000u); }
struct F8 { f32x4 a, b; };
__device__ __forceinline__ F8 unpk8(u32x4 w) { F8 r; r.a = (f32x4){bflo(w.x), bfhi(w.x), bflo(w.y), bfhi(w.y)}; r.b = (f32x4){bflo(w.z), bfhi(w.z), bflo(w.w), bfhi(w.w)}; return r; }
__device__ __forceinline__ u32x4 pk8(f32x4 a, f32x4 b) { u32x4 w; w.x = cvt_pk_bf16(a[0], a[1]); w.y = cvt_pk_bf16(a[2], a[3]); w.z = cvt_pk_bf16(b[0], b[1]); w.w = cvt_pk_bf16(b[2], b[3]); return w; }

struct EpiZG {
    static constexpr bool PERM = true, AFTER_DRAIN = false; static constexpr int RID = 0, NST = 16;
    bf16_t* Z; bf16_t* G; int skip;
    __device__ __forceinline__ void operator()(const f32x4 (&acc)[2][2][4][2], const Unit& u, int wr, int wc, int fr, int fq) const {
        if (skip == 1) return;
        const bool isg = u.pn >= 24; bf16_t* base = isg ? G : Z; int ldc = isg ? 4096 : 10752; int colt = (isg ? u.pn - 24 : u.pn) * BM;
        int row0 = u.pm * BM + wr * 64 + fr; if (skip == 2) { base = Z; ldc = 256; colt = 0; row0 = wr * 64 + fr; } const int col0 = colt + wc * 32 + 8 * fq;
#pragma unroll
        for (int ai = 0; ai < 2; ++ai)
#pragma unroll
            for (int m = 0; m < 4; ++m) { bf16_t* rowp = base + (size_t)(row0 + ai * HALF + m * 16) * ldc + col0;
#pragma unroll
                for (int bj = 0; bj < 2; ++bj) { f32x4 v0 = acc[ai][bj][m][0], v1 = acc[ai][bj][m][1];
                    if (isg) { v0 = sigm4(v0); v1 = sigm4(v1); }
                    const u32x4 w = pk8(v0, v1); if (skip != 3 || u.pm < 0) *(u32x4*)(rowp + bj * HALF) = w; } }
    }
};
struct EpiZB {
    static constexpr bool PERM = true, AFTER_DRAIN = false; static constexpr int RID = 1, NST = 16;
    bf16_t* Z; bf16_t* G; int skip;
    __device__ __forceinline__ void operator()(const f32x4 (&acc)[2][2][4][2], const Unit& u, int wr, int wc, int fr, int fq) const {
        if (skip == 1) return;
        const bool isg = u.pn >= 18 && u.pn < 34; bf16_t* base = isg ? G : Z; int ldc = isg ? 4096 : 10752; int colt = isg ? (u.pn - 18) * BM : (u.pn < 18 ? 6144 + u.pn * BM : (u.pn - 34) * BM);
        int row0 = u.pm * BM + wr * 64 + fr; if (skip == 2) { base = Z; ldc = 256; colt = 0; row0 = wr * 64 + fr; } const int col0 = colt + wc * 32 + 8 * fq;
#pragma unroll
        for (int ai = 0; ai < 2; ++ai)
#pragma unroll
            for (int m = 0; m < 4; ++m) { bf16_t* rowp = base + (size_t)(row0 + ai * HALF + m * 16) * ldc + col0;
#pragma unroll
                for (int bj = 0; bj < 2; ++bj) { f32x4 v0 = acc[ai][bj][m][0] * 0.03125f, v1 = acc[ai][bj][m][1] * 0.03125f;
                    if (isg) { v0 = sigm4(v0); v1 = sigm4(v1); }
                    const u32x4 w = pk8(v0, v1); if (skip != 3 || u.pm < 0) *(u32x4*)(rowp + bj * HALF) = w; } }
    }
};
struct EpiGateA {
    static constexpr bool PERM = true, AFTER_DRAIN = false; static constexpr int RID = 2, NST = 16;
    const bf16_t* G; bf16_t* T1;
    __device__ __forceinline__ void operator()(const f32x4 (&acc)[2][2][4][2], const Unit& u, int wr, int wc, int fr, int fq) const {
        const int row0 = u.pm * BM + wr * 64 + fr, col0 = u.pn * BM + wc * 32 + 8 * fq;
#pragma unroll
        for (int ai = 0; ai < 2; ++ai) { u32x4 gq[4][2];
#pragma unroll
            for (int m = 0; m < 4; ++m)
#pragma unroll
                for (int bj = 0; bj < 2; ++bj) gq[m][bj] = *(const u32x4*)(G + (size_t)(row0 + ai * HALF + m * 16) * 4096 + col0 + bj * HALF);
#pragma unroll
            for (int m = 0; m < 4; ++m) { const size_t r = (size_t)(row0 + ai * HALF + m * 16);
#pragma unroll
                for (int bj = 0; bj < 2; ++bj) { const F8 g = unpk8(gq[m][bj]);
                    *(u32x4*)(T1 + r * 2048 + col0 + bj * HALF) = pk8(acc[ai][bj][m][0] * g.a, acc[ai][bj][m][1] * g.b); } }
            asm volatile("" ::: "memory"); }
    }
};
struct EpiMerge {
    static constexpr bool PERM = true, AFTER_DRAIN = false; static constexpr int RID = 3, NST = 16;
    const bf16_t* G; const bf16_t* T1; bf16_t* O;
    __device__ __forceinline__ void operator()(const f32x4 (&acc)[2][2][4][2], const Unit& u, int wr, int wc, int fr, int fq) const {
        const int row0 = u.pm * BM + wr * 64 + fr, col0 = u.pn * BM + wc * 32 + 8 * fq;
#pragma unroll
        for (int ai = 0; ai < 2; ++ai) { u32x4 gq[4][2], tq[4][2];
#pragma unroll
            for (int m = 0; m < 4; ++m)
#pragma unroll
                for (int bj = 0; bj < 2; ++bj) { const size_t r = (size_t)(row0 + ai * HALF + m * 16); gq[m][bj] = *(const u32x4*)(G + r * 4096 + 2048 + col0 + bj * HALF); tq[m][bj] = *(const u32x4*)(T1 + r * 2048 + col0 + bj * HALF); }
#pragma unroll
            for (int m = 0; m < 4; ++m) { const size_t r = (size_t)(row0 + ai * HALF + m * 16);
#pragma unroll
                for (int bj = 0; bj < 2; ++bj) { const F8 g = unpk8(gq[m][bj]); const F8 t = unpk8(tq[m][bj]);
                    *(u32x4*)(O + r * 2048 + col0 + bj * HALF) = pk8(t.a + acc[ai][bj][m][0] * g.a, t.b + acc[ai][bj][m][1] * g.b); } }
            asm volatile("" ::: "memory"); }
    }
};
struct EpiRes {
    static constexpr bool PERM = false, AFTER_DRAIN = false; static constexpr int RID = 4, NST = 32;
    const float* X; float* O;
    __device__ __forceinline__ void operator()(const f32x4 (&acc)[2][2][4][2], const Unit& u, int wr, int wc, int fr, int fq) const {
        const int row0 = u.pm * BM + wr * 64 + fr, col0 = u.pn * BM + wc * 32 + 4 * fq;
#pragma unroll
        for (int ai = 0; ai < 2; ++ai) { f32x4 xq[4][2][2];
#pragma unroll
            for (int m = 0; m < 4; ++m) { const size_t off = (size_t)(row0 + ai * HALF + m * 16) * 2048 + col0;
#pragma unroll
                for (int bj = 0; bj < 2; ++bj)
#pragma unroll
                    for (int n = 0; n < 2; ++n) xq[m][bj][n] = *(const f32x4*)(X + off + bj * HALF + n * 16); }
#pragma unroll
            for (int m = 0; m < 4; ++m) { const size_t off = (size_t)(row0 + ai * HALF + m * 16) * 2048 + col0;
#pragma unroll
                for (int bj = 0; bj < 2; ++bj)
#pragma unroll
                    for (int n = 0; n < 2; ++n) *(f32x4*)(O + off + bj * HALF + n * 16) = xq[m][bj][n] + acc[ai][bj][m][n]; }
            asm volatile("" ::: "memory"); }
    }
};
struct EpiSwiGLU {
    typedef unsigned u32x2 __attribute__((ext_vector_type(2)));
    static constexpr bool PERM = true, AFTER_DRAIN = false; static constexpr int RID = 5, NST = 8;
    bf16_t* Hd; const int* RT; const float* r1;
    __device__ __forceinline__ void operator()(const f32x4 (&acc)[2][2][4][2], const Unit& u, int wr, int wc, int fr, int fq) const {
        const int lr0 = wr * 64 + fr, row0 = u.pm * BM + lr0, col0 = (u.pn & 7) * HALF + wc * 32 + 8 * fq;
        int tok[2][4]; float rsv[2][4];
#pragma unroll
        for (int ai = 0; ai < 2; ++ai)
#pragma unroll
            for (int m = 0; m < 4; ++m) { const int lr = lr0 + ai * HALF + m * 16; tok[ai][m] = lr < u.nvalid ? RT[u.arow0 + lr] : 0; }
#pragma unroll
        for (int ai = 0; ai < 2; ++ai)
#pragma unroll
            for (int m = 0; m < 4; ++m) rsv[ai][m] = r1[tok[ai][m]] * 0.03125f;
#pragma unroll
        for (int ai = 0; ai < 2; ++ai)
#pragma unroll
            for (int m = 0; m < 4; ++m) { const size_t r = (size_t)(row0 + ai * HALF + m * 16); const float rs = rsv[ai][m];
                const f32x4 a0 = acc[ai][0][m][0] * rs, a1 = acc[ai][0][m][1] * rs, b0 = acc[ai][1][m][0] * rs, b1 = acc[ai][1][m][1] * rs;
                const f32x4 v0 = a0 * sigm4(a0) * b0, v1 = a1 * sigm4(a1) * b1;
                u32x2 w; w.x = (unsigned)__builtin_amdgcn_cvt_pk_fp8_f32(v0[2], v0[3], __builtin_amdgcn_cvt_pk_fp8_f32(v0[0], v0[1], 0, false), true);
                w.y = (unsigned)__builtin_amdgcn_cvt_pk_fp8_f32(v1[2], v1[3], __builtin_amdgcn_cvt_pk_fp8_f32(v1[0], v1[1], 0, false), true);
                *(u32x2*)((unsigned char*)Hd + r * 1024 + col0) = w; }
    }
};
struct EpiY {
    static constexpr bool PERM = true, AFTER_DRAIN = false; static constexpr int RID = 6, NST = 16;
    bf16_t* Y;
    __device__ __forceinline__ void operator()(const f32x4 (&acc)[2][2][4][2], const Unit& u, int wr, int wc, int fr, int fq) const {
        const int row0 = u.pm * BM + wr * 64 + fr, col0 = (u.pn & 7) * BM + wc * 32 + 8 * fq;
#pragma unroll
        for (int ai = 0; ai < 2; ++ai)
#pragma unroll
            for (int m = 0; m < 4; ++m) { bf16_t* rowp = Y + (size_t)(row0 + ai * HALF + m * 16) * 2048 + col0;
#pragma unroll
                for (int bj = 0; bj < 2; ++bj) *(u32x4*)(rowp + bj * HALF) = pk8(acc[ai][bj][m][0] * 0.03125f, acc[ai][bj][m][1] * 0.03125f); }
    }
};
struct EpiBf {
    static constexpr bool PERM = true, AFTER_DRAIN = false; static constexpr int RID = 7, NST = 16;
    bf16_t* O;
    __device__ __forceinline__ void operator()(const f32x4 (&acc)[2][2][4][2], const Unit& u, int wr, int wc, int fr, int fq) const {
        const int row0 = u.pm * BM + wr * 64 + fr, col0 = u.pn * BM + wc * 32 + 8 * fq;
#pragma unroll
        for (int ai = 0; ai < 2; ++ai)
#pragma unroll
            for (int m = 0; m < 4; ++m) { bf16_t* rowp = O + (size_t)(row0 + ai * HALF + m * 16) * 2048 + col0;
#pragma unroll
                for (int bj = 0; bj < 2; ++bj) *(u32x4*)(rowp + bj * HALF) = pk8(acc[ai][bj][m][0], acc[ai][bj][m][1]); }
    }
};
struct EpiPle {
    static constexpr bool PERM = true, AFTER_DRAIN = false; static constexpr int RID = 8, NST = 16;
    const bf16_t* E; const bf16_t* H3; const float* rinv; const float* gple; bf16_t* X3; float sc;
    __device__ __forceinline__ void operator()(const f32x4 (&acc)[2][2][4][2], const Unit& u, int wr, int wc, int fr, int fq) const {
        const int row0 = u.pm * BM + wr * 64 + fr, col0 = u.pn * BM + wc * 32 + 8 * fq;
        f32x4 gi[2][2];
#pragma unroll
        for (int bj = 0; bj < 2; ++bj)
#pragma unroll
            for (int n = 0; n < 2; ++n) { const f32x4 gv = *(const f32x4*)(gple + col0 + bj * HALF + 4 * n); gi[bj][n] = (f32x4){1.f / gv[0], 1.f / gv[1], 1.f / gv[2], 1.f / gv[3]}; }
#pragma unroll
        for (int ai = 0; ai < 2; ++ai)
#pragma unroll
          for (int mh = 0; mh < 2; ++mh) { u32x4 eq[2][2], hq[2][2]; float riq[2];
#pragma unroll
            for (int mm = 0; mm < 2; ++mm) { const size_t r = (size_t)(row0 + ai * HALF + (2 * mh + mm) * 16); riq[mm] = rinv[r];
#pragma unroll
                for (int bj = 0; bj < 2; ++bj) { eq[mm][bj] = *(const u32x4*)(E + r * 2048 + col0 + bj * HALF); hq[mm][bj] = *(const u32x4*)(H3 + r * 2048 + col0 + bj * HALF); } }
#pragma unroll
            for (int mm = 0; mm < 2; ++mm) { const int m = 2 * mh + mm; const size_t r = (size_t)(row0 + ai * HALF + m * 16); const float ri = riq[mm];
#pragma unroll
                for (int bj = 0; bj < 2; ++bj) { const F8 ev = unpk8(eq[mm][bj]); const F8 hv = unpk8(hq[mm][bj]);
                    f32x4 a0 = acc[ai][bj][m][0] * 0.03125f, a1 = acc[ai][bj][m][1] * 0.03125f; asm volatile("" : "+v"(a0), "+v"(a1));
                    const f32x4 v0 = hv.a * gi[bj][0] * ri + sigm4(a0) * (ev.a * sc), v1 = hv.b * gi[bj][1] * ri + sigm4(a1) * (ev.b * sc);
                    *(u32x4*)(X3 + r * 2048 + col0 + bj * HALF) = pk8(v0, v1); } }
            asm volatile("" ::: "memory"); }
    }
};
#ifndef MOE_XCD
#define MOE_XCD 1
#endif
struct MoeOrder {
    static constexpr bool PURE = true;
    const volatile PG8_LAS int* TE; const volatile PG8_LAS int* TS; const volatile PG8_LAS int* CN; int n8, G, c;
    __device__ __forceinline__ bool next(int i, Unit& u) const {
        long L = (long)i * G + c;
        if (MOE_XCD && G == 256) { const int x = c & 7, s = c >> 3; L = ((long)i * 32 + x * 4 + (s >> 3)) * 8 + (s & 7); }
        if (L >= n8) return false;
        u.pm = (int)(L >> 3);
        const int e = __builtin_amdgcn_readfirstlane(TE[u.pm]), lt = u.pm - __builtin_amdgcn_readfirstlane(TS[e]);
        u.pn = e * 8 + (int)(L & 7); u.arow0 = e * 65536 + lt * 256; u.nvalid = __builtin_amdgcn_readfirstlane(CN[e]) - lt * 256; return true;
    }
    __device__ __forceinline__ void a_ready(const Unit&) const {}
    __device__ __forceinline__ void done(const Unit&) const {}
};
template <class Epi, class Sched, bool ALIGN_EPI = false, bool SP2 = false, bool GATHER = false, bool F8 = false>
__device__ __forceinline__ void gemm_phase(PG8_LAS unsigned char* lds, const Gemm g, const Sched& S, const Epi& E, const int wave, const int* RT = nullptr) {
    const int tid = fresh_tid(wave), wid = wave, lane = tid & 63, wr = wid >> 2, wc = wid & 3, fr = lane & 15, fq = lane >> 4;
    const int K = g.K, KB = F8 ? g.K : g.K * 2  , nt = KB / (BK * 2);
    unsigned oC0[2], oC1[2], oN0[2], oN1[2], voffB[2]; int Rg[2]; unsigned Cb[2];
    const size_t kstep = (size_t)(BK * 2);
    const size_t hstep = (size_t)HALF * KB;
#pragma unroll
    for (int i = 0; i < 2; ++i) { int R, C; stage_rc(tid * 16 + i * 8192, R, C); const int Rb = Epi::PERM ? ((R & ~31) + perm32(R & 31)) : R;
        Rg[i] = R; Cb[i] = (unsigned)C * 2u; oC0[i] = (unsigned)(R * KB + C * 2); oC1[i] = oC0[i] + (unsigned)hstep; oN0[i] = oC0[i]; oN1[i] = oC1[i]; voffB[i] = (unsigned)(Rb * KB + C * 2); }
#define PG8_GOFFS(u_, o0_, o1_) do { _Pragma("unroll") for (int _i = 0; _i < 2; ++_i) { const int t0_ = Rg[_i] < (u_).nvalid ? RT[(u_).arow0 + Rg[_i]] : 0, t1_ = HALF + Rg[_i] < (u_).nvalid ? RT[(u_).arow0 + HALF + Rg[_i]] : 0; \
        o0_[_i] = (unsigned)t0_ * (unsigned)KB + Cb[_i]; o1_[_i] = (unsigned)t1_ * (unsigned)KB + Cb[_i]; } } while (0)
    const size_t tstep = 2 * hstep;
    const unsigned ldsw = (unsigned)wid * 1024u;
    const int aoff = lds_byte(wr * 64 + fr, fq * 8), boff = lds_byte(wc * 32 + fr, fq * 8);
#define PG8_SA(b, h) (((b) * 2 + (h)) * HTB)
#define PG8_SB(b, h) ((4 + (b) * 2 + (h)) * HTB)
#define PG8_STAGE(bufoff, gbase, voff) do { _Pragma("unroll") for (int _i = 0; _i < 2; ++_i) \
        __builtin_amdgcn_global_load_lds((const unsigned*)((const char*)(gbase) + (voff)[_i]), (PG8_LAS unsigned*)(lds + (bufoff) + ldsw + _i * 8192), 16, 0, 0); } while (0)
#define PG8_STAGE_A(bufoff, gbase, h_, o0_, o1_) do { if constexpr (GATHER) { if ((h_) == 0) PG8_STAGE(bufoff, gbase, o0_); else PG8_STAGE(bufoff, gbase, o1_); } \
        else { PG8_STAGE(bufoff, (gbase) + (h_) * hstep, oC0); } } while (0)
#define PG8_LDA(dst, b, h) do { _Pragma("unroll") for (int m = 0; m < 4; ++m) { if constexpr (F8) { dst##8[m].lo = *(const PG8_LAS i32x4_t*)(lds + PG8_SA(b, h) + aoff + m * 2048); dst##8[m].hi = *(const PG8_LAS i32x4_t*)(lds + PG8_SA(b, h) + aoff + m * 2048 + 1024); } \
        else { _Pragma("unroll") for (int k = 0; k < 2; ++k) dst[m][k] = *(const PG8_LAS bf16x8*)(lds + PG8_SA(b, h) + aoff + m * 2048 + k * 1024); } } } while (0)
#define PG8_LDB(dst, b, h) do { _Pragma("unroll") for (int n = 0; n < 2; ++n) { if constexpr (F8) { dst##8[n].lo = *(const PG8_LAS i32x4_t*)(lds + PG8_SB(b, h) + boff + n * 2048); dst##8[n].hi = *(const PG8_LAS i32x4_t*)(lds + PG8_SB(b, h) + boff + n * 2048 + 1024); } \
        else { _Pragma("unroll") for (int k = 0; k < 2; ++k) dst[n][k] = *(const PG8_LAS bf16x8*)(lds + PG8_SB(b, h) + boff + n * 2048 + k * 1024); } } } while (0)
#define PG8_MMA(ai, bj, At, Bt) do { __builtin_amdgcn_s_setprio(1); _Pragma("unroll") for (int m = 0; m < 4; ++m) _Pragma("unroll") for (int n = 0; n < 2; ++n) { \
        if constexpr (F8) asm volatile("v_mfma_scale_f32_16x16x128_f8f6f4 %0, %1, %2, %0, %3, %3 op_sel_hi:[0,0,0]" : "+v"(acc[ai][bj][m][n]) : "v"(Bt##8[n]), "v"(At##8[m]), "v"(sc127));     \
        else { _Pragma("unroll") for (int k = 0; k < 2; ++k) acc[ai][bj][m][n] = __builtin_amdgcn_mfma_f32_16x16x32_bf16(Bt[n][k], At[m][k], acc[ai][bj][m][n], 0, 0, 0); } } \
        __builtin_amdgcn_s_setprio(0); } while (0)
#define PG8_WAIT_V(n) asm volatile("s_waitcnt vmcnt(" #n ")" ::: "memory")
#define PG8_WAIT_L(n) asm volatile("s_waitcnt lgkmcnt(" #n ")" ::: "memory")
#define PG8_WAIT_VF do { if (relax_) asm volatile("s_waitcnt vmcnt(%0)" :: "n"(8 + Epi::NST) : "memory"); else PG8_WAIT_V(8); } while (0)
#define PG8_BAR __builtin_amdgcn_s_barrier()
#define PG8_SCHED __builtin_amdgcn_sched_barrier(0)
    Unit cur, nxt; int ui = 0;
    if (!S.next(0, cur)) return;
    f32x4 acc[2][2][4][2];
#pragma unroll
    for (int a = 0; a < 2; ++a)
#pragma unroll
        for (int b = 0; b < 2; ++b)
#pragma unroll
            for (int m = 0; m < 4; ++m)
#pragma unroll
                for (int n = 0; n < 2; ++n) acc[a][b][m][n] = (f32x4){0.f, 0.f, 0.f, 0.f};
    int sc127 = 127; asm volatile("" : "+v"(sc127));
    bf16x8 At[4][2], B0[2][2], B1[2][2]; i32x8_t At8[4], B08[2], B18[2];
    const char* cA = (const char*)g.A + (GATHER ? (size_t)0 : (size_t)cur.pm * tstep); const char* cB = (const char*)g.Bt + (size_t)cur.pn * tstep;
    S.a_ready(cur);
    if constexpr (GATHER) { PG8_GOFFS(cur, oC0, oC1); }
    if constexpr (SP2) {
        PG8_STAGE(PG8_SB(0, 0), cB, voffB); PG8_STAGE(PG8_SB(0, 1), cB + hstep, voffB); PG8_STAGE_A(PG8_SA(0, 0), cA, 0, oC0, oC1); PG8_STAGE_A(PG8_SA(0, 1), cA, 1, oC0, oC1);
        if (wr == 1) PG8_BAR;
        PG8_WAIT_V(2); PG8_BAR;
        PG8_STAGE(PG8_SB(1, 0), cB + kstep, voffB); PG8_STAGE_A(PG8_SA(1, 0), cA + kstep, 0, oC0, oC1); PG8_STAGE(PG8_SB(1, 1), cB + hstep + kstep, voffB);
        PG8_WAIT_V(6); PG8_BAR;
    } else {
        PG8_STAGE(PG8_SB(0, 0), cB, voffB); PG8_STAGE_A(PG8_SA(0, 0), cA, 0, oC0, oC1); PG8_STAGE(PG8_SB(0, 1), cB + hstep, voffB); PG8_STAGE_A(PG8_SA(0, 1), cA, 1, oC0, oC1);
        if (wr == 1) PG8_BAR;
        PG8_WAIT_V(4); PG8_BAR;
        PG8_STAGE(PG8_SB(1, 0), cB + kstep, voffB); PG8_STAGE_A(PG8_SA(1, 0), cA + kstep, 0, oC0, oC1); PG8_STAGE(PG8_SB(1, 1), cB + hstep + kstep, voffB);
        PG8_WAIT_V(6); PG8_BAR;
    }
    for (;;) {
        const bool has_next = S.next(ui + 1, nxt);
        const char* nA = (has_next && !GATHER) ? (const char*)g.A + (size_t)nxt.pm * tstep : cA;
        if constexpr (GATHER) { if (has_next) { PG8_GOFFS(nxt, oN0, oN1); } else { _Pragma("unroll") for (int _i = 0; _i < 2; ++_i) { oN0[_i] = oC0[_i]; oN1[_i] = oC1[_i]; } } } const char* nB = has_next ? (const char*)g.Bt + (size_t)nxt.pn * tstep : cB;
        for (int t = 0; t < nt; t += 2) {
            const bool last = (t == nt - 2); const bool relax_ = ((PG8_RELAX >> Epi::RID) & 1) && !GATHER && Epi::NST > 0 && t == 0 && ui > 0;
            const char* a1 = cA + (size_t)(t + 1) * kstep;
            const char* a2 = last ? nA : cA + (size_t)(t + 2) * kstep; const char* b2 = last ? nB : cB + (size_t)(t + 2) * kstep;
            const char* a3 = a2 + kstep; const char* b3 = b2 + kstep;
            unsigned oX0[2], oX1[2];
#pragma unroll
            for (int _i = 0; _i < 2; ++_i) { oX0[_i] = (GATHER && last) ? oN0[_i] : oC0[_i]; oX1[_i] = (GATHER && last) ? oN1[_i] : oC1[_i]; }
            if (last && has_next) S.a_ready(nxt);
            if constexpr (SP2) {
            PG8_LDB(B0, 0, 0); PG8_LDB(B1, 0, 1); PG8_SCHED; PG8_LDA(At, 0, 0); PG8_STAGE_A(PG8_SA(1, 1), a1, 1, oC0, oC1);
            PG8_WAIT_VF; PG8_WAIT_L(0); PG8_BAR; PG8_MMA(0, 0, At, B0); PG8_MMA(0, 1, At, B1); PG8_BAR; PG8_SCHED;
            PG8_LDA(At, 0, 1); PG8_STAGE(PG8_SB(0, 0), b2, voffB); PG8_STAGE(PG8_SB(0, 1), b2 + hstep, voffB); PG8_STAGE_A(PG8_SA(0, 0), a2, 0, oX0, oX1);
            PG8_WAIT_VF; PG8_WAIT_L(0); PG8_BAR; PG8_MMA(1, 0, At, B0); PG8_MMA(1, 1, At, B1); PG8_BAR; PG8_SCHED;
            PG8_LDB(B0, 1, 0); PG8_LDB(B1, 1, 1); PG8_SCHED; PG8_LDA(At, 1, 0); PG8_STAGE_A(PG8_SA(0, 1), a2, 1, oX0, oX1);
            PG8_WAIT_V(8); PG8_WAIT_L(0); PG8_BAR; PG8_MMA(0, 0, At, B0); PG8_MMA(0, 1, At, B1); PG8_BAR; PG8_SCHED;
            PG8_LDA(At, 1, 1); PG8_STAGE(PG8_SB(1, 0), b3, voffB); PG8_STAGE(PG8_SB(1, 1), b3 + hstep, voffB); PG8_STAGE_A(PG8_SA(1, 0), a3, 0, oX0, oX1);
            PG8_WAIT_V(8); PG8_WAIT_L(0); PG8_BAR; PG8_MMA(1, 0, At, B0); PG8_MMA(1, 1, At, B1); PG8_BAR; PG8_SCHED;
            } else {
            PG8_LDB(B0, 0, 0); PG8_SCHED; PG8_LDA(At, 0, 0); PG8_STAGE_A(PG8_SA(1, 1), a1, 1, oC0, oC1);
            PG8_WAIT_L(8); PG8_BAR; PG8_WAIT_L(0); PG8_MMA(0, 0, At, B0); PG8_BAR; PG8_SCHED;
            PG8_LDB(B1, 0, 1); PG8_STAGE(PG8_SB(0, 0), b2, voffB);
            PG8_BAR; PG8_WAIT_L(0); PG8_MMA(0, 1, At, B1); PG8_BAR;
            PG8_LDA(At, 0, 1); PG8_STAGE_A(PG8_SA(0, 0), a2, 0, oX0, oX1);
            PG8_BAR; PG8_WAIT_L(0); PG8_MMA(1, 0, At, B0); PG8_BAR; PG8_SCHED;
            PG8_STAGE(PG8_SB(0, 1), b2 + hstep, voffB);
            PG8_WAIT_V(6); PG8_BAR; PG8_MMA(1, 1, At, B1); PG8_BAR;
            PG8_LDB(B0, 1, 0); PG8_SCHED; PG8_LDA(At, 1, 0); PG8_STAGE_A(PG8_SA(0, 1), a2, 1, oX0, oX1);
            PG8_WAIT_L(8); PG8_BAR; PG8_WAIT_L(0); PG8_MMA(0, 0, At, B0); PG8_BAR; PG8_SCHED;
            PG8_LDB(B1, 1, 1); PG8_STAGE(PG8_SB(1, 0), b3, voffB);
            PG8_BAR; PG8_WAIT_L(0); PG8_MMA(0, 1, At, B1); PG8_BAR;
            PG8_LDA(At, 1, 1); PG8_STAGE_A(PG8_SA(1, 0), a3, 0, oX0, oX1);
            PG8_BAR; PG8_WAIT_L(0); PG8_MMA(1, 0, At, B0); PG8_BAR; PG8_SCHED;
            PG8_STAGE(PG8_SB(1, 1), b3 + hstep, voffB);
            PG8_WAIT_V(6); PG8_BAR; PG8_MMA(1, 1, At, B1); PG8_BAR;
            }
        }
        if constexpr (F8) asm volatile("s_nop 15\n\ts_nop 15" ::: "memory");
        if constexpr (ALIGN_EPI) { if (wr == 0) PG8_BAR; }
        if constexpr (!Epi::AFTER_DRAIN) { const int l_ = fresh_tid(0); E(acc, cur, wr, wc, l_ & 15, l_ >> 4); S.done(cur); }
        if (!has_next) break;
#pragma unroll
        for (int a = 0; a < 2; ++a)
#pragma unroll
            for (int b = 0; b < 2; ++b)
#pragma unroll
                for (int m = 0; m < 4; ++m)
#pragma unroll
                    for (int n = 0; n < 2; ++n) acc[a][b][m][n] = (f32x4){0.f, 0.f, 0.f, 0.f};
        cur = nxt; cA = nA; cB = nB; ++ui;
        if constexpr (GATHER) { _Pragma("unroll") for (int _i = 0; _i < 2; ++_i) { oC0[_i] = oN0[_i]; oC1[_i] = oN1[_i]; } }
        if constexpr (ALIGN_EPI) { if (wr == 1) PG8_BAR; }
    }
    PG8_WAIT_V(0);
    if constexpr (!ALIGN_EPI) { if (wr == 0) PG8_BAR; }
    PG8_BAR;
    if constexpr (Epi::AFTER_DRAIN) { E.fused(acc, cur, wr, wc, fr, fq, lds, wid, lane); S.done(cur); }
#undef PG8_SA
#undef PG8_GOFFS
#undef PG8_STAGE_A
#undef PG8_SB
#undef PG8_STAGE
#undef PG8_LDA
#undef PG8_LDB
#undef PG8_MMA
#undef PG8_WAIT_V
#undef PG8_WAIT_L
#undef PG8_BAR
#undef PG8_SCHED
}
}

namespace att {
typedef unsigned short bf16_t;
typedef short bf16x8 __attribute__((ext_vector_type(8)));
typedef short s16x4 __attribute__((ext_vector_type(4)));
typedef float f32x16 __attribute__((ext_vector_type(16)));
typedef float f32x4 __attribute__((ext_vector_type(4)));
typedef unsigned u32x4 __attribute__((ext_vector_type(4)));
constexpr int LDZ = 10752;
constexpr int WS_OFF = 98304, TAB_OFF = WS_OFF + 2048, TAB_N = 2304, ATT_LDS = TAB_OFF + TAB_N * 4;
constexpr float THR = 8.f;
#define SBAR() __builtin_amdgcn_sched_barrier(0)
__device__ __forceinline__ int crow(int r, int hi) { return (r & 3) + 8 * (r >> 2) + 4 * hi; }
__device__ __forceinline__ unsigned cvtpk(float lo, float hi) { unsigned r; asm volatile("v_cvt_pk_bf16_f32 %0, %1, %2" : "=v"(r) : "v"(lo), "v"(hi)); return r; }
template <int DH> __device__ __forceinline__ int kswz(int row, int colB) { return row * (DH * 2) + (colB ^ ((row & 7) << 4)); }
template <int DH> __device__ __forceinline__ int v_st(int k, int c) { const int kk = (k & ~0xC) | ((k & 4) << 1) | ((k & 8) >> 1); return ((kk >> 3) * (DH / 32) + (c >> 5)) * 512 + ((kk & 7) * 32 + (c & 31)) * 2; }
__device__ __forceinline__ int v_rd_base(int lane) { return ((lane & 3) << 3) | (((lane >> 2) & 3) << 6) | (((lane >> 4) & 1) << 5) | (((lane >> 5) & 1) << 8); }
__device__ __forceinline__ bf16x8 ld8(const bf16_t* p) { return *reinterpret_cast<const bf16x8*>(p); }
__device__ __forceinline__ size_t vrow_off(int v, int dil, int lgL) { return (size_t)((v & ((1 << lgL) - 1)) * dil + (v >> lgL)) * LDZ; }
__device__ __forceinline__ int vrow_tok(int v, int dil, int lgL) { return (v & ((1 << lgL) - 1)) * dil + (v >> lgL); }

__device__ __forceinline__ void bias_tile(f32x16& p0, f32x16& p1, const float* tb) {
#pragma unroll
    for (int r = 0; r < 16; ++r) { const int c = (r & 3) + 8 * (r >> 2); p0[r] += tb[59 - c]; p1[r] += tb[27 - c]; }
}
__device__ __forceinline__ void mask_tile(f32x16& p0, f32x16& p1, int dq, unsigned W) {
    const float NEG = -__builtin_inff();
#pragma unroll
    for (int r = 0; r < 16; ++r) { const int c = (r & 3) + 8 * (r >> 2);
        if ((unsigned)(dq - c) >= W) p0[r] = NEG;
        if ((unsigned)(dq - c - 32) >= W) p1[r] = NEG; }
}
template <int DH>
__device__ __forceinline__ void partialSM(f32x16& p0, f32x16& p1, float& m_reg, float& mn, float& alpha) {
    constexpr float SCALE = DH == 128 ? 0.08838834764831845f : 0.125f;
    float pmax = p0[0];
#pragma unroll
    for (int r = 1; r < 16; ++r) pmax = fmaxf(pmax, p0[r]);
#pragma unroll
    for (int r = 0; r < 16; ++r) pmax = fmaxf(pmax, p1[r]);
    { auto rr = __builtin_amdgcn_permlane32_swap(__float_as_uint(pmax), __float_as_uint(pmax), false, false);
      pmax = fmaxf(__uint_as_float(rr[0]), __uint_as_float(rr[1])); }
    constexpr float C2 = 1.4426950408889634f * SCALE;
    if (__builtin_expect(__all((pmax - m_reg) * SCALE <= THR), 1)) { mn = m_reg; alpha = 1.f; }
    else { mn = fmaxf(m_reg, pmax); alpha = __builtin_amdgcn_exp2f((m_reg - mn) * C2); m_reg = mn; }
    const float mnL = -mn * C2;
#pragma unroll
    for (int r = 0; r < 16; ++r) p0[r] = fmaf(p0[r], C2, mnL);
#pragma unroll
    for (int r = 0; r < 16; ++r) p1[r] = fmaf(p1[r], C2, mnL);
#pragma unroll
    for (int r = 0; r < 16; ++r) p0[r] = __builtin_amdgcn_exp2f(p0[r]);
}
__device__ __forceinline__ void finishSM(f32x16& p0, f32x16& p1, float alpha, float& l_reg, bf16x8& pa0, bf16x8& pa1, bf16x8& pa2, bf16x8& pa3) {
#pragma unroll
    for (int r = 0; r < 16; ++r) p1[r] = __builtin_amdgcn_exp2f(p1[r]);
    float ps = 0;
#pragma unroll
    for (int r = 0; r < 16; ++r) ps += p0[r];
#pragma unroll
    for (int r = 0; r < 16; ++r) ps += p1[r];
    { auto rr = __builtin_amdgcn_permlane32_swap(__float_as_uint(ps), __float_as_uint(ps), false, false);
      ps = __uint_as_float(rr[0]) + __uint_as_float(rr[1]); }
    l_reg = l_reg * alpha + ps;
#define PK4(P, B_, OUT) do { unsigned a0 = cvtpk(P[B_+0], P[B_+1]), a1 = cvtpk(P[B_+2], P[B_+3]);                          \
        unsigned b0 = cvtpk(P[B_+4], P[B_+5]), b1 = cvtpk(P[B_+6], P[B_+7]);                                             \
        auto r0 = __builtin_amdgcn_permlane32_swap(a0, b0, false, false); auto r1 = __builtin_amdgcn_permlane32_swap(a1, b1, false, false); \
        u32x4 w = {r0[0], r1[0], r0[1], r1[1]}; OUT = *reinterpret_cast<bf16x8*>(&w); } while (0)
    PK4(p0, 0, pa0); PK4(p0, 8, pa1); PK4(p1, 0, pa2); PK4(p1, 8, pa3);
#undef PK4
}
__device__ __forceinline__ void finishSM_ns(f32x16& p0, f32x16& p1, bf16x8& pa0, bf16x8& pa1, bf16x8& pa2, bf16x8& pa3) {
#pragma unroll
    for (int r = 0; r < 16; ++r) p1[r] = __builtin_amdgcn_exp2f(p1[r]);
#define PK4(P, B_, OUT) do { unsigned a0 = cvtpk(P[B_+0], P[B_+1]), a1 = cvtpk(P[B_+2], P[B_+3]);                          \
        unsigned b0 = cvtpk(P[B_+4], P[B_+5]), b1 = cvtpk(P[B_+6], P[B_+7]);                                             \
        auto r0 = __builtin_amdgcn_permlane32_swap(a0, b0, false, false); auto r1 = __builtin_amdgcn_permlane32_swap(a1, b1, false, false); \
        u32x4 w = {r0[0], r1[0], r0[1], r1[1]}; OUT = *reinterpret_cast<bf16x8*>(&w); } while (0)
    PK4(p0, 0, pa0); PK4(p0, 8, pa1); PK4(p1, 0, pa2); PK4(p1, 8, pa3);
#undef PK4
}
template <int DH, bool SK>
__device__ __forceinline__ void qkt(f32x16& p0, f32x16& p1, const char* K_slot, int r32, int hi, const bf16x8* qr, bool act, const float* tb = nullptr) {
    if (SK && !act) { const float NEG = -__builtin_inff();
#pragma unroll
        for (int r = 0; r < 16; ++r) { p0[r] = NEG; p1[r] = NEG; } return; }
    if (tb) {
#pragma unroll
        for (int r = 0; r < 16; ++r) { const int c = (r & 3) + 8 * (r >> 2); p0[r] = tb[59 - c]; p1[r] = tb[27 - c]; }
    } else { p0 = f32x16{}; p1 = f32x16{}; }
    const char* kb[4];
    if constexpr (DH == 128) {
#pragma unroll
        for (int dd = 0; dd < 4; ++dd) kb[dd] = K_slot + kswz<DH>(r32, (dd * 16 + hi * 8) * 2);
#pragma unroll
        for (int d0 = 0; d0 < 8; ++d0) { const char* a = kb[d0 & 3] + (d0 >> 2) * 128;
            bf16x8 b0 = *reinterpret_cast<const bf16x8*>(a);
            bf16x8 b1 = *reinterpret_cast<const bf16x8*>(a + 32 * 256);
            p0 = __builtin_amdgcn_mfma_f32_32x32x16_bf16(b0, qr[d0], p0, 0, 0, 0);
            p1 = __builtin_amdgcn_mfma_f32_32x32x16_bf16(b1, qr[d0], p1, 0, 0, 0); }
    } else {
#pragma unroll
        for (int dd = 0; dd < 4; ++dd) kb[dd] = K_slot + kswz<DH>(r32, (dd * 16 + hi * 8) * 2);
#pragma unroll
        for (int d0 = 0; d0 < 4; ++d0) { const char* a = kb[d0];
            bf16x8 b0 = *reinterpret_cast<const bf16x8*>(a);
            bf16x8 b1 = *reinterpret_cast<const bf16x8*>(a + 32 * 128);
            p0 = __builtin_amdgcn_mfma_f32_32x32x16_bf16(b0, qr[d0], p0, 0, 0, 0);
            p1 = __builtin_amdgcn_mfma_f32_32x32x16_bf16(b1, qr[d0], p1, 0, 0, 0); }
    }
}
__device__ __forceinline__ void qkt_bias128(f32x16& p0, f32x16& p1, const char* K_slot, int r32, int hi, const bf16x8* qr, const float* tb) {
#pragma unroll
    for (int r = 0; r < 16; ++r) { const int c = (r & 3) + 8 * (r >> 2); p0[r] = tb[59 - c]; p1[r] = tb[27 - c]; }
    const char* kb[4];
#pragma unroll
    for (int dd = 0; dd < 4; ++dd) kb[dd] = K_slot + kswz<128>(r32, (dd * 16 + hi * 8) * 2);
#pragma unroll
    for (int d0 = 0; d0 < 8; ++d0) { const char* a = kb[d0 & 3] + (d0 >> 2) * 128;
        bf16x8 b0 = *reinterpret_cast<const bf16x8*>(a);
        bf16x8 b1 = *reinterpret_cast<const bf16x8*>(a + 32 * 256);
        p0 = __builtin_amdgcn_mfma_f32_32x32x16_bf16(b0, qr[d0], p0, 0, 0, 0);
        p1 = __builtin_amdgcn_mfma_f32_32x32x16_bf16(b1, qr[d0], p1, 0, 0, 0); }
}
template <int DH, bool SK>
__device__ __forceinline__ void pv_tile(f32x16* o, int vb0, bf16x8 pa0, bf16x8 pa1, bf16x8 pa2, bf16x8 pa3, bool act) {
    constexpr int HF = (DH / 32) * 512, KS = 2 * HF;
    if (SK && !act) return;
#define TRRD(dst, off) asm volatile("ds_read_b64_tr_b16 %0, %1 offset:%2" : "=&v"(dst) : "v"(vb0), "i"(off) : "memory")
#define PV_D0(d0) do { s16x4 l0, l1, l2, l3, h0, h1, h2, h3; constexpr int b_ = (d0) * 512; \
        TRRD(l0, b_); TRRD(h0, b_ + HF); TRRD(l1, b_ + KS); TRRD(h1, b_ + KS + HF); TRRD(l2, b_ + 2 * KS); TRRD(h2, b_ + 2 * KS + HF); TRRD(l3, b_ + 3 * KS); TRRD(h3, b_ + 3 * KS + HF); \
        asm volatile("s_waitcnt lgkmcnt(0)" ::: "memory"); SBAR();   \
        o[d0] = __builtin_amdgcn_mfma_f32_32x32x16_bf16(pa0, (bf16x8){l0[0], l0[1], l0[2], l0[3], h0[0], h0[1], h0[2], h0[3]}, o[d0], 0, 0, 0);   \
        o[d0] = __builtin_amdgcn_mfma_f32_32x32x16_bf16(pa1, (bf16x8){l1[0], l1[1], l1[2], l1[3], h1[0], h1[1], h1[2], h1[3]}, o[d0], 0, 0, 0);   \
        o[d0] = __builtin_amdgcn_mfma_f32_32x32x16_bf16(pa2, (bf16x8){l2[0], l2[1], l2[2], l2[3], h2[0], h2[1], h2[2], h2[3]}, o[d0], 0, 0, 0);   \
        o[d0] = __builtin_amdgcn_mfma_f32_32x32x16_bf16(pa3, (bf16x8){l3[0], l3[1], l3[2], l3[3], h3[0], h3[1], h3[2], h3[3]}, o[d0], 0, 0, 0); } while (0)
    PV_D0(0); PV_D0(1);
    if constexpr (DH == 128) { PV_D0(2); PV_D0(3); }
#undef PV_D0
#undef TRRD
}

struct BlockRef { const bf16_t* Q; const bf16_t* K; const bf16_t* V; float* scr; bf16_t* O; float* lse; int P0, dil, lgL, mode, ldo, head; float lam; };
template <int DH> struct Seam { bf16x8 qr[DH / 16]; bf16x8 st_v0, st_v1, st_k0, st_k1; };

template <bool BANDED> __device__ __forceinline__ int blk_lowk(int P0, int lgL) { const int ss = P0 & ~((1 << lgL) - 1); int lk = BANDED ? P0 - 128 : 0; return lk < ss ? ss : lk; }

#define VMW() asm volatile("s_waitcnt vmcnt(0)" ::: "memory")
#define VMWN(n) asm volatile("s_waitcnt vmcnt(%0)" :: "i"(n) : "memory")
#define TBASE(v0, dl, lg) ((size_t)(BANDED ? vrow_tok((v0), (dl), (lg)) : (v0)) * LDZ)
#define LOFF(rr, dl) ((unsigned)((rr) * (BANDED ? (dl) : 1) * LDZ + sc))
#define SLOAD_H(Kp, Vp, k0, dl, lg) do { const bf16_t* kp_ = (Kp) + TBASE(k0, dl, lg); const bf16_t* vp_ = (Vp) + TBASE(k0, dl, lg); const unsigned l0_ = LOFF(sr, dl); \
        S.st_v0 = ld8(vp_ + l0_); if constexpr (DH == 128) S.st_v1 = ld8(vp_ + LOFF(32 + sr, dl)); \
        S.st_k0 = ld8(kp_ + l0_); if constexpr (DH == 128) S.st_k1 = ld8(kp_ + LOFF(32 + sr, dl)); } while (0)
#define SWRITE_HK(so) do { *(bf16x8*)(K_lds + (so) + kws) = S.st_k0; if constexpr (DH == 128) *(bf16x8*)(K_lds + (so) + kws + 32 * 256) = S.st_k1; } while (0)
#define SWRITE_HV(so) do { *(bf16x8*)(V_lds + (so) + vst0) = S.st_v0; if constexpr (DH == 128) *(bf16x8*)(V_lds + (so) + vst1) = S.st_v1; } while (0)
#define SWRITE_H(so) do { SWRITE_HV(so); SWRITE_HK(so); } while (0)
#define STAGE_IDX() int sr, sc, vst0, vst1, kws; \
    if constexpr (DH == 128) { sr = tid >> 4; sc = (tid & 15) * 8; vst0 = v_st<DH>(sr, sc); vst1 = v_st<DH>(32 + sr, sc); kws = kswz<DH>(sr, sc * 2); } \
    else { sr = tid >> 3; sc = (tid & 7) * 8; vst0 = v_st<DH>(sr, sc); vst1 = 0; kws = kswz<DH>(sr, sc * 2); } (void)vst1

#ifdef NO_BIAS
#define BIAS_CALL(a,b,c) do {} while (0)
#else
#define BIAS_CALL(a,b,c) bias_tile(a,b,c)
#endif
template <int DH, bool BANDED>
__device__ __forceinline__ void attn_prime(const BlockRef& cur, char* lds, Seam<DH>& S, const int tid) {
    constexpr int SHM = 64 * DH * 2;
    const int wid = __builtin_amdgcn_readfirstlane(tid >> 6), lane = tid & 63, r32 = lane & 31, hi = lane >> 5;
    STAGE_IDX(); (void)vst0;
    char* K_lds = lds + 3 * SHM;
    const int kb0 = blk_lowk<BANDED>(cur.P0, cur.lgL) & ~63;
    const bf16_t* qp = cur.Q + TBASE(cur.P0 + wid * 32, cur.dil, cur.lgL) + (unsigned)(r32 * (BANDED ? cur.dil : 1) * LDZ + hi * 8);
#pragma unroll
    for (int d0 = 0; d0 < DH / 16; ++d0) S.qr[d0] = ld8(qp + d0 * 16);
    SLOAD_H(cur.K, cur.V, kb0, cur.dil, cur.lgL); VMW(); SWRITE_HK(0);
    __syncthreads();
}
template <int DH, bool BANDED>
__device__ __forceinline__ void attn_block(const BlockRef& cur, const BlockRef& nxt, char* lds, Seam<DH>& S, const int tid) {
    constexpr int SHM = 64 * DH * 2, NQ = DH / 16, ND = DH / 32;
    constexpr float SCALE = DH == 128 ? 0.08838834764831845f : 0.125f;
    constexpr bool SK = BANDED;
    const int wid = __builtin_amdgcn_readfirstlane(tid >> 6), lane = tid & 63, r32 = lane & 31, hi = lane >> 5;
    const int dil = cur.dil, lgL = cur.lgL, Lm = (1 << lgL) - 1;
    const int j_lo = blk_lowk<BANDED>(cur.P0, lgL) >> 6;
    const int NT = (cur.P0 >> 6) + 4 - j_lo;
    const int kbn = blk_lowk<BANDED>(nxt.P0, nxt.lgL) & ~63;
    const int qlo = cur.P0 + wid * 32, qv = qlo + r32, qm = qv - 4 * hi;
    unsigned Wl = 0x40000000u; int wlow = 0;
    if constexpr (BANDED) { const int l1 = (qv & Lm) + 1; Wl = (unsigned)(l1 < 129 ? l1 : 129); wlow = qlo - 128; const int ss = qlo & ~Lm; if (wlow < ss) wlow = ss; }
    char* V_lds = lds; char* K_lds = lds + 3 * SHM;
    float* ws = (float*)(lds + WS_OFF) + wid * 64; float* li_l = ws; float* al_l = ws + 32;
    const float* tab = (const float*)(lds + TAB_OFF) + (256 - 59);
    float m_reg = -1e30f, l_reg = 0; f32x16 o[ND];
#pragma unroll
    for (int d_ = 0; d_ < ND; ++d_) o[d_] = f32x16{};
    STAGE_IDX();
    const int vb0 = (int)(uintptr_t)V_lds + v_rd_base(lane);
    const bf16_t* Kh = cur.K; const bf16_t* Vh = cur.V;
#define RESC(a) do { if (__any((a) < 1.f)) { if (hi == 0) al_l[r32] = (a); asm volatile("s_waitcnt lgkmcnt(0)" ::: "memory");              \
                     _Pragma("unroll") for (int d_ = 0; d_ < ND; ++d_) _Pragma("unroll") for (int r = 0; r < 16; ++r) o[d_][r] *= al_l[crow(r, hi)]; } } while (0)
#define KBASE(t) ((j_lo + (t)) * 64)
#define ACT(t) (KBASE(t) <= qlo + 31 && KBASE(t) + 63 >= wlow)
#define MASKT(P0_, P1_, t) do { const int kb_ = KBASE(t); if (!SK || ACT(t)) { if (BANDED || kb_ + 63 > qlo) mask_tile(P0_, P1_, qm - kb_, Wl); } } while (0)
#define TBT(t) (tab + (qm - KBASE(t)))
#define SEAM_K0() do { VMWN(NQ); SWRITE_HK(0); SBAR(); } while (0)
    f32x16 pA0, pA1, pB0, pB1; float mnA, mnB, alA, alB; bf16x8 pa0, pa1, pa2, pa3;
    int s_prev = 0, s_cur = 0, s_next = SHM;
#define ROT() do { s_prev = s_cur; s_cur = s_next; s_next = (s_next == 2 * SHM) ? 0 : s_next + SHM; } while (0)
    SWRITE_HV(0); SBAR();
    if (NT > 1) SLOAD_H(Kh, Vh, KBASE(1), dil, lgL);
    SBAR(); qkt<DH, SK>(pA0, pA1, K_lds, r32, hi, S.qr, ACT(0), TBT(0));
    MASKT(pA0, pA1, 0); partialSM<DH>(pA0, pA1, m_reg, mnA, alA);
    if (NT > 1) { VMW(); SWRITE_H(SHM); }
    __syncthreads();
#define HALF_STEP(PX0, PX1, mnX, alX, PY0, PY1, alY, t) do {                                                                   \
        ROT();                                                                   \
        if ((t) + 1 < NT) { SLOAD_H(Kh, Vh, KBASE((t) + 1), dil, lgL); }                                                      \
        SBAR(); qkt<DH, SK>(PX0, PX1, K_lds + s_cur, r32, hi, S.qr, ACT(t), TBT(t));                                           \
        finishSM(PY0, PY1, alY, l_reg, pa0, pa1, pa2, pa3); SBAR();                                                           \
        pv_tile<DH, SK>(o, vb0 + s_prev, pa0, pa1, pa2, pa3, ACT((t) - 1)); MASKT(PX0, PX1, (t)); partialSM<DH>(PX0, PX1, m_reg, mnX, alX); \
        if ((t) + 1 < NT) { VMW(); SWRITE_H(s_next); }                                                                        \
        RESC(alX); __syncthreads(); } while (0)
    for (int t = 1; t + 1 < NT; t += 2) {
        HALF_STEP(pB0, pB1, mnB, alB, pA0, pA1, alA, t);
        HALF_STEP(pA0, pA1, mnA, alA, pB0, pB1, alB, t + 1);
    }
    const bool even = (NT & 1) == 0;
    if (even) { ROT(); SBAR(); qkt<DH, SK>(pB0, pB1, K_lds + s_cur, r32, hi, S.qr, ACT(NT - 1), TBT(NT - 1)); SBAR(); }
    SLOAD_H(nxt.K, nxt.V, kbn, nxt.dil, nxt.lgL); SBAR();
    { const bf16_t* qp = nxt.Q + TBASE(nxt.P0 + wid * 32, nxt.dil, nxt.lgL) + (unsigned)(r32 * (BANDED ? nxt.dil : 1) * LDZ + hi * 8);
#pragma unroll
      for (int d0 = 0; d0 < NQ; ++d0) S.qr[d0] = ld8(qp + d0 * 16); }
    SBAR();
    finishSM(pA0, pA1, alA, l_reg, pa0, pa1, pa2, pa3); SBAR();
    pv_tile<DH, SK>(o, vb0 + (even ? s_prev : s_cur), pa0, pa1, pa2, pa3, ACT(even ? NT - 2 : NT - 1));
    if (even) { MASKT(pB0, pB1, NT - 1); partialSM<DH>(pB0, pB1, m_reg, mnB, alB); __syncthreads();
        RESC(alB);
        finishSM(pB0, pB1, alB, l_reg, pa0, pa1, pa2, pa3); SBAR(); pv_tile<DH, SK>(o, vb0 + s_cur, pa0, pa1, pa2, pa3, ACT(NT - 1)); }
    SBAR(); SEAM_K0();
    if (hi == 0) li_l[r32] = l_reg; asm volatile("s_waitcnt lgkmcnt(0)" ::: "memory");
    float rli[16];
#pragma unroll
    for (int r = 0; r < 16; ++r) rli[r] = __builtin_amdgcn_rcpf(li_l[crow(r, hi)]);
    int lo_ = r32, hh_ = hi, ln_ = lane; asm volatile("" : "+v"(lo_), "+v"(hh_), "+v"(ln_));
    if constexpr (BANDED) {
        bf16_t* ob = cur.O + lo_;
#pragma unroll
        for (int r = 0; r < 16; ++r) { const int tokr = vrow_tok(qlo + (r & 3) + 8 * (r >> 2) + 4 * hh_, dil, lgL); bf16_t* op = ob + (size_t)tokr * cur.ldo;
            const float v0 = o[0][r] * rli[r], v1 = o[1][r] * rli[r]; const float n0 = __shfl_xor(v0, 1), n1 = __shfl_xor(v1, 1);
            if ((lo_ & 1) == 0) { *(unsigned*)(op) = cvtpk(v0, n0); *(unsigned*)(op + 32) = cvtpk(v1, n1); } }
        if (hh_ == 0) cur.lse[(size_t)vrow_tok(qlo + lo_, dil, lgL) * 24] = m_reg * SCALE + 0.6931471805599453f * __builtin_amdgcn_logf(l_reg);
    } else {
        float* sw = cur.scr + (size_t)(wid * 32) * DH + ln_;
        if (cur.mode == 0) {
#pragma unroll
            for (int r = 0; r < 16; ++r)
#pragma unroll
                for (int d0 = 0; d0 < ND; ++d0) sw[(r * ND + d0) * 64] = o[d0][r] * rli[r];
        } else {
            const float lam = cur.lam; bf16_t* ob = cur.O + (size_t)(qlo + 4 * hh_) * cur.ldo + lo_;
#pragma unroll
            for (int r = 0; r < 16; ++r) { bf16_t* op = ob + (size_t)((r & 3) + 8 * (r >> 2)) * cur.ldo;
                float v[ND], n[ND];
#pragma unroll
                for (int d0 = 0; d0 < ND; ++d0) { v[d0] = sw[(r * ND + d0) * 64] - lam * (o[d0][r] * rli[r]); n[d0] = __shfl_xor(v[d0], 1); }
                if ((lo_ & 1) == 0) {
#pragma unroll
                    for (int d0 = 0; d0 < ND; ++d0) *(unsigned*)(op + d0 * 32) = cvtpk(v[d0], n[d0]); }
                if (r & 1) asm volatile("" ::: "memory"); }
        }
    }
    __syncthreads();
#undef RESC
#undef KBASE
#undef ACT
#undef MASKT
#undef TBT
#undef SEAM_K0
#undef HALF_STEP
#undef ROT
}

#ifndef A3_OLDPV
#define A3_OLDPV 0
#endif
constexpr int A2_V = 0, A2_K = 65536, A2_P = 98304, A2_WS = 139264, A2_TAB = 141312, A2_LDS_END = A2_TAB + TAB_N * 4;
#ifndef A3VAR
#define A3VAR 0
#endif
__device__ __forceinline__ void attn_block2(const BlockRef& cur, char* lds, const int tid, const float* tabsrc  , const int var = 0) {
    constexpr int DH = 128, SHMK = 16384, SHMV = 32768;
    const int wid = __builtin_amdgcn_readfirstlane(tid >> 6), lane = tid & 63, r32 = lane & 31, hi = lane >> 5;
    const bool isS = wid < 4; const int pw = wid & 3;
    const int NT = (cur.P0 >> 6) + 2;
    const int qlo = cur.P0 + pw * 32, qv = qlo + r32, qm = qv - 4 * hi;
    char* V_lds = lds + A2_V; char* K_lds = lds + A2_K; char* P_lds = lds + A2_P;
    float* wsA = (float*)(lds + A2_WS);
    if (isS) {
        const float* tab = (const float*)(lds + A2_TAB) + (256 - 59);
        bf16x8 qr[8]; bf16x8 stk[4]; bf16x8 pa0, pa1, pa2, pa3;
        const int sr = tid >> 4, sc = (tid & 15) * 8;
        unsigned lk = (unsigned)(sr * LDZ + sc); asm volatile("" : "+v"(lk));
        const int kws = kswz<DH>(sr, sc * 2);
        { const bf16_t* qp = cur.Q + (size_t)qlo * LDZ + (unsigned)(r32 * LDZ + hi * 8);
#pragma unroll
          for (int d0 = 0; d0 < 8; ++d0) qr[d0] = ld8(qp + d0 * 16); }
#define KLOAD(t_) do { const bf16_t* kp_ = cur.K + (size_t)((t_) * 64) * LDZ; _Pragma("unroll") for (int i_ = 0; i_ < 4; ++i_) stk[i_] = ld8((kp_ + (size_t)(16 * i_) * LDZ) + lk); } while (0)
#define KWRITE(so) do { _Pragma("unroll") for (int i_ = 0; i_ < 4; ++i_) *(bf16x8*)(K_lds + (so) + kws + i_ * 16 * 256) = stk[i_]; } while (0)
        { bf16x8 stk2[4];
          const bf16_t* kp_ = cur.K;
#pragma unroll
          for (int i_ = 0; i_ < 4; ++i_) { stk[i_] = ld8((kp_ + (size_t)(16 * i_) * LDZ) + lk); stk2[i_] = ld8((kp_ + (size_t)(64 + 16 * i_) * LDZ) + lk); }
          if (tabsrc) { float* td = (float*)(lds + A2_TAB); for (int i_ = tid; i_ < TAB_N; i_ += 256) td[i_] = tabsrc[i_]; }
          VMW(); KWRITE(0);
#pragma unroll
          for (int i_ = 0; i_ < 4; ++i_) *(bf16x8*)(K_lds + SHMK + kws + i_ * 16 * 256) = stk2[i_]; }
        __syncthreads();
        float m_reg = -1e30f; f32x16 pA0, pA1, pB0, pB1; f32x16 lacc = f32x16{};
        const bf16x8 ones = (bf16x8){0x3F80, 0x3F80, 0x3F80, 0x3F80, 0x3F80, 0x3F80, 0x3F80, 0x3F80};
        qkt_bias128(pA0, pA1, K_lds, r32, hi, qr, tab + qm);
        __syncthreads();
#define SSTEP(PX0, PX1, PN0, PN1, t) do {                                                                                      \
            if ((t) + 2 < NT && !(var & 1)) KLOAD((t) + 2);                                                                     \
            SBAR(); if ((t) + 1 < NT) qkt_bias128(PN0, PN1, K_lds + (((t) + 1) & 1) * SHMK, r32, hi, qr, tab + (qm - ((t) + 1) * 64)); \
            float mn_, al_ = 1.f;                                                                                               \
            if (!(var & 2)) { { const int kb_ = (t) * 64; if (kb_ + 63 > qlo) mask_tile(PX0, PX1, qm - kb_, 0x40000000u); } \
            partialSM<DH>(PX0, PX1, m_reg, mn_, al_); }                                                                         \
            if (hi == 0) wsA[(((t) & 1) * 4 + pw) * 32 + r32] = al_;                                                            \
            if (!(var & 2)) { finishSM_ns(PX0, PX1, pa0, pa1, pa2, pa3);                                                        \
                if (__any(al_ < 1.f)) { const float* alw_ = wsA + (((t) & 1) * 4 + pw) * 32; asm volatile("s_waitcnt lgkmcnt(0)" ::: "memory"); _Pragma("unroll") for (int r = 0; r < 16; ++r) lacc[r] *= alw_[crow(r, hi)]; } \
                lacc = __builtin_amdgcn_mfma_f32_32x32x16_bf16(pa0, ones, lacc, 0, 0, 0); lacc = __builtin_amdgcn_mfma_f32_32x32x16_bf16(pa1, ones, lacc, 0, 0, 0); \
                lacc = __builtin_amdgcn_mfma_f32_32x32x16_bf16(pa2, ones, lacc, 0, 0, 0); lacc = __builtin_amdgcn_mfma_f32_32x32x16_bf16(pa3, ones, lacc, 0, 0, 0); } \
            else { lacc[0] += PX0[0] + PX1[0]; pa0 = (bf16x8){}; pa1 = pa0; pa2 = pa0; pa3 = pa0; }                             \
            { bf16x8* pp = (bf16x8*)(P_lds + ((t) & 1) * 16384 + pw * 4096) + lane; pp[0] = pa0; pp[64] = pa1; pp[128] = pa2; pp[192] = pa3; } \
            if ((t) + 2 < NT) { VMW(); KWRITE(((t) & 1) * SHMK); }                                                              \
            __syncthreads(); } while (0)
        for (int t = 0; t < NT; t += 2) {
            SSTEP(pA0, pA1, pB0, pB1, t);
            SSTEP(pB0, pB1, pA0, pA1, t + 1);
        }
        if (r32 == 0) {
#pragma unroll
            for (int r = 0; r < 16; ++r) wsA[256 + pw * 32 + crow(r, hi)] = lacc[r]; }
        __syncthreads();
#undef SSTEP
#undef KLOAD
#undef KWRITE
    } else {
        bf16x8 stv[8]; bf16x8 pa0, pa1, pa2, pa3;
        f32x16 o[8];
#pragma unroll
        for (int d_ = 0; d_ < 8; ++d_) o[d_] = f32x16{};
        const int vb0 = (int)(uintptr_t)V_lds + v_rd_base(lane);
        const int t2 = tid - 256, vr = t2 >> 5, vc = (t2 & 31) * 8;
        unsigned lv = (unsigned)(vr * LDZ + vc); asm volatile("" : "+v"(lv));
        const int vhalf = (vc >> 7) * 16384, vcc = vc & 127;
#define VLOAD(t_) do { const bf16_t* vp_ = cur.V + (size_t)((t_) * 64) * LDZ; _Pragma("unroll") for (int i_ = 0; i_ < 8; ++i_) stv[i_] = ld8((vp_ + (size_t)(8 * i_) * LDZ) + lv); } while (0)
#define VWRITE(so) do { _Pragma("unroll") for (int i_ = 0; i_ < 8; ++i_) *(bf16x8*)(V_lds + (so) + vhalf + v_st<DH>(vr + 8 * i_, vcc)) = stv[i_]; } while (0)
#define TR2(dl, dh, off) do { asm volatile("ds_read_b64_tr_b16 %0, %1 offset:%2" : "=&v"(dl) : "v"(vbx), "i"(off) : "memory"); asm volatile("ds_read_b64_tr_b16 %0, %1 offset:%2" : "=&v"(dh) : "v"(vbx), "i"((off) + 2048) : "memory"); } while (0)
#define LDD(fl, fh, d0) do { TR2(fl[0], fh[0], ((d0) >> 2) * 16384 + ((d0) & 3) * 512); TR2(fl[1], fh[1], ((d0) >> 2) * 16384 + ((d0) & 3) * 512 + 4096); \
                             TR2(fl[2], fh[2], ((d0) >> 2) * 16384 + ((d0) & 3) * 512 + 8192); TR2(fl[3], fh[3], ((d0) >> 2) * 16384 + ((d0) & 3) * 512 + 12288); } while (0)
#define FR(fl, fh, j) (bf16x8){fl[j][0], fl[j][1], fl[j][2], fl[j][3], fh[j][0], fh[j][1], fh[j][2], fh[j][3]}
#define MMD(fl, fh, d0) do { o[d0] = __builtin_amdgcn_mfma_f32_32x32x16_bf16(pa0, FR(fl, fh, 0), o[d0], 0, 0, 0); o[d0] = __builtin_amdgcn_mfma_f32_32x32x16_bf16(pa1, FR(fl, fh, 1), o[d0], 0, 0, 0); \
                             o[d0] = __builtin_amdgcn_mfma_f32_32x32x16_bf16(pa2, FR(fl, fh, 2), o[d0], 0, 0, 0); o[d0] = __builtin_amdgcn_mfma_f32_32x32x16_bf16(pa3, FR(fl, fh, 3), o[d0], 0, 0, 0); } while (0)
#define WL(n) asm volatile("s_waitcnt lgkmcnt(" #n ")" ::: "memory")
#define PVALL(slot_) do { const int vbx = vb0 + (slot_); s16x4 al_[4], ah_[4], bl_[4], bh_[4];                                   \
            LDD(al_, ah_, 0); LDD(bl_, bh_, 1);                                                                                 \
            WL(8); SBAR(); MMD(al_, ah_, 0); SBAR(); LDD(al_, ah_, 2);                                                           \
            WL(8); SBAR(); MMD(bl_, bh_, 1); SBAR(); LDD(bl_, bh_, 3);                                                           \
            WL(8); SBAR(); MMD(al_, ah_, 2); SBAR(); LDD(al_, ah_, 4);                                                           \
            WL(8); SBAR(); MMD(bl_, bh_, 3); SBAR(); LDD(bl_, bh_, 5);                                                           \
            WL(8); SBAR(); MMD(al_, ah_, 4); SBAR(); LDD(al_, ah_, 6);                                                           \
            WL(8); SBAR(); MMD(bl_, bh_, 5); SBAR(); LDD(bl_, bh_, 7);                                                           \
            WL(8); SBAR(); MMD(al_, ah_, 6); SBAR();                                                                             \
            WL(0); SBAR(); MMD(bl_, bh_, 7); SBAR();                                                                             \
            asm volatile("" :: "v"(pa0), "v"(pa1), "v"(pa2), "v"(pa3)); } while (0)
#define APPLY(tt) do { const float* alw = wsA + (((tt) & 1) * 4 + pw) * 32;                                                     \
            const bf16x8* pp = (const bf16x8*)(P_lds + ((tt) & 1) * 16384 + pw * 4096) + lane; pa0 = pp[0]; pa1 = pp[64]; pa2 = pp[128]; pa3 = pp[192]; \
            const float al = alw[r32];                                                                                          \
            if (__any(al < 1.f)) { _Pragma("unroll") for (int d_ = 0; d_ < 8; ++d_) _Pragma("unroll") for (int r = 0; r < 16; ++r) o[d_][r] *= alw[crow(r, hi)]; } \
            asm volatile("s_waitcnt lgkmcnt(0)" ::: "memory"); SBAR();                                                          \
            if (var & 4) { o[0][0] += alw[0]; } else if (A3_OLDPV) { pv_tile<DH, false>(o, vb0 + ((tt) & 1) * SHMV, pa0, pa1, pa2, pa3, true); pv_tile<DH, false>(o + 4, vb0 + ((tt) & 1) * SHMV + 16384, pa0, pa1, pa2, pa3, true); } else { PVALL(((tt) & 1) * SHMV); } } while (0)
        VLOAD(0);
        __syncthreads();
        __syncthreads();
        for (int t = 0; t < NT; ++t) {
            if (t > 0) APPLY(t - 1);
            VMW(); VWRITE((t & 1) * SHMV);
            if (t + 1 < NT && !(var & 1)) VLOAD(t + 1);
            __syncthreads();
        }
        APPLY(NT - 1);
        __syncthreads();
#undef APPLY
#undef PVALL
#undef WL
#undef MMD
#undef FR
#undef LDD
#undef TR2
#undef VLOAD
#undef VWRITE
        const float* li_l = wsA + 256 + pw * 32;
        float rli[16];
#pragma unroll
        for (int r = 0; r < 16; ++r) rli[r] = __builtin_amdgcn_rcpf(li_l[crow(r, hi)]);
        int lo_ = r32, hh_ = hi, ln_ = lane; asm volatile("" : "+v"(lo_), "+v"(hh_), "+v"(ln_));
        float* sw = cur.scr + (size_t)pw * 8192 + ln_;
        if (cur.mode == 3) {
            bf16_t* ob = cur.O + (size_t)(qlo + 4 * hh_) * cur.ldo + lo_;
#pragma unroll
            for (int r = 0; r < 16; ++r) { bf16_t* op = ob + (size_t)((r & 3) + 8 * (r >> 2)) * cur.ldo;
                float v[8], n[8];
#pragma unroll
                for (int d0 = 0; d0 < 8; ++d0) { v[d0] = o[d0][r] * rli[r]; n[d0] = __shfl_xor(v[d0], 1); }
                if ((lo_ & 1) == 0) {
#pragma unroll
                    for (int d0 = 0; d0 < 8; ++d0) *(unsigned*)(op + d0 * 32) = cvtpk(v[d0], n[d0]); } }
        } else if (cur.mode == 0) {
#pragma unroll
            for (int r = 0; r < 16; ++r)
#pragma unroll
                for (int d0 = 0; d0 < 8; ++d0) sw[(r * 8 + d0) * 64] = o[d0][r] * rli[r];
        } else {
            const float lam = cur.lam; bf16_t* ob = cur.O + (size_t)(qlo + 4 * hh_) * cur.ldo + lo_;
#pragma unroll
            for (int r = 0; r < 16; ++r) { bf16_t* op = ob + (size_t)((r & 3) + 8 * (r >> 2)) * cur.ldo;
                float v[8], n[8];
#pragma unroll
                for (int d0 = 0; d0 < 8; ++d0) { v[d0] = sw[(r * 8 + d0) * 64] - lam * (o[d0][r] * rli[r]); n[d0] = __shfl_xor(v[d0], 1); }
                if ((lo_ & 1) == 0) {
#pragma unroll
                    for (int d0 = 0; d0 < 8; ++d0) *(unsigned*)(op + d0 * 32) = cvtpk(v[d0], n[d0]); }
                asm volatile("" ::: "memory"); }
        }
    }
}

struct A3Ctx { const bf16_t* Z; bf16_t* O1; bf16_t* O2; const float* tabs; int vcu; };
__device__ __forceinline__ void a3_ref(const A3Ctx& c, int bi, const bf16_t*& Q, const bf16_t*& K, const bf16_t*& V, bf16_t*& O, int& P0, int& head) {
    const int x = c.vcu >> 5, w = c.vcu & 31, r = bi >> 1, k = bi & 1, bh = x * 16 + 2 * r + (w >> 4), j = w & 15, map = j >> 3, y = j & 7, b = bh >> 3, h = bh & 7;
    const int qb = k == 0 ? y : 15 - y; const bf16_t* Zb = c.Z + (size_t)b * 2048 * LDZ;
    Q = Zb + h * 256 + map * 128; K = Zb + 2048 + h * 256 + map * 128; V = Zb + 4096 + h * 256; O = (map == 0 ? c.O1 : c.O2) + (size_t)b * 2048 * 2048 + h * 256; P0 = qb * 128; head = h;
}
__device__ __forceinline__ void a3_S_loop(const A3Ctx& c, char* lds, const int wave) {
    constexpr int DH = 128, SHMK = 16384;
    char* K_lds = lds + A2_K; char* P_lds = lds + A2_P; float* wsA = (float*)(lds + A2_WS);
    const float* tab = (const float*)(lds + A2_TAB) + (256 - 59);
    const bf16x8 ones = (bf16x8){0x3F80, 0x3F80, 0x3F80, 0x3F80, 0x3F80, 0x3F80, 0x3F80, 0x3F80};
    int head = -1;
    for (int bi = 0; bi < 16; ++bi) {
        const bf16_t* Qp; const bf16_t* Kp; const bf16_t* Vp; bf16_t* Op; int P0, hd; a3_ref(c, bi, Qp, Kp, Vp, Op, P0, hd); (void)Vp; (void)Op;
        const int tid = pg8::fresh_tid(wave), lane = tid & 63, r32 = lane & 31, hi = lane >> 5, pw = wave;
        const int NT = (P0 >> 6) + 2, qlo = P0 + pw * 32, qv = qlo + r32, qm = qv - 4 * hi;
        bf16x8 qr[8]; bf16x8 stk[4]; bf16x8 pa0, pa1, pa2, pa3;
        const int sr = tid >> 4, sc = (tid & 15) * 8;
        unsigned lk = (unsigned)(sr * LDZ + sc); asm volatile("" : "+v"(lk));
        const int kws = kswz<DH>(sr, sc * 2);
        { const bf16_t* qp = Qp + (size_t)qlo * LDZ + (unsigned)(r32 * LDZ + hi * 8);
#pragma unroll
          for (int d0 = 0; d0 < 8; ++d0) qr[d0] = ld8(qp + d0 * 16); }
#define KLOAD(t_) do { const bf16_t* kp_ = Kp + (size_t)((t_) * 64) * LDZ; _Pragma("unroll") for (int i_ = 0; i_ < 4; ++i_) stk[i_] = ld8((kp_ + (size_t)(16 * i_) * LDZ) + lk); } while (0)
#define KWRITE(so) do { _Pragma("unroll") for (int i_ = 0; i_ < 4; ++i_) *(bf16x8*)(K_lds + (so) + kws + i_ * 16 * 256) = stk[i_]; } while (0)
        { bf16x8 stk2[4];
#pragma unroll
          for (int i_ = 0; i_ < 4; ++i_) { stk[i_] = ld8((Kp + (size_t)(16 * i_) * LDZ) + lk); stk2[i_] = ld8((Kp + (size_t)(64 + 16 * i_) * LDZ) + lk); }
          if (hd != head) { head = hd; const float* ts = c.tabs + (size_t)hd * TAB_N; float* td = (float*)(lds + A2_TAB); for (int i_ = tid; i_ < TAB_N; i_ += 256) td[i_] = ts[i_]; }
          VMW(); KWRITE(0);
#pragma unroll
          for (int i_ = 0; i_ < 4; ++i_) *(bf16x8*)(K_lds + SHMK + kws + i_ * 16 * 256) = stk2[i_]; }
        __syncthreads();
        float m_reg = -1e30f; f32x16 pA0, pA1, pB0, pB1; f32x16 lacc = f32x16{};
        qkt_bias128(pA0, pA1, K_lds, r32, hi, qr, tab + qm);
        __syncthreads();
#define SSTEP(PX0, PX1, PN0, PN1, t) do {                                                                                      \
            if ((t) + 2 < NT) KLOAD((t) + 2);                                                                                   \
            SBAR(); if ((t) + 1 < NT) qkt_bias128(PN0, PN1, K_lds + (((t) + 1) & 1) * SHMK, r32, hi, qr, tab + (qm - ((t) + 1) * 64)); \
            float mn_, al_;                                                                                                     \
            { const int kb_ = (t) * 64; if (kb_ + 63 > qlo) mask_tile(PX0, PX1, qm - kb_, 0x40000000u); }                       \
            partialSM<DH>(PX0, PX1, m_reg, mn_, al_);                                                                           \
            if (hi == 0) wsA[(((t) & 1) * 4 + pw) * 32 + r32] = al_;                                                            \
            finishSM_ns(PX0, PX1, pa0, pa1, pa2, pa3);                                                                          \
            if (__any(al_ < 1.f)) { const float* alw_ = wsA + (((t) & 1) * 4 + pw) * 32; asm volatile("s_waitcnt lgkmcnt(0)" ::: "memory"); _Pragma("unroll") for (int r = 0; r < 16; ++r) lacc[r] *= alw_[crow(r, hi)]; } \
            lacc = __builtin_amdgcn_mfma_f32_32x32x16_bf16(pa0, ones, lacc, 0, 0, 0); lacc = __builtin_amdgcn_mfma_f32_32x32x16_bf16(pa1, ones, lacc, 0, 0, 0); \
            lacc = __builtin_amdgcn_mfma_f32_32x32x16_bf16(pa2, ones, lacc, 0, 0, 0); lacc = __builtin_amdgcn_mfma_f32_32x32x16_bf16(pa3, ones, lacc, 0, 0, 0); \
            { bf16x8* pp = (bf16x8*)(P_lds + ((t) & 1) * 16384 + pw * 4096) + lane; pp[0] = pa0; pp[64] = pa1; pp[128] = pa2; pp[192] = pa3; } \
            if ((t) + 2 < NT) { VMW(); KWRITE(((t) & 1) * SHMK); }                                                              \
            __syncthreads(); } while (0)
        for (int t = 0; t < NT; t += 2) {
            SSTEP(pA0, pA1, pB0, pB1, t);
            SSTEP(pB0, pB1, pA0, pA1, t + 1);
        }
        if (r32 == 0) {
#pragma unroll
            for (int r = 0; r < 16; ++r) wsA[256 + pw * 32 + crow(r, hi)] = lacc[r]; }
        __syncthreads();
#undef SSTEP
#undef KLOAD
#undef KWRITE
    }
}
__device__ __forceinline__ void a3_V_loop(const A3Ctx& c, char* lds, const int wave) {
    constexpr int DH = 128, SHMV = 32768;
    char* V_lds = lds + A2_V; char* P_lds = lds + A2_P; float* wsA = (float*)(lds + A2_WS);
    const int pw = wave & 3;
    f32x16 o[8]; float rli[16]; bf16_t* Oprev = nullptr; int qlo_prev = 0;
#pragma unroll
    for (int d_ = 0; d_ < 8; ++d_) o[d_] = f32x16{};
#pragma unroll
    for (int r = 0; r < 16; ++r) rli[r] = 0.f;
#define A3_EPI() do { int lo_ = r32, hh_ = hi; asm volatile("" : "+v"(lo_), "+v"(hh_));                                          \
        bf16_t* ob = Oprev + (size_t)(qlo_prev + 4 * hh_) * 2048 + lo_;                                                        \
        _Pragma("unroll") for (int r = 0; r < 16; ++r) { bf16_t* op = ob + (size_t)((r & 3) + 8 * (r >> 2)) * 2048; float v[8], n[8]; \
            _Pragma("unroll") for (int d0 = 0; d0 < 8; ++d0) { v[d0] = o[d0][r] * rli[r]; n[d0] = __shfl_xor(v[d0], 1); }        \
            if ((lo_ & 1) == 0) { _Pragma("unroll") for (int d0 = 0; d0 < 8; ++d0) *(unsigned*)(op + d0 * 32) = cvtpk(v[d0], n[d0]); } } \
        _Pragma("unroll") for (int d_ = 0; d_ < 8; ++d_) o[d_] = f32x16{}; } while (0)
    for (int bi = 0; bi < 16; ++bi) {
        const bf16_t* Qp; const bf16_t* Kp; const bf16_t* Vp; bf16_t* Op; int P0, hd; a3_ref(c, bi, Qp, Kp, Vp, Op, P0, hd); (void)Qp; (void)Kp; (void)hd;
        const int tid = pg8::fresh_tid(wave), lane = tid & 63, r32 = lane & 31, hi = lane >> 5;
        const int NT = (P0 >> 6) + 2, qlo = P0 + pw * 32;
        bf16x8 stv[8]; bf16x8 pa0, pa1, pa2, pa3;
        const int vb0 = (int)(uintptr_t)V_lds + v_rd_base(lane);
        const int t2 = tid - 256, vr = t2 >> 5, vc = (t2 & 31) * 8;
        unsigned lv = (unsigned)(vr * LDZ + vc); asm volatile("" : "+v"(lv));
        const int vhalf = (vc >> 7) * 16384, vcc = vc & 127;
#define VLOAD(t_) do { const bf16_t* vp_ = Vp + (size_t)((t_) * 64) * LDZ; _Pragma("unroll") for (int i_ = 0; i_ < 8; ++i_) stv[i_] = ld8((vp_ + (size_t)(8 * i_) * LDZ) + lv); } while (0)
#define VWRITE(so) do { _Pragma("unroll") for (int i_ = 0; i_ < 8; ++i_) *(bf16x8*)(V_lds + (so) + vhalf + v_st<DH>(vr + 8 * i_, vcc)) = stv[i_]; } while (0)
#define TR2(dl, dh, off) do { asm volatile("ds_read_b64_tr_b16 %0, %1 offset:%2" : "=&v"(dl) : "v"(vbx), "i"(off) : "memory"); asm volatile("ds_read_b64_tr_b16 %0, %1 offset:%2" : "=&v"(dh) : "v"(vbx), "i"((off) + 2048) : "memory"); } while (0)
#define LDD(fl, fh, d0) do { TR2(fl[0], fh[0], ((d0) >> 2) * 16384 + ((d0) & 3) * 512); TR2(fl[1], fh[1], ((d0) >> 2) * 16384 + ((d0) & 3) * 512 + 4096); \
                             TR2(fl[2], fh[2], ((d0) >> 2) * 16384 + ((d0) & 3) * 512 + 8192); TR2(fl[3], fh[3], ((d0) >> 2) * 16384 + ((d0) & 3) * 512 + 12288); } while (0)
#define FR(fl, fh, j) (bf16x8){fl[j][0], fl[j][1], fl[j][2], fl[j][3], fh[j][0], fh[j][1], fh[j][2], fh[j][3]}
#define MMD(fl, fh, d0) do { o[d0] = __builtin_amdgcn_mfma_f32_32x32x16_bf16(pa0, FR(fl, fh, 0), o[d0], 0, 0, 0); o[d0] = __builtin_amdgcn_mfma_f32_32x32x16_bf16(pa1, FR(fl, fh, 1), o[d0], 0, 0, 0); \
                             o[d0] = __builtin_amdgcn_mfma_f32_32x32x16_bf16(pa2, FR(fl, fh, 2), o[d0], 0, 0, 0); o[d0] = __builtin_amdgcn_mfma_f32_32x32x16_bf16(pa3, FR(fl, fh, 3), o[d0], 0, 0, 0); } while (0)
#define WL(n) asm volatile("s_waitcnt lgkmcnt(" #n ")" ::: "memory")
#define PVALL(slot_) do { const int vbx = vb0 + (slot_); s16x4 al_[4], ah_[4], bl_[4], bh_[4];                                   \
            LDD(al_, ah_, 0); LDD(bl_, bh_, 1);                                                                                 \
            WL(8); SBAR(); MMD(al_, ah_, 0); SBAR(); LDD(al_, ah_, 2);                                                           \
            WL(8); SBAR(); MMD(bl_, bh_, 1); SBAR(); LDD(bl_, bh_, 3);                                                           \
            WL(8); SBAR(); MMD(al_, ah_, 2); SBAR(); LDD(al_, ah_, 4);                                                           \
            WL(8); SBAR(); MMD(bl_, bh_, 3); SBAR(); LDD(bl_, bh_, 5);                                                           \
            WL(8); SBAR(); MMD(al_, ah_, 4); SBAR(); LDD(al_, ah_, 6);                                                           \
            WL(8); SBAR(); MMD(bl_, bh_, 5); SBAR(); LDD(bl_, bh_, 7);                                                           \
            WL(8); SBAR(); MMD(al_, ah_, 6); SBAR();                                                                             \
            WL(0); SBAR(); MMD(bl_, bh_, 7); SBAR();                                                                             \
            asm volatile("" :: "v"(pa0), "v"(pa1), "v"(pa2), "v"(pa3)); } while (0)
#define APPLY(tt) do { const float* alw = wsA + (((tt) & 1) * 4 + pw) * 32;                                                     \
            const bf16x8* pp = (const bf16x8*)(P_lds + ((tt) & 1) * 16384 + pw * 4096) + lane; pa0 = pp[0]; pa1 = pp[64]; pa2 = pp[128]; pa3 = pp[192]; \
            const float al = alw[r32];                                                                                          \
            if (__any(al < 1.f)) { _Pragma("unroll") for (int d_ = 0; d_ < 8; ++d_) _Pragma("unroll") for (int r = 0; r < 16; ++r) o[d_][r] *= alw[crow(r, hi)]; } \
            asm volatile("s_waitcnt lgkmcnt(0)" ::: "memory"); SBAR();                                                          \
            PVALL(((tt) & 1) * SHMV); } while (0)
        VLOAD(0);
        __syncthreads();
        __syncthreads();
        if (bi > 0) A3_EPI();
        for (int t = 0; t < NT; ++t) {
            if (t > 0) APPLY(t - 1);
            VMW(); VWRITE((t & 1) * SHMV);
            if (t + 1 < NT) VLOAD(t + 1);
            __syncthreads();
        }
        APPLY(NT - 1);
        __syncthreads();
        { const float* li_l = wsA + 256 + pw * 32;
#pragma unroll
          for (int r = 0; r < 16; ++r) rli[r] = __builtin_amdgcn_rcpf(li_l[crow(r, hi)]); }
        Oprev = Op; qlo_prev = qlo;
        if (bi == 15) A3_EPI();
#undef APPLY
#undef PVALL
#undef WL
#undef MMD
#undef FR
#undef LDD
#undef TR2
#undef VLOAD
#undef VWRITE
    }
#undef A3_EPI
}
#undef VMW
#undef VMWN
#undef TBASE
#undef LOFF
#undef SLOAD_H
#undef SWRITE_HK
#undef SWRITE_HV
#undef SWRITE_H
#undef STAGE_IDX
#undef SBAR
}
#define GAS __attribute__((address_space(1)))
#define LAS __attribute__((address_space(3)))
typedef unsigned short bf16;
typedef unsigned v4u __attribute__((ext_vector_type(4)));
typedef float f32x4 __attribute__((ext_vector_type(4)));
typedef short bf16x8 __attribute__((ext_vector_type(8)));
typedef GAS unsigned gu32;
typedef GAS unsigned long long gu64;
#define RLX_AGENT __ATOMIC_RELAXED, __HIP_MEMORY_SCOPE_AGENT
#define LDS_WAIT() asm volatile("s_waitcnt lgkmcnt(0)" ::: "memory")
#define VM_WAIT() asm volatile("s_waitcnt vmcnt(0)" ::: "memory")
__device__ __forceinline__ unsigned long long rt() { return __builtin_amdgcn_s_memrealtime(); }
__device__ __forceinline__ unsigned f2bf(float f) { unsigned u = __builtin_bit_cast(unsigned, f); return (u + 0x7fffu + ((u >> 16) & 1u)) >> 16; }
__device__ __forceinline__ unsigned pk2(float lo, float hi) { return f2bf(lo) | (f2bf(hi) << 16); }

#define XB_TMO      128
#define XB_XCNT(j)  (256  + 64 * (j))
#define XB_XSUB(j)  (1280 + 64 * (j))
#define XB_XGEN(j)  (2304 + 64 * (j))
#define XB_TOP      3328
#define XB_TOPGEN   3392
#define XCD_BAR_WORDS 3456
#define XB_SPIN_CAP (1u << 18)

__device__ __forceinline__ unsigned xb_ld(unsigned* p)              { return __hip_atomic_load(p, __ATOMIC_RELAXED, __HIP_MEMORY_SCOPE_AGENT); }
__device__ __forceinline__ unsigned xb_add(unsigned* p, unsigned v) { return __hip_atomic_fetch_add(p, v, __ATOMIC_RELAXED, __HIP_MEMORY_SCOPE_AGENT); }
__device__ __forceinline__ unsigned xb_xcc_id() { return (unsigned)__builtin_amdgcn_s_getreg((3 << 11) | 20) & 0xFu; }
#define XB_SPIN(cond, bar) do { unsigned _sp = 0; while (cond) { __builtin_amdgcn_s_sleep(1); \
    if ((++_sp & 255u) == 0u) { if (xb_ld(&(bar)[XB_TMO])) break; if (_sp > XB_SPIN_CAP) { atomicAdd(&(bar)[XB_TMO], 1u); break; } } } } while (0)

struct XcdBarrier {
    unsigned* bar; unsigned x;
    volatile LAS unsigned* st;
};

__device__ __forceinline__ XcdBarrier xcd_barrier_post(unsigned* bar, volatile LAS unsigned* st) {
    XcdBarrier b; b.bar = bar; b.x = xb_xcc_id(); b.st = st;
    if (threadIdx.x == 0) (void)xb_add(&bar[XB_XCNT(b.x)], 1u);
    return b;
}
__device__ __forceinline__ void xcd_barrier_complete(unsigned* bar, unsigned x, unsigned& nloc, unsigned& nx) {
    const unsigned G = gridDim.x * gridDim.y * gridDim.z;
    unsigned sum, cnt, mine, sp = 0u;
    for (;;) {
        sum = 0u; cnt = 0u; mine = 0u;
#pragma unroll
        for (unsigned j = 0; j < 16; ++j) { const unsigned c = xb_ld(&bar[XB_XCNT(j)]); sum += c; cnt += (c > 0u) ? 1u : 0u; mine = (j == x) ? c : mine; }
        if (sum == G) break;
        __builtin_amdgcn_s_sleep(1);
        if ((++sp & 255u) == 0u) { if (xb_ld(&bar[XB_TMO])) break; if (sp > XB_SPIN_CAP) { atomicAdd(&bar[XB_TMO], 1u); break; } }
    }
    nloc = mine > 0u ? mine : 1u; nx = cnt > 0u ? cnt : 1u;
}

__device__ __forceinline__ void xcd_barrier(const XcdBarrier& b) {
    asm volatile("s_waitcnt vmcnt(0)" ::: "memory");
    __syncthreads();
    if (threadIdx.x == 0) {
        unsigned* bar = b.bar;
        __builtin_amdgcn_s_waitcnt(0);
        unsigned nloc = b.st[0], nx = b.st[1];
        if (nloc == 0u) { xcd_barrier_complete(bar, b.x, nloc, nx); b.st[0] = nloc; b.st[1] = nx; }
        const unsigned old = xb_add(&bar[XB_XSUB(b.x)], 1u);
        const unsigned gen = old / nloc;
        if (old + 1u == (gen + 1u) * nloc) {
            __builtin_amdgcn_fence(__ATOMIC_RELEASE, "agent");
            asm volatile("s_waitcnt vmcnt(0)" ::: "memory");
            const unsigned og = xb_add(&bar[XB_TOP], 1u);
            const unsigned tg = og / nx;
            if (og + 1u == (tg + 1u) * nx) xb_add(&bar[XB_TOPGEN], 1u);
            else XB_SPIN(xb_ld(&bar[XB_TOPGEN]) == tg, bar);
            __builtin_amdgcn_fence(__ATOMIC_ACQUIRE, "agent");
            xb_add(&bar[XB_XGEN(b.x)], 1u);
            asm volatile("s_waitcnt vmcnt(0)" ::: "memory");
        } else {
            XB_SPIN(xb_ld(&bar[XB_XGEN(b.x)]) == gen, bar);
            __builtin_amdgcn_fence(__ATOMIC_ACQUIRE, "agent");
            asm volatile("s_waitcnt vmcnt(0)" ::: "memory");
        }
    }
    __syncthreads();
}


constexpr int NWAVES = 8;
#ifndef MK_N_LAUNCHES
#define MK_N_LAUNCHES 1
#endif
#ifndef ATT_A2
#define ATT_A2 1
#endif
#ifndef P1_NOEPI
#define P1_NOEPI 0
#endif
#ifndef P4_SWAP
#define P4_SWAP 0
#endif
#ifndef P1_SWAP
#define P1_SWAP 1
#endif
#ifndef P1_ALIGN
#define P1_ALIGN true
#endif
constexpr int NPH = 13;
constexpr int T = 32768, DM = 2048, SEQ = 2048, NZ = 10752, NCAT = 14848, PLED = 256, NEXP = 32, DE = 1024, MAXROWS = 2 * T + NEXP * 256;
constexpr size_t MiB = 1u << 20;
constexpr size_t WS_CTL = 0, CTL_ZERO_BYTES = 1 * MiB;
constexpr size_t WS_TAB = 1 * MiB, WS_LAM = WS_TAB + 512 * 1024, WS_RINV1 = WS_TAB + 640 * 1024, WS_RINV2 = WS_TAB + 768 * 1024;
constexpr size_t WS_X3 = 378 * MiB;
constexpr size_t WS_H38 = 234 * MiB + 76 * MiB;
constexpr size_t WS_H8 = 538 * MiB + 384 * MiB;
constexpr size_t WS_TOKE = 2 * MiB, WS_TOKW = WS_TOKE + 256 * 1024, WS_ROWT = WS_TOKE + 512 * 1024, WS_ROWW = WS_TOKE + 832 * 1024, WS_TILE = WS_TOKE + 1152 * 1024, WS_TOKP = WS_TOKE + 1280 * 1024, WS_WRT = WS_TOKE + 1536 * 1024;
constexpr size_t WS_WCAT = 4 * MiB, WS_PA = 62 * MiB, WS_PB = 70 * MiB, WS_WOUT = 72 * MiB, WS_WPG = 80 * MiB, WS_WPP = 88 * MiB;
#ifndef P1F8
#define P1F8 1
#endif
constexpr size_t WS_WB8 = P1F8 == 2 ? 4 * MiB : 4 * MiB + 40 * MiB;
constexpr size_t WS_HP8 = 234 * MiB;
constexpr size_t WS_PBF = 90 * MiB;
constexpr size_t WS_R1 = 106 * MiB;
constexpr size_t WS_R2 = 234 * MiB;
constexpr size_t WS_OG = WS_R2, WS_LSE = WS_R2 + 96 * MiB, WS_SCRA = WS_R2 + 100 * MiB, WS_HDN = WS_R2;
constexpr size_t WS_R3 = 378 * MiB;
constexpr size_t WS_OA = WS_R3, WS_OB = WS_R3 + 128 * MiB;
constexpr size_t WS_Z = 538 * MiB;
constexpr size_t WS_WE13 = WS_Z, WS_WE2 = WS_Z + 256 * MiB, WS_SP = WS_Z + 384 * MiB;
constexpr size_t WS_RT = 1210 * MiB;
constexpr size_t WS_END = 1218 * MiB;
constexpr int CW_BAR = 4096, CW_CUR = 16384;
constexpr int RING_OFF = 0, RING_BYTES = 131072, LDSCTL_OFF = RING_BYTES, MISC_OFF = LDSCTL_OFF + 320, LDS_BYTES = 163840;
static_assert(att::ATT_LDS <= RING_BYTES && att::A2_P + 32768 <= LDSCTL_OFF && att::A2_WS >= MISC_OFF + 4096 && att::A2_LDS_END <= LDS_BYTES, "attention LDS");
constexpr int MOE_TS = MISC_OFF + 1024, MOE_CN = MISC_OFF + 1280, MOE_TE = MISC_OFF + 2048;

struct Frame { LAS unsigned char* lds; volatile LAS unsigned* MISC; gu32* ctl; int tid, lane, wave, vcu, G; };

__device__ __forceinline__ float wave_sum(float v) {
#pragma unroll
    for (int o = 1; o < 64; o <<= 1) v += __shfl_xor(v, o);
    return v;
}
__device__ __forceinline__ float dot4(f32x4 a, f32x4 b) { return (a.x * b.x + a.y * b.y) + (a.z * b.z + a.w * b.w); }
__device__ __forceinline__ void rms_row_bf16(const float* xrow, const f32x4 (&g)[8], bf16* orow, float eps, int lane, unsigned char* o8row = nullptr  ) {
    const GAS f32x4* xr = (const GAS f32x4*)xrow + lane;
    f32x4 v[8]; float s = 0.f;
#pragma unroll
    for (int j = 0; j < 8; ++j) { v[j] = xr[64 * j]; s += dot4(v[j], v[j]); }
    const float r = 1.0f / sqrtf(wave_sum(s) * (1.f / 2048.f) + eps);
    GAS unsigned long long* o8 = (GAS unsigned long long*)orow + lane;
#pragma unroll
    for (int j = 0; j < 8; ++j) { const f32x4 y = v[j] * r * g[j]; o8[64 * j] = (unsigned long long)pk2(y.x, y.y) | ((unsigned long long)pk2(y.z, y.w) << 32);
        if (o8row) ((GAS unsigned*)o8row)[lane + 64 * j] = (unsigned)__builtin_amdgcn_cvt_pk_fp8_f32(y.z, y.w, __builtin_amdgcn_cvt_pk_fp8_f32(y.x, y.y, 0, false), true); }
}
__device__ __forceinline__ int t5_bucket(int d) {
    if (d < 16) return d;
    return 16 + (d >= 22) + (d >= 30) + (d >= 40) + (d >= 54) + (d >= 73) + (d >= 99) + (d >= 134) + (d >= 182) + (d >= 246) + (d >= 332) + (d >= 450) + (d >= 609) + (d >= 825) + (d >= 1117) + (d >= 1513);
}

struct Args { const float* in[24]; float* out; unsigned char* ws; int ph_lo, ph_hi; };
enum { I_X = 0, I_P, I_RELB, I_NMIXG, I_WIN, I_WGATE, I_LQ1, I_LK1, I_LQ2, I_LK2, I_SUBLN, I_WPA, I_WPB, I_WOUT, I_NFFNG, I_WCOARSE, I_WFINE, I_W1, I_W3, I_W2, I_NPLEG, I_WPLEG, I_WPLEP, I_FNG };

__device__ __forceinline__ void conv64_f8(const float* W, int ldw, int k0, int n0, unsigned char* WT, int ldt, size_t rbase, int il, int lane) {
    const int ng = lane & 15, kg = lane >> 4;
    const GAS f32x4* src = (const GAS f32x4*)(W + (size_t)(k0 + 16 * kg) * ldw + n0) + ng; const size_t rs = (size_t)(ldw >> 2);
    f32x4 v[16];
#pragma unroll
    for (int kk = 0; kk < 16; ++kk) v[kk] = src[kk * rs] * 32.f;
#pragma unroll
    for (int j = 0; j < 4; ++j) { const int n = n0 + 4 * ng + j; const size_t r = rbase + (il ? (size_t)((n >> 7) * 256 + (n & 127)) : (size_t)n);
        v4u o;
        o.x = (unsigned)__builtin_amdgcn_cvt_pk_fp8_f32(v[2][j], v[3][j], __builtin_amdgcn_cvt_pk_fp8_f32(v[0][j], v[1][j], 0, false), true);
        o.y = (unsigned)__builtin_amdgcn_cvt_pk_fp8_f32(v[6][j], v[7][j], __builtin_amdgcn_cvt_pk_fp8_f32(v[4][j], v[5][j], 0, false), true);
        o.z = (unsigned)__builtin_amdgcn_cvt_pk_fp8_f32(v[10][j], v[11][j], __builtin_amdgcn_cvt_pk_fp8_f32(v[8][j], v[9][j], 0, false), true);
        o.w = (unsigned)__builtin_amdgcn_cvt_pk_fp8_f32(v[14][j], v[15][j], __builtin_amdgcn_cvt_pk_fp8_f32(v[12][j], v[13][j], 0, false), true);
        *(GAS v4u*)(WT + r * ldt + k0 + 16 * kg) = o; }
}
__device__ __forceinline__ void conv64_bf16(const float* W, int ldw, int k0, int n0, bf16* WT, int ldt, size_t rbase, int lane) {
    const int ng = lane & 15, kg = lane >> 4;
    const GAS f32x4* src = (const GAS f32x4*)(W + (size_t)(k0 + 16 * kg) * ldw + n0) + ng; const size_t rs = (size_t)(ldw >> 2);
    f32x4 v[16];
#pragma unroll
    for (int kk = 0; kk < 16; ++kk) v[kk] = src[kk * rs];
#pragma unroll
    for (int j = 0; j < 4; ++j) { const size_t r = rbase + (size_t)(n0 + 4 * ng + j);
        v4u lo, hi; lo.x = pk2(v[0][j], v[1][j]); lo.y = pk2(v[2][j], v[3][j]); lo.z = pk2(v[4][j], v[5][j]); lo.w = pk2(v[6][j], v[7][j]);
        hi.x = pk2(v[8][j], v[9][j]); hi.y = pk2(v[10][j], v[11][j]); hi.z = pk2(v[12][j], v[13][j]); hi.w = pk2(v[14][j], v[15][j]);
        GAS v4u* d = (GAS v4u*)(WT + r * ldt + k0 + 16 * kg); d[0] = lo; d[1] = hi; }
}
__device__ __forceinline__ void conv_item(const Args& a, int id, int lane) {
    unsigned char* ws = a.ws; const int which = id >> 13, e = (id >> 8) & 31, r = id & 255;
    if (which < 2) { const int nb = r & 15, kb = r >> 4; const float* W = (which == 0 ? a.in[I_W1] : a.in[I_W3]) + (size_t)e * DM * DE;
        conv64_f8(W, DE, 128 * kb, 64 * nb, ws + WS_WE13, DM, (size_t)e * 2048 + (which ? 128 : 0), 1, lane); conv64_f8(W, DE, 128 * kb + 64, 64 * nb, ws + WS_WE13, DM, (size_t)e * 2048 + (which ? 128 : 0), 1, lane); }
    else { const int nb = r & 31, kb = r >> 5; const float* W = a.in[I_W2] + (size_t)e * DE * DM;
        conv64_f8(W, DM, 128 * kb, 64 * nb, ws + WS_WE2, DE, (size_t)e * 2048, 0, lane); conv64_f8(W, DM, 128 * kb + 64, 64 * nb, ws + WS_WE2, DE, (size_t)e * 2048, 0, lane); }
}
constexpr int CONV_ITEMS = 3 * 8192;
struct ConvCall { const float* W; unsigned char* WT; int ldw, ldt, k0, n0, il; size_t rbase; };
__device__ __forceinline__ ConvCall conv_call(const Args& a, int id, int half) {
    unsigned char* ws = a.ws; const int which = id >> 13, e = (id >> 8) & 31, r = id & 255; ConvCall c;
    if (which < 2) { const int nb = r & 15, kb = r >> 4; c.W = (which == 0 ? a.in[I_W1] : a.in[I_W3]) + (size_t)e * DM * DE; c.ldw = DE; c.k0 = 128 * kb + 64 * half; c.n0 = 64 * nb; c.WT = ws + WS_WE13; c.ldt = DM; c.rbase = (size_t)e * 2048 + (which ? 128 : 0); c.il = 1; }
    else { const int nb = r & 31, kb = r >> 5; c.W = a.in[I_W2] + (size_t)e * DE * DM; c.ldw = DM; c.k0 = 128 * kb + 64 * half; c.n0 = 64 * nb; c.WT = ws + WS_WE2; c.ldt = DE; c.rbase = (size_t)e * 2048; c.il = 0; }
    return c;
}
__device__ __forceinline__ void conv64_load(f32x4 (&v)[16], const ConvCall& c, int lane) {
    const int ng = lane & 15, kg = lane >> 4;
    const GAS f32x4* src = (const GAS f32x4*)(c.W + (size_t)(c.k0 + 16 * kg) * c.ldw + c.n0) + ng; const size_t rs = (size_t)(c.ldw >> 2);
#pragma unroll
    for (int kk = 0; kk < 16; ++kk) v[kk] = src[kk * rs];
}
__device__ __forceinline__ void conv64_store(const f32x4 (&v)[16], const ConvCall& c, int lane) {
    const int ng = lane & 15, kg = lane >> 4;
#pragma unroll
    for (int j = 0; j < 4; ++j) { const int n = c.n0 + 4 * ng + j; const size_t r = c.rbase + (c.il ? (size_t)((n >> 7) * 256 + (n & 127)) : (size_t)n);
        v4u o;
        o.x = (unsigned)__builtin_amdgcn_cvt_pk_fp8_f32(v[2][j] * 32.f, v[3][j] * 32.f, __builtin_amdgcn_cvt_pk_fp8_f32(v[0][j] * 32.f, v[1][j] * 32.f, 0, false), true);
        o.y = (unsigned)__builtin_amdgcn_cvt_pk_fp8_f32(v[6][j] * 32.f, v[7][j] * 32.f, __builtin_amdgcn_cvt_pk_fp8_f32(v[4][j] * 32.f, v[5][j] * 32.f, 0, false), true);
        o.z = (unsigned)__builtin_amdgcn_cvt_pk_fp8_f32(v[10][j] * 32.f, v[11][j] * 32.f, __builtin_amdgcn_cvt_pk_fp8_f32(v[8][j] * 32.f, v[9][j] * 32.f, 0, false), true);
        o.w = (unsigned)__builtin_amdgcn_cvt_pk_fp8_f32(v[14][j] * 32.f, v[15][j] * 32.f, __builtin_amdgcn_cvt_pk_fp8_f32(v[12][j] * 32.f, v[13][j] * 32.f, 0, false), true);
        *(GAS v4u*)(c.WT + r * c.ldt + c.k0 + 16 * kg) = o; }
}

__device__ __forceinline__ void p0_prologue(Frame& F, const Args& a) {
    unsigned char* ws = a.ws;
    const int gw = F.vcu * NWAVES + F.wave, NGW = F.G * NWAVES;
    static_assert(P1F8 == 1, "the prologue converts the weights for the P1F8 == 1 split");
    constexpr int F_DIL = 72 * 16, F_G = 64 * 16, F_PG = 32 * 16, NF = F_DIL + F_G + F_PG;
    constexpr int B_A = 96 * 32, B_PA = 32 * 32, B_PB = 32 * 8, B_OUT = 32 * 32, B_PP = 32 * 4, NB = B_A + B_PA + B_PB + B_OUT + B_PP;
    for (int it = gw; it < NF + NB; it += NGW) {
        int r = it;
        if (r < NF) { const float* W; int ldw, nbn; unsigned char* dst; size_t rbase;
            if (r < F_DIL) { W = a.in[I_WIN] + 6144; ldw = NZ; nbn = 72; dst = ws + WS_WB8; rbase = 0; }
            else if ((r -= F_DIL) < F_G) { W = a.in[I_WGATE]; ldw = 4096; nbn = 64; dst = ws + WS_WB8; rbase = 4608; }
            else { r -= F_G; W = a.in[I_WPLEG]; ldw = DM; nbn = 32; dst = ws + WS_WPG; rbase = 0; }
            const int nb = r % nbn, kb = r / nbn;
            conv64_f8(W, ldw, 128 * kb, 64 * nb, dst, DM, rbase, 0, F.lane); conv64_f8(W, ldw, 128 * kb + 64, 64 * nb, dst, DM, rbase, 0, F.lane);
        } else { r -= NF; const float* W; int ldw, nbn, ldt; bf16* dst;
            if (r < B_A) { W = a.in[I_WIN]; ldw = NZ; nbn = 96; dst = (bf16*)(ws + WS_WCAT); ldt = DM; }
            else if ((r -= B_A) < B_PA) { W = a.in[I_WPA]; ldw = DM; nbn = 32; dst = (bf16*)(ws + WS_PA); ldt = DM; }
            else if ((r -= B_PA) < B_PB) { W = a.in[I_WPB]; ldw = DM; nbn = 32; dst = (bf16*)(ws + WS_PB); ldt = 512; }
            else if ((r -= B_PB) < B_OUT) { W = a.in[I_WOUT]; ldw = DM; nbn = 32; dst = (bf16*)(ws + WS_WOUT); ldt = DM; }
            else { r -= B_OUT; W = a.in[I_WPLEP]; ldw = DM; nbn = 32; dst = (bf16*)(ws + WS_WPP); ldt = PLED; }
            const int nb = r % nbn, kb = r / nbn;
            conv64_bf16(W, ldw, 64 * kb, 64 * nb, dst, ldt, 0, F.lane);
        }
    }
    { f32x4 g[8];
#pragma unroll
      for (int j = 0; j < 8; ++j) g[j] = ((const f32x4*)a.in[I_NMIXG])[F.lane + 64 * j];
      auto ld = [&](f32x4 (&v)[8], int m) { const GAS f32x4* xr = (const GAS f32x4*)(a.in[I_X] + (size_t)m * DM) + F.lane;
#pragma unroll
          for (int j = 0; j < 8; ++j) v[j] = xr[64 * j]; };
      auto fin = [&](const f32x4 (&v)[8], int m) { float s = 0.f;
#pragma unroll
          for (int j = 0; j < 8; ++j) s += dot4(v[j], v[j]);
          const float r = 1.0f / sqrtf(wave_sum(s) * (1.f / 2048.f) + 1e-6f);
          GAS unsigned long long* o8 = (GAS unsigned long long*)((bf16*)(ws + WS_R1) + (size_t)m * DM) + F.lane; GAS unsigned* q8 = (GAS unsigned*)(ws + WS_HP8 + (size_t)m * DM) + F.lane;
#pragma unroll
          for (int j = 0; j < 8; ++j) { const f32x4 y = v[j] * r * g[j]; o8[64 * j] = (unsigned long long)pk2(y.x, y.y) | ((unsigned long long)pk2(y.z, y.w) << 32);
              q8[64 * j] = (unsigned)__builtin_amdgcn_cvt_pk_fp8_f32(y.z, y.w, __builtin_amdgcn_cvt_pk_fp8_f32(y.x, y.y, 0, false), true); } };
      f32x4 va[8], vb[8];
      if (gw < T) ld(va, gw);
      for (int m = gw; m < T; m += 2 * NGW) {
          const bool hb = m + NGW < T; if (hb) ld(vb, m + NGW);
          asm volatile("" ::: "memory"); fin(va, m);
          if (m + 2 * NGW < T) ld(va, m + 2 * NGW);
          asm volatile("" ::: "memory"); if (hb) fin(vb, m + NGW);
      } }
    { const f32x4* p4 = (const f32x4*)a.in[I_P]; v4u* o = (v4u*)(ws + WS_PBF); const size_t n8 = (size_t)T * PLED / 8, st = (size_t)NGW * 64;
      for (size_t i0 = (size_t)gw * 64 + F.lane; i0 < n8; i0 += 8 * st) { f32x4 u0[8], u1[8];
#pragma unroll
          for (int j = 0; j < 8; ++j) { const size_t i = i0 + j * st; if (i < n8) { u0[j] = p4[2 * i]; u1[j] = p4[2 * i + 1]; } }
#pragma unroll
          for (int j = 0; j < 8; ++j) { const size_t i = i0 + j * st; if (i < n8) { v4u w; w.x = pk2(u0[j].x, u0[j].y); w.y = pk2(u0[j].z, u0[j].w); w.z = pk2(u1[j].x, u1[j].y); w.w = pk2(u1[j].z, u1[j].w); o[i] = w; } } } }
    { float* tabs = (float*)(ws + WS_TAB); const float* rb = a.in[I_RELB];
      for (int e = (F.vcu * NWAVES * 64) + F.tid; e < 32 * att::TAB_N; e += F.G * NWAVES * 64) {
          const int head = e / att::TAB_N, d = e % att::TAB_N - 256; float v = 0.f;
          if (head < 8) { if (d >= 0 && d < 2048) v = rb[t5_bucket(d) * 32 + head] * 11.313708498984761f; }
          else { const int g = (head - 8) >> 3, dil = g == 0 ? 1 : (g == 1 ? 4 : 16); if (d >= 0 && d <= 128) v = rb[t5_bucket(d * dil) * 32 + head] * 8.0f; }
          tabs[e] = v; } }
    { float* wrt = (float*)(ws + WS_WRT); const float* wc = a.in[I_WCOARSE]; const float* wf = a.in[I_WFINE]; const float* gf = a.in[I_NFFNG];
      for (int e = (F.vcu * NWAVES * 64) + F.tid; e < 48 * DM; e += F.G * NWAVES * 64) { const int i = e & 7, ln = (e >> 3) & 63, cb = e >> 9, b = cb % 3, c = cb / 3, n = ln & 15, kq = ln >> 4, k = 32 * c + 8 * kq + i, col = 16 * b + n;
          const float w = col < 4 ? wc[k * 4 + col] : (col < 36 ? wf[(size_t)((col - 4) >> 3) * DM * 8 + k * 8 + ((col - 4) & 7)] : 0.f);
          wrt[e] = w * gf[k]; } }
    if (F.vcu == 0 && F.wave == 0) {
        const float* q1 = a.in[I_LQ1]; const float* k1 = a.in[I_LK1]; const float* q2 = a.in[I_LQ2]; const float* k2 = a.in[I_LK2];
        const float s1 = wave_sum(q1[F.lane] * k1[F.lane] + q1[F.lane + 64] * k1[F.lane + 64]), s2 = wave_sum(q2[F.lane] * k2[F.lane] + q2[F.lane + 64] * k2[F.lane + 64]);
        if (F.lane == 0) *(float*)(ws + WS_LAM) = expf(s1) - expf(s2) + 0.2f;
    }
}
__device__ __forceinline__ void p3_post_attn(Frame& F, const Args& a) {
    unsigned char* ws = a.ws;
    const int gw = F.vcu * NWAVES + F.wave, NGW = F.G * NWAVES, lane = F.lane;
    const bf16* Cb = (const bf16*)(ws + WS_R1); const bf16* C2 = (const bf16*)(ws + WS_OA); const float lam = *(const float*)(ws + WS_LAM); const bf16* OG = (const bf16*)(ws + WS_OG); const float* LSE = (const float*)(ws + WS_LSE);
    bf16* OA = (bf16*)(ws + WS_OA); bf16* OB = (bf16*)(ws + WS_OB);
    const f32x4 ga = ((const f32x4*)a.in[I_SUBLN])[2 * (lane & 31)], gb = ((const f32x4*)a.in[I_SUBLN])[2 * (lane & 31) + 1];
    struct Row { v4u w[4], w2[4], og[3]; float l0, l1, l2; };
    auto ld = [&](Row& R, int row) { const v4u* cp = (const v4u*)(Cb + (size_t)row * DM); const v4u* cp2 = (const v4u*)(C2 + (size_t)row * DM);
#pragma unroll
        for (int j = 0; j < 4; ++j) { R.w[j] = cp[lane + 64 * j]; R.w2[j] = cp2[lane + 64 * j]; }
        const int hh = lane >> 3; R.l0 = LSE[(size_t)row * 24 + hh]; R.l1 = LSE[(size_t)row * 24 + 8 + hh]; R.l2 = LSE[(size_t)row * 24 + 16 + hh];
        const v4u* gp = (const v4u*)(OG + (size_t)row * 1536); R.og[0] = gp[lane]; R.og[1] = gp[64 + lane]; R.og[2] = gp[128 + lane]; };
    auto fin = [&](const Row& R, int row) { v4u* op = (v4u*)(OA + (size_t)row * DM);
#pragma unroll
        for (int j = 0; j < 4; ++j) { pg8::F8 v = pg8::unpk8(R.w[j]); const pg8::F8 u2 = pg8::unpk8(R.w2[j]); v.a = v.a - u2.a * lam; v.b = v.b - u2.b * lam; float s = dot4(v.a, v.a) + dot4(v.b, v.b);
            s += __shfl_xor(s, 1); s += __shfl_xor(s, 2); s += __shfl_xor(s, 4); s += __shfl_xor(s, 8); s += __shfl_xor(s, 16);
            const float r = 0.8f / sqrtf(s * (1.f / 256.f) + 1e-5f);
            op[lane + 64 * j] = pg8::pk8(v.a * r * ga, v.b * r * gb); }
        const float l0 = R.l0, l1 = R.l1, l2 = R.l2;
        const float mx = fmaxf(l0, fmaxf(l1, l2)); const float e0 = __expf(l0 - mx), e1 = __expf(l1 - mx), e2 = __expf(l2 - mx); const float inv = 1.f / (e0 + e1 + e2);
        const pg8::F8 o0 = pg8::unpk8(R.og[0]), o1 = pg8::unpk8(R.og[1]), o2 = pg8::unpk8(R.og[2]);
        const float a0 = e0 * inv, a1 = e1 * inv, a2 = e2 * inv;
        ((v4u*)(OB + (size_t)row * 512))[lane] = pg8::pk8(o0.a * a0 + o1.a * a1 + o2.a * a2, o0.b * a0 + o1.b * a1 + o2.b * a2); };
    { Row RA, RB;
      if (gw < T) ld(RA, gw);
      for (int row = gw; row < T; row += 2 * NGW) {
          const bool hb = row + NGW < T; if (hb) ld(RB, row + NGW);
          asm volatile("" ::: "memory"); fin(RA, row);
          if (row + 2 * NGW < T) ld(RA, row + 2 * NGW);
          asm volatile("" ::: "memory"); if (hb) fin(RB, row + NGW);
      } }
    { constexpr int NQ = 2 * (CONV_ITEMS / (256 * NWAVES));
      if (NGW == 256 * NWAVES) { f32x4 va[16], vb[16]; ConvCall ca = conv_call(a, gw, 0), cb; conv64_load(va, ca, lane);
          for (int q = 0; q < NQ; q += 2) { cb = conv_call(a, gw + (q >> 1) * NGW, 1); conv64_load(vb, cb, lane); asm volatile("" ::: "memory"); conv64_store(va, ca, lane);
              if (q + 2 < NQ) { ca = conv_call(a, gw + ((q + 2) >> 1) * NGW, 0); conv64_load(va, ca, lane); } asm volatile("" ::: "memory"); conv64_store(vb, cb, lane); } }
      else for (int id = gw; id < CONV_ITEMS; id += NGW) conv_item(a, id, lane); }
}
__device__ __forceinline__ void p6_route(Frame& F, const Args& a, int rep) {
    typedef unsigned u32x2 __attribute__((ext_vector_type(2)));
    unsigned char* ws = a.ws;
    const int gw = F.vcu * NWAVES + F.wave, lane = F.lane, r16 = lane & 15, kq = lane >> 4;
    int* toke = (int*)(ws + WS_TOKE); float* tokw = (float*)(ws + WS_TOKW); int* toki = (int*)(ws + WS_TOKP); int* RT = (int*)(ws + WS_RT); unsigned* cur = (unsigned*)(F.ctl + CW_CUR) + 64 * rep;
    float* r1 = (float*)(ws + WS_RINV1);
    LAS unsigned* lcnt = (LAS unsigned*)(F.lds + RING_OFF); LAS int* lbase = (LAS int*)(F.lds + RING_OFF + 256);
    LAS float* lg = (LAS float*)(F.lds + RING_OFF + 1024 + F.wave * 4096); LAS float* rr = lg + 16 * 48; LAS int* rec = (LAS int*)(rr + 16);
    if (F.tid < 32) lcnt[F.tid] = 0u;
    __syncthreads();
    if (F.G * NWAVES * 16 == T) {
        const int row0 = gw * 16;
        const float* xrow = a.out + (size_t)(row0 + r16) * DM + kq * 8;
        const float* wb = (const float*)(ws + WS_WRT) + lane * 8;
        const float* gk = a.in[I_NFFNG] + kq * 8;
        bf16* hrow = (bf16*)(ws + WS_R1) + (size_t)(row0 + r16) * DM + kq * 8;
        unsigned char* h8row = ws + WS_H8 + (size_t)(row0 + r16) * DM + kq * 8;
        f32x4 D0 = {0.f, 0.f, 0.f, 0.f}, D1 = D0, D2 = D0; float ss = 0.f;
        struct XL { f32x4 a, b; };
        struct WL { f32x4 b0a, b0b, b1a, b1b, b2a, b2b, ga, gb; };
#define XLOAD(L, c_) do { L.a = *(const GAS f32x4*)(xrow + 32 * (c_)); L.b = *(const GAS f32x4*)(xrow + 32 * (c_) + 4); } while (0)
#define WLOAD(L, c_) do { const float* w_ = wb + (size_t)(3 * (c_)) * 512; L.b0a = *(const GAS f32x4*)(w_); L.b0b = *(const GAS f32x4*)(w_ + 4); L.b1a = *(const GAS f32x4*)(w_ + 512); L.b1b = *(const GAS f32x4*)(w_ + 516); \
            L.b2a = *(const GAS f32x4*)(w_ + 1024); L.b2b = *(const GAS f32x4*)(w_ + 1028); L.ga = *(const GAS f32x4*)(gk + 32 * (c_)); L.gb = *(const GAS f32x4*)(gk + 32 * (c_) + 4); } while (0)
#define RCOMP(X, L, c_) do { ss += dot4(X.a, X.a) + dot4(X.b, X.b); const f32x4 ya_ = X.a * L.ga, yb_ = X.b * L.gb; v4u o_; o_.x = pk2(ya_.x, ya_.y); o_.y = pk2(ya_.z, ya_.w); o_.z = pk2(yb_.x, yb_.y); o_.w = pk2(yb_.z, yb_.w); \
            *(GAS v4u*)(hrow + 32 * (c_)) = o_; u32x2 q_; q_.x = (unsigned)__builtin_amdgcn_cvt_pk_fp8_f32(ya_.z, ya_.w, __builtin_amdgcn_cvt_pk_fp8_f32(ya_.x, ya_.y, 0, false), true); \
            q_.y = (unsigned)__builtin_amdgcn_cvt_pk_fp8_f32(yb_.z, yb_.w, __builtin_amdgcn_cvt_pk_fp8_f32(yb_.x, yb_.y, 0, false), true); *(GAS u32x2*)(h8row + 32 * (c_)) = q_; \
            _Pragma("unroll") for (int i = 0; i < 4; ++i) { D0 = __builtin_amdgcn_mfma_f32_16x16x4f32(X.a[i], L.b0a[i], D0, 0, 0, 0); D1 = __builtin_amdgcn_mfma_f32_16x16x4f32(X.a[i], L.b1a[i], D1, 0, 0, 0); D2 = __builtin_amdgcn_mfma_f32_16x16x4f32(X.a[i], L.b2a[i], D2, 0, 0, 0); } \
            _Pragma("unroll") for (int i = 0; i < 4; ++i) { D0 = __builtin_amdgcn_mfma_f32_16x16x4f32(X.b[i], L.b0b[i], D0, 0, 0, 0); D1 = __builtin_amdgcn_mfma_f32_16x16x4f32(X.b[i], L.b1b[i], D1, 0, 0, 0); D2 = __builtin_amdgcn_mfma_f32_16x16x4f32(X.b[i], L.b2b[i], D2, 0, 0, 0); } } while (0)
        XL xq[4];
#pragma unroll
        for (int j = 0; j < 4; ++j) XLOAD(xq[j], j);
        WL WA, WB; WLOAD(WA, 0); WLOAD(WB, 1);
        for (int c = 0; c < 64; c += 4) {
#pragma unroll
            for (int j = 0; j < 4; ++j) {
                WL NC = WB;
                if (c + j + 2 < 64) WLOAD(NC, c + j + 2);
                const XL x0 = xq[j];
                if (c + 4 < 64) XLOAD(xq[j], c + 4 + j);
                asm volatile("" ::: "memory");
                RCOMP(x0, WA, c + j);
                WA = WB; WB = NC;
            }
        }
#undef XLOAD
#undef WLOAD
#undef RCOMP
        ss += __shfl_xor(ss, 16); ss += __shfl_xor(ss, 32);
        const float rsq = sqrtf(ss * (1.f / 2048.f) + 1e-6f), rv = 1.0f / rsq;
        if (kq == 0) { rr[r16] = rv; r1[row0 + r16] = rv; }
        LDS_WAIT(); asm volatile("" ::: "memory");
#pragma unroll
        for (int i = 0; i < 4; ++i) { const int m = 4 * kq + i; const float rm = rr[m]; lg[m * 48 + r16] = D0[i] * rm; lg[m * 48 + 16 + r16] = D1[i] * rm; lg[m * 48 + 32 + r16] = D2[i] * rm; }
        LDS_WAIT(); asm volatile("" ::: "memory");
        if (lane < 16) { const LAS float* L = lg + lane * 48; const int m = row0 + lane;
            const float c0 = L[0], c1 = L[1], c2 = L[2], c3 = L[3];
            float cm = c0; int gs = 0; if (c1 > cm) { cm = c1; gs = 1; } if (c2 > cm) { cm = c2; gs = 2; } if (c3 > cm) { cm = c3; gs = 3; }
            const float pg = 1.0f / (expf(c0 - cm) + expf(c1 - cm) + expf(c2 - cm) + expf(c3 - cm));
            const LAS float* Fp = L + 4 + 8 * gs;
            const float f0 = Fp[0], f1 = Fp[1], f2 = Fp[2], f3 = Fp[3], f4 = Fp[4], f5 = Fp[5], f6 = Fp[6], f7 = Fp[7];
            float v0 = f0; int i0 = 0;
            if (f1 > v0) { v0 = f1; i0 = 1; } if (f2 > v0) { v0 = f2; i0 = 2; } if (f3 > v0) { v0 = f3; i0 = 3; } if (f4 > v0) { v0 = f4; i0 = 4; } if (f5 > v0) { v0 = f5; i0 = 5; } if (f6 > v0) { v0 = f6; i0 = 6; } if (f7 > v0) { v0 = f7; i0 = 7; }
            float v1 = -3.0e38f; int i1 = 0;
            if (i0 != 0 && f0 > v1) { v1 = f0; i1 = 0; } if (i0 != 1 && f1 > v1) { v1 = f1; i1 = 1; } if (i0 != 2 && f2 > v1) { v1 = f2; i1 = 2; } if (i0 != 3 && f3 > v1) { v1 = f3; i1 = 3; }
            if (i0 != 4 && f4 > v1) { v1 = f4; i1 = 4; } if (i0 != 5 && f5 > v1) { v1 = f5; i1 = 5; } if (i0 != 6 && f6 > v1) { v1 = f6; i1 = 6; } if (i0 != 7 && f7 > v1) { v1 = f7; i1 = 7; }
            const float ee = expf(v1 - v0), w0 = pg / (1.f + ee), w1 = pg * ee / (1.f + ee);
            const int e0 = gs * 8 + i0, e1 = gs * 8 + i1; toke[2 * m] = e0; toke[2 * m + 1] = e1; tokw[2 * m] = w0; tokw[2 * m + 1] = w1;
            LAS int* rc = rec + lane * 8; rc[0] = e0; rc[1] = (int)atomicAdd((unsigned*)(lcnt + e0), 1u); rc[2] = e1; rc[3] = (int)atomicAdd((unsigned*)(lcnt + e1), 1u); }
    }
    __syncthreads();
    if (F.tid < 32) lbase[F.tid] = (int)__hip_atomic_fetch_add(cur + F.tid, lcnt[F.tid], RLX_AGENT);
    __syncthreads();
    if (lane < 16 && F.G * NWAVES * 16 == T) { const int m = gw * 16 + lane; const LAS int* rc = rec + lane * 8; const int e0 = rc[0], e1 = rc[2], j0 = lbase[e0] + rc[1], j1 = lbase[e1] + rc[3];
        toki[2 * m] = j0; toki[2 * m + 1] = j1; RT[e0 * 65536 + j0] = m; RT[e1 * 65536 + j1] = m; }
    __syncthreads();
}
__device__ __forceinline__ int moe_tables(Frame& F, int rep) {
    volatile LAS int* TS = (volatile LAS int*)(F.lds + MOE_TS); volatile LAS int* CN = (volatile LAS int*)(F.lds + MOE_CN); volatile LAS int* TE = (volatile LAS int*)(F.lds + MOE_TE);
    __syncthreads();
    if (F.wave == 0) { const unsigned* cur = (const unsigned*)(F.ctl + CW_CUR) + 64 * rep; const int l = pg8::fresh_tid(0);
        const int c = l < NEXP ? (int)__hip_atomic_load(cur + l, RLX_AGENT) : 0, nt = (c + 255) >> 8;
        int incl = nt;
#pragma unroll
        for (int o = 1; o < 32; o <<= 1) { const int t = __shfl_up(incl, o); if (l >= o) incl += t; }
        const int excl = incl - nt;
        if (l < NEXP) { TS[l] = excl; CN[l] = c; for (int t = 0; t < nt; ++t) TE[excl + t] = l; }
        if (l == NEXP - 1) TS[32] = incl; }
    __syncthreads();
    return __builtin_amdgcn_readfirstlane(TS[32]);
}
__device__ __forceinline__ void p10_combine(Frame& F, const Args& a, float sc) {
    typedef unsigned u32x2 __attribute__((ext_vector_type(2)));
    unsigned char* ws = a.ws;
    const int gw = F.vcu * NWAVES + F.wave, NGW = F.G * NWAVES, lane = F.lane;
    f32x4 g[8], gi[8];
#pragma unroll
    for (int j = 0; j < 8; ++j) { g[j] = ((const f32x4*)a.in[I_NPLEG])[lane + 64 * j]; const f32x4 gf = ((const f32x4*)a.in[I_NFFNG])[lane + 64 * j]; gi[j] = (f32x4){1.f / gf.x, 1.f / gf.y, 1.f / gf.z, 1.f / gf.w}; }
    const int* toki = (const int*)(ws + WS_TOKP); const int* toke = (const int*)(ws + WS_TOKE); const float* tokw = (const float*)(ws + WS_TOKW); const bf16* Y = (const bf16*)(ws + WS_SP);
    float* rinv2 = (float*)(ws + WS_RINV2);
    volatile LAS int* TS = (volatile LAS int*)(F.lds + MOE_TS);
    struct Rec { int p0, p1; float w0, w1; };
    auto rec = [&](int m) { Rec r; const int e0 = toke[2 * m], e1 = toke[2 * m + 1], i0 = toki[2 * m], i1 = toki[2 * m + 1]; r.w0 = tokw[2 * m] * sc; r.w1 = tokw[2 * m + 1] * sc; r.p0 = TS[e0] * 256 + i0; r.p1 = TS[e1] * 256 + i1; return r; };
    auto ld = [&](u32x2 (&hx)[8], u32x2 (&a0)[8], u32x2 (&a1)[8], const Rec& r, int m) {
        const GAS u32x2* hr = (const GAS u32x2*)((const bf16*)(ws + WS_R1) + (size_t)m * DM) + lane;
        const GAS u32x2* y0 = (const GAS u32x2*)(Y + (size_t)r.p0 * DM) + lane; const GAS u32x2* y1 = (const GAS u32x2*)(Y + (size_t)r.p1 * DM) + lane;
#pragma unroll
        for (int j = 0; j < 8; ++j) { hx[j] = hr[64 * j]; a0[j] = y0[64 * j]; a1[j] = y1[64 * j]; } };
    auto fin = [&](const u32x2 (&hx)[8], const u32x2 (&a0)[8], const u32x2 (&a1)[8], const Rec& rc, int m) {
        GAS u32x2* hr = (GAS u32x2*)((bf16*)(ws + WS_R1) + (size_t)m * DM) + lane;
        f32x4 v[8]; float s = 0.f;
#pragma unroll
        for (int j = 0; j < 8; ++j) {
            const f32x4 x = (f32x4){pg8::bflo(hx[j].x), pg8::bfhi(hx[j].x), pg8::bflo(hx[j].y), pg8::bfhi(hx[j].y)} * gi[j];
            const f32x4 ya = {pg8::bflo(a0[j].x), pg8::bfhi(a0[j].x), pg8::bflo(a0[j].y), pg8::bfhi(a0[j].y)}, yb = {pg8::bflo(a1[j].x), pg8::bfhi(a1[j].x), pg8::bflo(a1[j].y), pg8::bfhi(a1[j].y)};
            v[j] = x + ya * rc.w0 + yb * rc.w1; s += dot4(v[j], v[j]); }
        const float rsq = sqrtf(wave_sum(s) * (1.f / 2048.f) + 1e-6f), r = 1.0f / rsq;
        if (lane == 0) rinv2[m] = rsq;
        GAS unsigned* h8 = (GAS unsigned*)(ws + WS_H38 + (size_t)m * DM) + lane;
#pragma unroll
        for (int j = 0; j < 8; ++j) { const f32x4 y = v[j] * r * g[j]; u32x2 o; o.x = pk2(y.x, y.y); o.y = pk2(y.z, y.w); hr[64 * j] = o;
            h8[64 * j] = (unsigned)__builtin_amdgcn_cvt_pk_fp8_f32(y.z, y.w, __builtin_amdgcn_cvt_pk_fp8_f32(y.x, y.y, 0, false), true); } };
    u32x2 ha[8], ya0[8], ya1[8], hb[8], yb0[8], yb1[8]; Rec ra{}, rb{}, rn{};
    if (gw < T) { ra = rec(gw); ld(ha, ya0, ya1, ra, gw); if (gw + NGW < T) rb = rec(gw + NGW); }
    for (int m = gw; m < T; m += 2 * NGW) {
        const bool h1 = m + NGW < T, h2 = m + 2 * NGW < T, h3 = m + 3 * NGW < T;
        if (h1) ld(hb, yb0, yb1, rb, m + NGW);
        if (h2) rn = rec(m + 2 * NGW);
        asm volatile("" ::: "memory"); fin(ha, ya0, ya1, ra, m);
        if (h2) { ra = rn; ld(ha, ya0, ya1, ra, m + 2 * NGW); }
        Rec rn2{}; if (h3) rn2 = rec(m + 3 * NGW);
        asm volatile("" ::: "memory"); if (h1) fin(hb, yb0, yb1, rb, m + NGW);
        rb = rn2;
    }
}
__device__ __forceinline__ void p12_final(Frame& F, const Args& a, bool dry) {
    typedef unsigned u32x2 __attribute__((ext_vector_type(2)));
    const int gw = F.vcu * NWAVES + F.wave, NGW = F.G * NWAVES, lane = F.lane;
    f32x4 g[8];
#pragma unroll
    for (int j = 0; j < 8; ++j) g[j] = ((const f32x4*)a.in[I_FNG])[lane + 64 * j];
    auto ld = [&](u32x2 (&w)[8], int m) {
#pragma unroll
        for (int j = 0; j < 8; ++j) w[j] = ((const GAS u32x2*)((const bf16*)(a.ws + WS_X3) + (size_t)m * DM) + lane)[64 * j]; };
    auto fin = [&](const u32x2 (&w)[8], int m) { GAS f32x4* orow = (GAS f32x4*)(a.out + (size_t)m * DM) + lane;
        f32x4 v[8]; float s = 0.f;
#pragma unroll
        for (int j = 0; j < 8; ++j) { v[j] = (f32x4){pg8::bflo(w[j].x), pg8::bfhi(w[j].x), pg8::bflo(w[j].y), pg8::bfhi(w[j].y)}; s += dot4(v[j], v[j]); }
        const float r = 1.0f / sqrtf(wave_sum(s) * (1.f / 2048.f) + 1e-6f);
#pragma unroll
        for (int j = 0; j < 8; ++j) orow[64 * j] = dry ? v[j] : v[j] * r * g[j]; };
    u32x2 wa[8], wb[8];
    if (gw < T) ld(wa, gw);
    for (int m = gw; m < T; m += 2 * NGW) {
        const bool hb = m + NGW < T; if (hb) ld(wb, m + NGW);
        asm volatile("" ::: "memory"); fin(wa, m);
        if (m + 2 * NGW < T) ld(wa, m + 2 * NGW);
        asm volatile("" ::: "memory"); if (hb) fin(wb, m + NGW);
    }
}
__device__ __forceinline__ att::BlockRef ref_a(const Args& a, int vcu, int bi, float lam) {
    const int u = vcu * 4 + (bi >> 2), k = bi & 3, bh = u >> 3, b = bh >> 3, h = bh & 7, sub = u & 7, vh = sub >> 2, y = sub & 3;
    const int qb = (k < 2) ? y : 7 - y, map = k & 1;
    const att::bf16_t* Z = (const att::bf16_t*)(a.ws + WS_Z) + (size_t)b * SEQ * NZ;
    att::BlockRef r;
    r.Q = Z + h * 256 + map * 128; r.K = Z + 2048 + h * 256 + map * 128; r.V = Z + 4096 + h * 256 + vh * 128;
    r.scr = (float*)(a.ws + WS_SCRA) + (size_t)blockIdx.x * 256 * 128;
    r.O = (att::bf16_t*)(a.ws + WS_R1) + (size_t)b * SEQ * DM + h * 256 + vh * 128; r.lse = nullptr;
    r.P0 = qb * 256; r.dil = 1; r.lgL = 11; r.mode = map; r.ldo = DM; r.head = h; r.lam = lam;
    return r;
}
__device__ __forceinline__ att::BlockRef ref_a2(const Args& a, int vcu, int bi, float lam) {
    const int u = (bi >> 2) * 256 + vcu, k = bi & 3, bh = u >> 3, b = bh >> 3, h = bh & 7, y = u & 7;
    const int qb = (k < 2) ? y : 15 - y, map = k & 1;
    const att::bf16_t* Z = (const att::bf16_t*)(a.ws + WS_Z) + (size_t)b * SEQ * NZ;
    att::BlockRef r;
    r.Q = Z + h * 256 + map * 128; r.K = Z + 2048 + h * 256 + map * 128; r.V = Z + 4096 + h * 256;
    r.scr = (float*)(a.ws + WS_SCRA) + (size_t)blockIdx.x * 256 * 128;
    r.O = (att::bf16_t*)(a.ws + WS_R1) + (size_t)b * SEQ * DM + h * 256; r.lse = nullptr;
    r.P0 = qb * 128; r.dil = 1; r.lgL = 11; r.mode = map; r.ldo = DM; r.head = h; r.lam = lam;
    return r;
}
__device__ __forceinline__ att::BlockRef ref_a3(const Args& a, int vcu, int bi) {
    const int x = vcu >> 5, w = vcu & 31, r = bi >> 1, k = bi & 1, bh = x * 16 + 2 * r + (w >> 4), j = w & 15, map = j >> 3, y = j & 7, b = bh >> 3, h = bh & 7;
    const int qb = k == 0 ? y : 15 - y;
    const att::bf16_t* Z = (const att::bf16_t*)(a.ws + WS_Z) + (size_t)b * SEQ * NZ;
    att::BlockRef rr;
    rr.Q = Z + h * 256 + map * 128; rr.K = Z + 2048 + h * 256 + map * 128; rr.V = Z + 4096 + h * 256;
    rr.scr = nullptr; rr.O = (att::bf16_t*)(a.ws + (map == 0 ? WS_R1 : WS_OA)) + (size_t)b * SEQ * DM + h * 256; rr.lse = nullptr;
    rr.P0 = qb * 128; rr.dil = 1; rr.lgL = 11; rr.mode = 3; rr.ldo = DM; rr.head = h; rr.lam = 0.f;
    return rr;
}
__device__ __forceinline__ att::BlockRef ref_b(const Args& a, int vcu, int bi) {
    const int u = vcu * 12 + bi, qb = u & 7, bgh = u >> 3, hh = bgh & 7, bg = bgh >> 3, g = bg % 3, b = bg / 3;
    const att::bf16_t* Z = (const att::bf16_t*)(a.ws + WS_Z) + (size_t)b * SEQ * NZ;
    att::BlockRef r;
    r.Q = Z + 6144 + g * 512 + hh * 64; r.K = Z + 7680 + g * 512 + hh * 64; r.V = Z + 9216 + g * 512 + hh * 64;
    r.scr = nullptr; r.O = (att::bf16_t*)(a.ws + WS_OG) + (size_t)b * SEQ * 1536 + g * 512 + hh * 64; r.lse = (float*)(a.ws + WS_LSE) + (size_t)b * SEQ * 24 + g * 8 + hh;
    r.P0 = qb * 256; r.dil = g == 0 ? 1 : (g == 1 ? 4 : 16); r.lgL = g == 0 ? 11 : (g == 1 ? 9 : 7); r.mode = 2; r.ldo = 1536; r.head = 8 + g * 8 + hh; r.lam = 0.f;
    return r;
}
__device__ __forceinline__ void fill_tab(const Args& a, char* lds, int head, int tid, int tab_off = att::TAB_OFF) {
    const float* src = (const float*)(a.ws + WS_TAB) + (size_t)head * att::TAB_N; float* dst = (float*)(lds + tab_off);
    for (int i = tid; i < att::TAB_N; i += NWAVES * 64) dst[i] = src[i];
}

__global__ void __launch_bounds__(NWAVES * 64, 2) mk_fwd(Args args) {
    extern __shared__ __attribute__((aligned(16))) unsigned char lds[];
    Frame F;
    F.lds = (LAS unsigned char*)lds;
    F.MISC = (volatile LAS unsigned*)(F.lds + MISC_OFF);
    F.tid = threadIdx.x; F.lane = F.tid & 63; F.wave = __builtin_amdgcn_readfirstlane(F.tid >> 6);
    F.G = gridDim.x; { const int bx = blockIdx.x; F.vcu = (F.G % 8 == 0) ? (bx % 8) * (F.G / 8) + bx / 8 : bx; }
    unsigned char* ws = args.ws;
    F.ctl = (gu32*)(ws + WS_CTL);
    for (int u = F.tid; u < (LDS_BYTES - LDSCTL_OFF) / 4; u += NWAVES * 64) ((LAS unsigned*)(F.lds + LDSCTL_OFF))[u] = 0u;
    __syncthreads();
    XcdBarrier bar; bar.bar = (unsigned*)(F.ctl + CW_BAR); bar.x = 0; bar.st = nullptr;
    if (MK_N_LAUNCHES == 1) bar = xcd_barrier_post((unsigned*)(F.ctl + CW_BAR), F.MISC + 8);
    const int lo = args.ph_lo, hi = args.ph_hi;
#ifndef PHMASK
#define PHMASK 0x1fff
#endif
#define IN(k) (((PHMASK >> (k)) & 1) && lo <= (k) && (k) < hi)
#ifndef REPM
#define REPM 0
#endif
#ifndef NREPN
#define NREPN 2
#endif
#define NREP(k) (((REPM >> (k)) & 1) ? NREPN : 1)
#if defined(PROBE_A) || defined(PROBE_T)
#define STAMP(k) do { if (F.wave == 0) { if (pg8::fresh_tid(0) == 0) { const unsigned long long t_ = rt(); F.MISC[32 + 2 * (k)] = (unsigned)t_; F.MISC[33 + 2 * (k)] = (unsigned)(t_ >> 32); } } } while (0)
#define SEAM(k) do { if (IN(k) && IN((k) + 1)) xcd_barrier(bar); STAMP((k) + 1); } while (0)
#else
#define STAMP(k) do {} while (0)
#define SEAM(k) do { if (IN(k) && IN((k) + 1)) xcd_barrier(bar); } while (0)
#endif
    const int G = F.G, bx = (int)blockIdx.x;

    STAMP(0);
#ifdef PROBE_BARX
    for (int i_ = 0; i_ < PROBE_BARX; ++i_) xcd_barrier(bar);
#endif
    _Pragma("unroll") for (int rep = 0; rep < NREP(0); ++rep) if (IN(0)) { F.tid = pg8::fresh_tid(F.wave); F.lane = F.tid & 63; p0_prologue(F, args); SEAM(0); }

    _Pragma("unroll") for (int rep = 0; rep < NREP(1); ++rep) if (IN(1)) {
        constexpr int NB16 = P1F8 == 0 ? 10240 : (P1F8 == 1 ? 6144 : 0), NF8 = NCAT - NB16;
        const int par_ = P1_SWAP ? (bx & 1) : 0;
        _Pragma("nounroll") for (int s_ = 0; s_ < 2; ++s_) {
          if ((s_ ^ par_) == 0) {
            if constexpr (NB16 > 0) { pg8::Gemm g{(const pg8::bf16_t*)(ws + WS_R1), (const pg8::bf16_t*)(ws + WS_WCAT), T, NB16, DM}; pg8::StaticOrder S; S.init(T, NB16, G, bx);
              pg8::EpiZG E{(pg8::bf16_t*)(ws + WS_Z), (pg8::bf16_t*)args.out, 0};
              pg8::gemm_phase<pg8::EpiZG, pg8::StaticOrder, P1_ALIGN, true>(F.lds + RING_OFF, g, S, E, F.wave); }
          } else {
            pg8::Gemm g{(const pg8::bf16_t*)(ws + WS_HP8), (const pg8::bf16_t*)(ws + WS_WB8), T, NF8, DM}; pg8::StaticOrder S; S.init(T, NF8, G, bx);
            pg8::EpiZB E{(pg8::bf16_t*)(ws + WS_Z), (pg8::bf16_t*)args.out, 0};
            pg8::gemm_phase<pg8::EpiZB, pg8::StaticOrder, true, true, false, true>(F.lds + RING_OFF, g, S, E, F.wave);
          }
          __syncthreads();
        }
        SEAM(1);
    }
    _Pragma("unroll") for (int rep = 0; rep < NREP(2); ++rep) if (IN(2)) {
        char* al = (char*)lds + RING_OFF;
        const float lam = *(const float*)(ws + WS_LAM);
        if (G == 256) {
#ifndef NO_ATT_A
#if ATT_A2
#ifndef REPA
#define REPA 1
#endif
            _Pragma("unroll") for (int ra = 0; ra < REPA; ++ra)
            { att::A3Ctx cx{(const att::bf16_t*)(args.ws + WS_Z), (att::bf16_t*)(args.ws + WS_R1), (att::bf16_t*)(args.ws + WS_OA), (const float*)(args.ws + WS_TAB), F.vcu};
              if (F.wave < 4) att::a3_S_loop(cx, al, F.wave); else att::a3_V_loop(cx, al, F.wave);
              __syncthreads(); }
#else
            { const int ta = pg8::fresh_tid(F.wave); att::Seam<128> S; att::BlockRef cur = ref_a(args, F.vcu, 0, lam);
              fill_tab(args, al, cur.head, ta); __syncthreads();
              att::attn_prime<128, false>(cur, al, S, ta);
              for (int bi = 0; bi < 16; ++bi) { const att::BlockRef nxt = (bi + 1 < 16) ? ref_a(args, F.vcu, bi + 1, lam) : cur;
                  att::attn_block<128, false>(cur, nxt, al, S, ta); cur = nxt; } }
#endif
#endif
            __syncthreads();
#ifndef NO_ATT_B
#ifndef REPB
#define REPB 1
#endif
            _Pragma("unroll") for (int rb = 0; rb < REPB; ++rb)
            { const int tb = pg8::fresh_tid(F.wave);
              att::Seam<64> S; att::BlockRef cur = ref_b(args, F.vcu, 0); int head = cur.head;
              fill_tab(args, al, head, tb); __syncthreads();
              att::attn_prime<64, true>(cur, al, S, tb);
              for (int bi = 0; bi < 12; ++bi) { const att::BlockRef nxt = (bi + 1 < 12) ? ref_b(args, F.vcu, bi + 1) : cur;
                  att::attn_block<64, true>(cur, nxt, al, S, tb);
                  if (nxt.head != head) { head = nxt.head; fill_tab(args, al, head, tb); __syncthreads(); }
                  cur = nxt; } }
#endif
        }
        SEAM(2);
    }
    _Pragma("unroll") for (int rep = 0; rep < NREP(3); ++rep) if (IN(3)) { F.tid = pg8::fresh_tid(F.wave); F.lane = F.tid & 63; p3_post_attn(F, args); SEAM(3); }
    _Pragma("unroll") for (int rep = 0; rep < NREP(4); ++rep) if (IN(4)) {
        { pg8::Gemm g{(const pg8::bf16_t*)(ws + WS_OA), (const pg8::bf16_t*)(ws + WS_PA), T, DM, DM}; pg8::StaticOrder S; S.init(T, DM, G, bx);
          pg8::EpiGateA E{(const pg8::bf16_t*)args.out, (pg8::bf16_t*)(ws + WS_SP)};
          pg8::gemm_phase<pg8::EpiGateA, pg8::StaticOrder, true, true>(F.lds + RING_OFF, g, S, E, F.wave); }
        { pg8::Gemm g{(const pg8::bf16_t*)(ws + WS_OB), (const pg8::bf16_t*)(ws + WS_PB), T, DM, 512}; pg8::StaticOrder S; S.init(T, DM, G, bx);
          pg8::EpiMerge E{(const pg8::bf16_t*)args.out, (const pg8::bf16_t*)(ws + WS_SP), (pg8::bf16_t*)(ws + WS_R1)};
          pg8::gemm_phase<pg8::EpiMerge, pg8::StaticOrder, true, true>(F.lds + RING_OFF, g, S, E, F.wave); }
        SEAM(4);
    }
    _Pragma("unroll") for (int rep = 0; rep < NREP(5); ++rep) if (IN(5)) {
        pg8::Gemm g{(const pg8::bf16_t*)(ws + WS_R1), (const pg8::bf16_t*)(ws + WS_WOUT), T, DM, DM}; pg8::StaticOrder S; S.init(T, DM, G, bx);
        pg8::EpiRes E{args.in[I_X], args.out};
        pg8::gemm_phase<pg8::EpiRes, pg8::StaticOrder, true, true>(F.lds + RING_OFF, g, S, E, F.wave);
        SEAM(5);
    }
    _Pragma("unroll") for (int rep = 0; rep < NREP(6); ++rep) if (IN(6)) { F.tid = pg8::fresh_tid(F.wave); F.lane = F.tid & 63; p6_route(F, args, rep); if (IN(6) && IN(8)) xcd_barrier(bar); STAMP(7); }
    _Pragma("unroll") for (int rep = 0; rep < NREP(8); ++rep) if (IN(8)) {
        F.tid = pg8::fresh_tid(F.wave); const int nt = moe_tables(F, 0);
        pg8::Gemm g{(const pg8::bf16_t*)(ws + WS_H8), (const pg8::bf16_t*)(ws + WS_WE13), nt * 256, 2048, DM};
        pg8::MoeOrder S{(const volatile LAS int*)(F.lds + MOE_TE), (const volatile LAS int*)(F.lds + MOE_TS), (const volatile LAS int*)(F.lds + MOE_CN), nt * 8, G, bx};
        pg8::EpiSwiGLU E{(pg8::bf16_t*)(ws + WS_HDN), (const int*)(ws + WS_RT), (const float*)(ws + WS_RINV1)};
        pg8::gemm_phase<pg8::EpiSwiGLU, pg8::MoeOrder, true, true, true, true>(F.lds + RING_OFF, g, S, E, F.wave, (const int*)(ws + WS_RT));
        SEAM(8);
    }
    _Pragma("unroll") for (int rep = 0; rep < NREP(9); ++rep) if (IN(9)) {
        F.tid = pg8::fresh_tid(F.wave); const int nt = moe_tables(F, 0);
        pg8::Gemm g{(const pg8::bf16_t*)(ws + WS_HDN), (const pg8::bf16_t*)(ws + WS_WE2), nt * 256, 2048, DE};
        pg8::MoeOrder S{(const volatile LAS int*)(F.lds + MOE_TE), (const volatile LAS int*)(F.lds + MOE_TS), (const volatile LAS int*)(F.lds + MOE_CN), nt * 8, G, bx};
        pg8::EpiY E{(pg8::bf16_t*)(ws + WS_SP)};
        pg8::gemm_phase<pg8::EpiY, pg8::MoeOrder, true, true, false, true>(F.lds + RING_OFF, g, S, E, F.wave);
        SEAM(9);
    }
    _Pragma("unroll") for (int rep = 0; rep < NREP(10); ++rep) if (IN(10)) {
        F.tid = pg8::fresh_tid(F.wave); F.lane = F.tid & 63; (void)moe_tables(F, 0); p10_combine(F, args, rep == 0 ? 1.f : 0.f);
        SEAM(10);
    }
    _Pragma("unroll") for (int rep = 0; rep < NREP(11); ++rep) if (IN(11)) {
        { pg8::Gemm g{(const pg8::bf16_t*)(ws + WS_PBF), (const pg8::bf16_t*)(ws + WS_WPP), T, DM, PLED}; pg8::StaticOrder S; S.init(T, DM, G, bx);
          pg8::EpiBf E{(pg8::bf16_t*)(ws + WS_SP)};
          pg8::gemm_phase<pg8::EpiBf, pg8::StaticOrder, true, true>(F.lds + RING_OFF, g, S, E, F.wave); }
        { pg8::Gemm g{(const pg8::bf16_t*)(ws + WS_H38), (const pg8::bf16_t*)(ws + WS_WPG), T, DM, DM}; pg8::StaticOrder S; S.init(T, DM, G, bx);
          pg8::EpiPle E{(const pg8::bf16_t*)(ws + WS_SP), (const pg8::bf16_t*)(ws + WS_R1), (const float*)(ws + WS_RINV2), args.in[I_NPLEG], (pg8::bf16_t*)(ws + WS_X3), rep == 0 ? 1.f : 0.f};
          pg8::gemm_phase<pg8::EpiPle, pg8::StaticOrder, true, true, false, true>(F.lds + RING_OFF, g, S, E, F.wave); }
        SEAM(11);
    }
    _Pragma("unroll") for (int rep = 0; rep < NREP(12); ++rep) if (IN(12)) { F.tid = pg8::fresh_tid(F.wave); F.lane = F.tid & 63; p12_final(F, args, rep + 1 < NREP(12)); if (rep + 1 < NREP(12)) xcd_barrier(bar); }
#ifdef PROBE_T
    STAMP(13); __syncthreads();
    if (blockIdx.x == 0 && F.wave == 0 && pg8::fresh_tid(0) == 0) { auto tsv = [&](int k) { return (unsigned long long)F.MISC[32 + 2 * k] | ((unsigned long long)F.MISC[33 + 2 * k] << 32); };
      const unsigned long long w_ = (tsv(PROBE_U) - tsv(PROBE_T)) * PROBE_TMUL, t0_ = rt(); while (rt() - t0_ < w_) __builtin_amdgcn_s_sleep(8); }
#endif
#ifdef PROBE_A
    xcd_barrier(bar); STAMP(13); __syncthreads();
    { auto tsv = [&](int k) { return (unsigned long long)F.MISC[32 + 2 * k] | ((unsigned long long)F.MISC[33 + 2 * k] << 32); };
      const float da = (float)(tsv(PROBE_A + 1) - tsv(PROBE_A)) * 0.01f, db = (float)(tsv(PROBE_B + 1) - tsv(PROBE_B)) * 0.01f;
      const float c1 = 10.f + da * 0.04f, c2 = 200.f + db;
      for (size_t i = (size_t)blockIdx.x * 512 + threadIdx.x; i < (size_t)T * DM; i += (size_t)gridDim.x * 512) args.out[i] = c1;
      if (blockIdx.x == 0 && threadIdx.x == 0) args.out[0] = c2; }
#endif
#undef IN
#undef SEAM
}

extern "C" void kernel_launch(void* const* d_in, const int* in_sizes, int n_in, void* d_out, int out_size, void* d_ws, size_t ws_size, hipStream_t stream) {
    static int grid = 0;
    if (grid == 0) {
        if (n_in != 24 || out_size != T * DM || ws_size < WS_END) { fprintf(stderr, "kernel_launch: unexpected shapes (n_in %d, out %d, ws %zu)\n", n_in, out_size, ws_size); grid = -1; return; }
        int dev = 0, cus = 0, per_cu = 0;
        if (hipGetDevice(&dev) != hipSuccess || hipDeviceGetAttribute(&cus, hipDeviceAttributeMultiprocessorCount, dev) != hipSuccess) { grid = -1; return; }
        if (hipFuncSetAttribute((const void*)mk_fwd, hipFuncAttributeMaxDynamicSharedMemorySize, LDS_BYTES) != hipSuccess) { fprintf(stderr, "kernel_launch: hipFuncSetAttribute failed\n"); grid = -1; return; }
        if (hipOccupancyMaxActiveBlocksPerMultiprocessor(&per_cu, (const void*)mk_fwd, NWAVES * 64, LDS_BYTES) != hipSuccess || per_cu < 1) fprintf(stderr, "kernel_launch: occupancy query reports %d\n", per_cu);
        (void)hipGetLastError();
        grid = cus;
    }
    if (grid < 0) return;
    if (hipMemsetAsync((char*)d_ws + WS_CTL, 0, CTL_ZERO_BYTES, stream) != hipSuccess) return;
    Args a{};
    for (int i = 0; i < 24; ++i) a.in[i] = (const float*)d_in[i];
    a.out = (float*)d_out; a.ws = (unsigned char*)d_ws;
    if (MK_N_LAUNCHES == 1) { a.ph_lo = 0; a.ph_hi = NPH; hipLaunchKernelGGL(mk_fwd, dim3(grid), dim3(NWAVES * 64), LDS_BYTES, stream, a); }
    else for (int p = 0; p < NPH; ++p) { a.ph_lo = p; a.ph_hi = p + 1; hipLaunchKernelGGL(mk_fwd, dim3(grid), dim3(NWAVES * 64), LDS_BYTES, stream, a); }
}
```

```cpp
#include <hip/hip_runtime.h>
#include <cstdio>
#include <cstdint>
#ifndef PG8_RELAX
#define PG8_RELAX 0x142
#endif
#ifndef PG8_WGM
#define PG8_WGM 8
#endif
namespace pg8 {
#define PG8_LAS __attribute__((address_space(3)))
typedef unsigned short bf16_t;
typedef short bf16x8 __attribute__((ext_vector_type(8)));
typedef float f32x4 __attribute__((ext_vector_type(4)));
typedef unsigned u32x4 __attribute__((ext_vector_type(4)));
typedef int i32x8_t __attribute__((ext_vector_type(8)));
typedef int i32x4_t __attribute__((ext_vector_type(4)));
typedef short bf16x16_t __attribute__((ext_vector_type(16)));
constexpr int BM = 256, BK = 64, HALF = 128, HTB = HALF * BK * 2  , STAGE_BYTES = 8 * HTB, NXCD = 8, WGM = PG8_WGM;

__host__ __device__ __forceinline__ int lds_byte(int r, int c) { const int st = (r >> 4) * 2 + (c >> 5), rr = r & 15, cc = c & 31, ob = rr * 64 + cc * 2; return st * 1024 + (ob ^ (((ob >> 9) & 1) << 5)); }
__host__ __device__ __forceinline__ void stage_rc(int b, int& R, int& C) { const int st = b / 1024, sb = b % 1024, swz = sb ^ (((sb >> 9) & 1) << 5); R = (st >> 1) * 16 + swz / 64; C = (st & 1) * 32 + (swz % 64) / 2; }
__host__ __device__ __forceinline__ int perm32(int rho) { const int n = rho >> 4, i = rho & 15; return 8 * (i >> 2) + 4 * n + (i & 3); }

__device__ __forceinline__ int fresh_tid(int wave) { int l; asm volatile("v_mbcnt_lo_u32_b32 %0, -1, 0\n\tv_mbcnt_hi_u32_b32 %0, -1, %0" : "=v"(l)); return wave * 64 + l; }
struct Unit { int pm, pn, arow0, nvalid; };
struct Gemm { const bf16_t* A; const bf16_t* Bt; int M, N, K; };

struct StaticOrder {
    static constexpr bool PURE = true;
    int nM, nN, nwg, G, c, i0 = 0, cnt = 0x7fffffff;
    __host__ __device__ void init(int M, int N, int G_, int c_) { nM = M / BM; nN = N / BM; nwg = nM * nN; G = G_; c = c_; }
    __host__ __device__ bool next(int i, Unit& u) const {
        const long L = (long)(i + i0) * G + c; if (i >= cnt || L >= nwg) return false;
        int wgid = (int)L; { const int q = nwg / NXCD, r = nwg % NXCD, xcd = wgid % NXCD, off = wgid / NXCD; wgid = (xcd < r ? xcd * (q + 1) : r * (q + 1) + (xcd - r) * q) + off; }
        const int nig = WGM * nN, gid = wgid / nig, fm = gid * WGM, gsz = (nM - fm) < WGM ? (nM - fm) : WGM;
        u.pm = fm + ((wgid % nig) % gsz); u.pn = (wgid % nig) / gsz; return true;
    }
    __device__ __forceinline__ void a_ready(const Unit&) const {}
    __device__ __forceinline__ void done(const Unit&) const {}
};


__device__ __forceinline__ unsigned cvt_pk_bf16(float lo, float hi) { unsigned r; asm volatile("v_cvt_pk_bf16_f32 %0, %1, %2" : "=v"(r) : "v"(lo), "v"(hi)); return r; }
__device__ __forceinline__ float sigm(float x) { return __builtin_amdgcn_rcpf(1.0f + __builtin_amdgcn_exp2f(-1.4426950408889634f * x)); }
__device__ __forceinline__ f32x4 sigm4(f32x4 v) { return (f32x4){sigm(v[0]), sigm(v[1]), sigm(v[2]), sigm(v[3])}; }
__device__ __forceinline__ float bflo(unsigned w) { return __uint_as_float(w << 16); }
__device__ __forceinline__ float bfhi(unsigned w) { return __uint_as_float(w & 0xffff0000u); }
struct F8 { f32x4 a, b; };
__device__ __forceinline__ F8 unpk8(u32x4 w) { F8 r; r.a = (f32x4){bflo(w.x), bfhi(w.x), bflo(w.y), bfhi(w.y)}; r.b = (f32x4){bflo(w.z), bfhi(w.z), bflo(w.w), bfhi(w.w)}; return r; }
__device__ __forceinline__ u32x4 pk8(f32x4 a, f32x4 b) { u32x4 w; w.x = cvt_pk_bf16(a[0], a[1]); w.y = cvt_pk_bf16(a[2], a[3]); w.z = cvt_pk_bf16(b[0], b[1]); w.w = cvt_pk_bf16(b[2], b[3]); return w; }

struct EpiZG {
    static constexpr bool PERM = true, AFTER_DRAIN = false; static constexpr int RID = 0, NST = 16;
    bf16_t* Z; bf16_t* G; int skip;
    __device__ __forceinline__ void operator()(const f32x4 (&acc)[2][2][4][2], const Unit& u, int wr, int wc, int fr, int fq) const {
        if (skip == 1) return;
        const bool isg = u.pn >= 24; bf16_t* base = isg ? G : Z; int ldc = isg ? 4096 : 10752; int colt = (isg ? u.pn - 24 : u.pn) * BM;
        int row0 = u.pm * BM + wr * 64 + fr; if (skip == 2) { base = Z; ldc = 256; colt = 0; row0 = wr * 64 + fr; } const int col0 = colt + wc * 32 + 8 * fq;
#pragma unroll
        for (int ai = 0; ai < 2; ++ai)
#pragma unroll
            for (int m = 0; m < 4; ++m) { bf16_t* rowp = base + (size_t)(row0 + ai * HALF + m * 16) * ldc + col0;
#pragma unroll
                for (int bj = 0; bj < 2; ++bj) { f32x4 v0 = acc[ai][bj][m][0], v1 = acc[ai][bj][m][1];
                    if (isg) { v0 = sigm4(v0); v1 = sigm4(v1); }
                    const u32x4 w = pk8(v0, v1); if (skip != 3 || u.pm < 0) *(u32x4*)(rowp + bj * HALF) = w; } }
    }
};
struct EpiZB {
    static constexpr bool PERM = true, AFTER_DRAIN = false; static constexpr int RID = 1, NST = 16;
    bf16_t* Z; bf16_t* G; int skip;
    __device__ __forceinline__ void operator()(const f32x4 (&acc)[2][2][4][2], const Unit& u, int wr, int wc, int fr, int fq) const {
        if (skip == 1) return;
        const bool isg = u.pn >= 18 && u.pn < 34; bf16_t* base = isg ? G : Z; int ldc = isg ? 4096 : 10752; int colt = isg ? (u.pn - 18) * BM : (u.pn < 18 ? 6144 + u.pn * BM : (u.pn - 34) * BM);
        int row0 = u.pm * BM + wr * 64 + fr; if (skip == 2) { base = Z; ldc = 256; colt = 0; row0 = wr * 64 + fr; } const int col0 = colt + wc * 32 + 8 * fq;
#pragma unroll
        for (int ai = 0; ai < 2; ++ai)
#pragma unroll
            for (int m = 0; m < 4; ++m) { bf16_t* rowp = base + (size_t)(row0 + ai * HALF + m * 16) * ldc + col0;
#pragma unroll
                for (int bj = 0; bj < 2; ++bj) { f32x4 v0 = acc[ai][bj][m][0] * 0.03125f, v1 = acc[ai][bj][m][1] * 0.03125f;
                    if (isg) { v0 = sigm4(v0); v1 = sigm4(v1); }
                    const u32x4 w = pk8(v0, v1); if (skip != 3 || u.pm < 0) *(u32x4*)(rowp + bj * HALF) = w; } }
    }
};
struct EpiGateA {
    static constexpr bool PERM = true, AFTER_DRAIN = false; static constexpr int RID = 2, NST = 16;
    const bf16_t* G; bf16_t* T1;
    __device__ __forceinline__ void operator()(const f32x4 (&acc)[2][2][4][2], const Unit& u, int wr, int wc, int fr, int fq) const {
        const int row0 = u.pm * BM + wr * 64 + fr, col0 = u.pn * BM + wc * 32 + 8 * fq;
#pragma unroll
        for (int ai = 0; ai < 2; ++ai) { u32x4 gq[4][2];
#pragma unroll
            for (int m = 0; m < 4; ++m)
#pragma unroll
                for (int bj = 0; bj < 2; ++bj) gq[m][bj] = *(const u32x4*)(G + (size_t)(row0 + ai * HALF + m * 16) * 4096 + col0 + bj * HALF);
#pragma unroll
            for (int m = 0; m < 4; ++m) { const size_t r = (size_t)(row0 + ai * HALF + m * 16);
#pragma unroll
                for (int bj = 0; bj < 2; ++bj) { const F8 g = unpk8(gq[m][bj]);
                    *(u32x4*)(T1 + r * 2048 + col0 + bj * HALF) = pk8(acc[ai][bj][m][0] * g.a, acc[ai][bj][m][1] * g.b); } }
            asm volatile("" ::: "memory"); }
    }
};
struct EpiMerge {
    typedef unsigned u32x2 __attribute__((ext_vector_type(2)));
    static constexpr bool PERM = true, AFTER_DRAIN = false; static constexpr int RID = 3, NST = 16;
    const bf16_t* G; const bf16_t* T1; bf16_t* O; int f8;
    __device__ __forceinline__ void operator()(const f32x4 (&acc)[2][2][4][2], const Unit& u, int wr, int wc, int fr, int fq) const {
        const int row0 = u.pm * BM + wr * 64 + fr, col0 = u.pn * BM + wc * 32 + 8 * fq;
#pragma unroll
        for (int ai = 0; ai < 2; ++ai) { u32x4 gq[4][2], tq[4][2];
#pragma unroll
            for (int m = 0; m < 4; ++m)
#pragma unroll
                for (int bj = 0; bj < 2; ++bj) { const size_t r = (size_t)(row0 + ai * HALF + m * 16); gq[m][bj] = *(const u32x4*)(G + r * 4096 + 2048 + col0 + bj * HALF); tq[m][bj] = *(const u32x4*)(T1 + r * 2048 + col0 + bj * HALF); }
#pragma unroll
            for (int m = 0; m < 4; ++m) { const size_t r = (size_t)(row0 + ai * HALF + m * 16);
#pragma unroll
                for (int bj = 0; bj < 2; ++bj) { const F8 g = unpk8(gq[m][bj]); const F8 t = unpk8(tq[m][bj]);
                    const f32x4 v0 = t.a + acc[ai][bj][m][0] * g.a, v1 = t.b + acc[ai][bj][m][1] * g.b;
                    if (f8) { u32x2 w; w.x = (unsigned)__builtin_amdgcn_cvt_pk_fp8_f32(v0[2], v0[3], __builtin_amdgcn_cvt_pk_fp8_f32(v0[0], v0[1], 0, false), true);
                        w.y = (unsigned)__builtin_amdgcn_cvt_pk_fp8_f32(v1[2], v1[3], __builtin_amdgcn_cvt_pk_fp8_f32(v1[0], v1[1], 0, false), true);
                        *(u32x2*)((unsigned char*)O + r * 2048 + col0 + bj * HALF) = w; }
                    else *(u32x4*)(O + r * 2048 + col0 + bj * HALF) = pk8(v0, v1); } }
            asm volatile("" ::: "memory"); }
    }
};
struct EpiRes {
    static constexpr bool PERM = false, AFTER_DRAIN = false; static constexpr int RID = 4, NST = 32;
    const float* X; float* O; float sc;
    __device__ __forceinline__ void operator()(const f32x4 (&acc)[2][2][4][2], const Unit& u, int wr, int wc, int fr, int fq) const {
        const int row0 = u.pm * BM + wr * 64 + fr, col0 = u.pn * BM + wc * 32 + 4 * fq;
#pragma unroll
        for (int ai = 0; ai < 2; ++ai) { f32x4 xq[4][2][2];
#pragma unroll
            for (int m = 0; m < 4; ++m) { const size_t off = (size_t)(row0 + ai * HALF + m * 16) * 2048 + col0;
#pragma unroll
                for (int bj = 0; bj < 2; ++bj)
#pragma unroll
                    for (int n = 0; n < 2; ++n) xq[m][bj][n] = *(const f32x4*)(X + off + bj * HALF + n * 16); }
#pragma unroll
            for (int m = 0; m < 4; ++m) { const size_t off = (size_t)(row0 + ai * HALF + m * 16) * 2048 + col0;
#pragma unroll
                for (int bj = 0; bj < 2; ++bj)
#pragma unroll
                    for (int n = 0; n < 2; ++n) *(f32x4*)(O + off + bj * HALF + n * 16) = xq[m][bj][n] + acc[ai][bj][m][n] * sc; }
            asm volatile("" ::: "memory"); }
    }
};
struct EpiSwiGLU {
    typedef unsigned u32x2 __attribute__((ext_vector_type(2)));
    static constexpr bool PERM = true, AFTER_DRAIN = false; static constexpr int RID = 5, NST = 8;
    bf16_t* Hd; const int* RT; const float* r1;
    __device__ __forceinline__ void operator()(const f32x4 (&acc)[2][2][4][2], const Unit& u, int wr, int wc, int fr, int fq) const {
        const int lr0 = wr * 64 + fr, row0 = u.pm * BM + lr0, col0 = (u.pn & 7) * HALF + wc * 32 + 8 * fq;
        int tok[2][4]; float rsv[2][4];
#pragma unroll
        for (int ai = 0; ai < 2; ++ai)
#pragma unroll
            for (int m = 0; m < 4; ++m) { const int lr = lr0 + ai * HALF + m * 16; tok[ai][m] = lr < u.nvalid ? RT[u.arow0 + lr] : 0; }
#pragma unroll
        for (int ai = 0; ai < 2; ++ai)
#pragma unroll
            for (int m = 0; m < 4; ++m) rsv[ai][m] = r1[tok[ai][m]] * 0.03125f;
#pragma unroll
        for (int ai = 0; ai < 2; ++ai)
#pragma unroll
            for (int m = 0; m < 4; ++m) { const size_t r = (size_t)(row0 + ai * HALF + m * 16); const float rs = rsv[ai][m];
                const f32x4 a0 = acc[ai][0][m][0] * rs, a1 = acc[ai][0][m][1] * rs, b0 = acc[ai][1][m][0] * rs, b1 = acc[ai][1][m][1] * rs;
                const f32x4 v0 = a0 * sigm4(a0) * b0, v1 = a1 * sigm4(a1) * b1;
                u32x2 w; w.x = (unsigned)__builtin_amdgcn_cvt_pk_fp8_f32(v0[2], v0[3], __builtin_amdgcn_cvt_pk_fp8_f32(v0[0], v0[1], 0, false), true);
                w.y = (unsigned)__builtin_amdgcn_cvt_pk_fp8_f32(v1[2], v1[3], __builtin_amdgcn_cvt_pk_fp8_f32(v1[0], v1[1], 0, false), true);
                *(u32x2*)((unsigned char*)Hd + r * 1024 + col0) = w; }
    }
};
struct EpiY {
    static constexpr bool PERM = true, AFTER_DRAIN = false; static constexpr int RID = 6, NST = 16;
    bf16_t* Y;
    __device__ __forceinline__ void operator()(const f32x4 (&acc)[2][2][4][2], const Unit& u, int wr, int wc, int fr, int fq) const {
        const int row0 = u.pm * BM + wr * 64 + fr, col0 = (u.pn & 7) * BM + wc * 32 + 8 * fq;
#pragma unroll
        for (int ai = 0; ai < 2; ++ai)
#pragma unroll
            for (int m = 0; m < 4; ++m) { bf16_t* rowp = Y + (size_t)(row0 + ai * HALF + m * 16) * 2048 + col0;
#pragma unroll
                for (int bj = 0; bj < 2; ++bj) *(u32x4*)(rowp + bj * HALF) = pk8(acc[ai][bj][m][0] * 0.03125f, acc[ai][bj][m][1] * 0.03125f); }
    }
};
struct EpiBf {
    static constexpr bool PERM = true, AFTER_DRAIN = false; static constexpr int RID = 7, NST = 16;
    bf16_t* O;
    __device__ __forceinline__ void operator()(const f32x4 (&acc)[2][2][4][2], const Unit& u, int wr, int wc, int fr, int fq) const {
        const int row0 = u.pm * BM + wr * 64 + fr, col0 = u.pn * BM + wc * 32 + 8 * fq;
#pragma unroll
        for (int ai = 0; ai < 2; ++ai)
#pragma unroll
            for (int m = 0; m < 4; ++m) { bf16_t* rowp = O + (size_t)(row0 + ai * HALF + m * 16) * 2048 + col0;
#pragma unroll
                for (int bj = 0; bj < 2; ++bj) *(u32x4*)(rowp + bj * HALF) = pk8(acc[ai][bj][m][0], acc[ai][bj][m][1]); }
    }
};
struct EpiPle {
    static constexpr bool PERM = true, AFTER_DRAIN = false; static constexpr int RID = 8, NST = 16;
    const bf16_t* E; const bf16_t* H3; const float* rinv; const float* gple; bf16_t* X3; float sc;
    __device__ __forceinline__ void operator()(const f32x4 (&acc)[2][2][4][2], const Unit& u, int wr, int wc, int fr, int fq) const {
        const int row0 = u.pm * BM + wr * 64 + fr, col0 = u.pn * BM + wc * 32 + 8 * fq;
        f32x4 gi[2][2];
#pragma unroll
        for (int bj = 0; bj < 2; ++bj)
#pragma unroll
            for (int n = 0; n < 2; ++n) { const f32x4 gv = *(const f32x4*)(gple + col0 + bj * HALF + 4 * n); gi[bj][n] = (f32x4){1.f / gv[0], 1.f / gv[1], 1.f / gv[2], 1.f / gv[3]}; }
#pragma unroll
        for (int ai = 0; ai < 2; ++ai)
#pragma unroll
          for (int mh = 0; mh < 2; ++mh) { u32x4 eq[2][2], hq[2][2]; float riq[2];
#pragma unroll
            for (int mm = 0; mm < 2; ++mm) { const size_t r = (size_t)(row0 + ai * HALF + (2 * mh + mm) * 16); riq[mm] = rinv[r];
#pragma unroll
                for (int bj = 0; bj < 2; ++bj) { eq[mm][bj] = *(const u32x4*)(E + r * 2048 + col0 + bj * HALF); hq[mm][bj] = *(const u32x4*)(H3 + r * 2048 + col0 + bj * HALF); } }
#pragma unroll
            for (int mm = 0; mm < 2; ++mm) { const int m = 2 * mh + mm; const size_t r = (size_t)(row0 + ai * HALF + m * 16); const float ri = riq[mm];
#pragma unroll
                for (int bj = 0; bj < 2; ++bj) { const F8 ev = unpk8(eq[mm][bj]); const F8 hv = unpk8(hq[mm][bj]);
                    f32x4 a0 = acc[ai][bj][m][0] * 0.03125f, a1 = acc[ai][bj][m][1] * 0.03125f; asm volatile("" : "+v"(a0), "+v"(a1));
                    const f32x4 v0 = hv.a * gi[bj][0] * ri + sigm4(a0) * (ev.a * sc), v1 = hv.b * gi[bj][1] * ri + sigm4(a1) * (ev.b * sc);
                    *(u32x4*)(X3 + r * 2048 + col0 + bj * HALF) = pk8(v0, v1); } }
            asm volatile("" ::: "memory"); }
    }
};
#ifndef MOE_XCD
#define MOE_XCD 1
#endif
struct MoeOrder {
    static constexpr bool PURE = true;
    const volatile PG8_LAS int* TE; const volatile PG8_LAS int* TS; const volatile PG8_LAS int* CN; int n8, G, c;
    __device__ __forceinline__ bool next(int i, Unit& u) const {
        long L = (long)i * G + c;
        if (MOE_XCD && G == 256) { const int x = c & 7, s = c >> 3; L = ((long)i * 32 + x * 4 + (s >> 3)) * 8 + (s & 7); }
        if (L >= n8) return false;
        u.pm = (int)(L >> 3);
        const int e = __builtin_amdgcn_readfirstlane(TE[u.pm]), lt = u.pm - __builtin_amdgcn_readfirstlane(TS[e]);
        u.pn = e * 8 + (int)(L & 7); u.arow0 = e * 65536 + lt * 256; u.nvalid = __builtin_amdgcn_readfirstlane(CN[e]) - lt * 256; return true;
    }
    __device__ __forceinline__ void a_ready(const Unit&) const {}
    __device__ __forceinline__ void done(const Unit&) const {}
};
template <class Epi, class Sched, bool ALIGN_EPI = false, bool SP2 = false, bool GATHER = false, bool F8 = false>
__device__ __forceinline__ void gemm_phase(PG8_LAS unsigned char* lds, const Gemm g, const Sched& S, const Epi& E, const int wave, const int* RT = nullptr) {
    const int tid = fresh_tid(wave), wid = wave, lane = tid & 63, wr = wid >> 2, wc = wid & 3, fr = lane & 15, fq = lane >> 4;
    const int K = g.K, KB = F8 ? g.K : g.K * 2  , nt = KB / (BK * 2);
    unsigned oC0[2], oC1[2], oN0[2], oN1[2], voffB[2]; int Rg[2]; unsigned Cb[2];
    const size_t kstep = (size_t)(BK * 2);
    const size_t hstep = (size_t)HALF * KB;
#pragma unroll
    for (int i = 0; i < 2; ++i) { int R, C; stage_rc(tid * 16 + i * 8192, R, C); const int Rb = Epi::PERM ? ((R & ~31) + perm32(R & 31)) : R;
        Rg[i] = R; Cb[i] = (unsigned)C * 2u; oC0[i] = (unsigned)(R * KB + C * 2); oC1[i] = oC0[i] + (unsigned)hstep; oN0[i] = oC0[i]; oN1[i] = oC1[i]; voffB[i] = (unsigned)(Rb * KB + C * 2); }
#define PG8_GOFFS(u_, o0_, o1_) do { _Pragma("unroll") for (int _i = 0; _i < 2; ++_i) { const int t0_ = Rg[_i] < (u_).nvalid ? RT[(u_).arow0 + Rg[_i]] : 0, t1_ = HALF + Rg[_i] < (u_).nvalid ? RT[(u_).arow0 + HALF + Rg[_i]] : 0; \
        o0_[_i] = (unsigned)t0_ * (unsigned)KB + Cb[_i]; o1_[_i] = (unsigned)t1_ * (unsigned)KB + Cb[_i]; } } while (0)
    const size_t tstep = 2 * hstep;
    const unsigned ldsw = (unsigned)wid * 1024u;
    const int aoff = lds_byte(wr * 64 + fr, fq * 8), boff = lds_byte(wc * 32 + fr, fq * 8);
#define PG8_SA(b, h) (((b) * 2 + (h)) * HTB)
#define PG8_SB(b, h) ((4 + (b) * 2 + (h)) * HTB)
#define PG8_STAGE(bufoff, gbase, voff) do { _Pragma("unroll") for (int _i = 0; _i < 2; ++_i) \
        __builtin_amdgcn_global_load_lds((const unsigned*)((const char*)(gbase) + (voff)[_i]), (PG8_LAS unsigned*)(lds + (bufoff) + ldsw + _i * 8192), 16, 0, 0); } while (0)
#define PG8_STAGE_A(bufoff, gbase, h_, o0_, o1_) do { if constexpr (GATHER) { if ((h_) == 0) PG8_STAGE(bufoff, gbase, o0_); else PG8_STAGE(bufoff, gbase, o1_); } \
        else { PG8_STAGE(bufoff, (gbase) + (h_) * hstep, oC0); } } while (0)
#define PG8_LDA(dst, b, h) do { _Pragma("unroll") for (int m = 0; m < 4; ++m) { if constexpr (F8) { dst##8[m].lo = *(const PG8_LAS i32x4_t*)(lds + PG8_SA(b, h) + aoff + m * 2048); dst##8[m].hi = *(const PG8_LAS i32x4_t*)(lds + PG8_SA(b, h) + aoff + m * 2048 + 1024); } \
        else { _Pragma("unroll") for (int k = 0; k < 2; ++k) dst[m][k] = *(const PG8_LAS bf16x8*)(lds + PG8_SA(b, h) + aoff + m * 2048 + k * 1024); } } } while (0)
#define PG8_LDB(dst, b, h) do { _Pragma("unroll") for (int n = 0; n < 2; ++n) { if constexpr (F8) { dst##8[n].lo = *(const PG8_LAS i32x4_t*)(lds + PG8_SB(b, h) + boff + n * 2048); dst##8[n].hi = *(const PG8_LAS i32x4_t*)(lds + PG8_SB(b, h) + boff + n * 2048 + 1024); } \
        else { _Pragma("unroll") for (int k = 0; k < 2; ++k) dst[n][k] = *(const PG8_LAS bf16x8*)(lds + PG8_SB(b, h) + boff + n * 2048 + k * 1024); } } } while (0)
#define PG8_MMA(ai, bj, At, Bt) do { __builtin_amdgcn_s_setprio(1); _Pragma("unroll") for (int m = 0; m < 4; ++m) _Pragma("unroll") for (int n = 0; n < 2; ++n) { \
        if constexpr (F8) asm volatile("v_mfma_scale_f32_16x16x128_f8f6f4 %0, %1, %2, %0, %3, %3 op_sel_hi:[0,0,0]" : "+v"(acc[ai][bj][m][n]) : "v"(Bt##8[n]), "v"(At##8[m]), "v"(sc127));     \
        else { _Pragma("unroll") for (int k = 0; k < 2; ++k) acc[ai][bj][m][n] = __builtin_amdgcn_mfma_f32_16x16x32_bf16(Bt[n][k], At[m][k], acc[ai][bj][m][n], 0, 0, 0); } } \
        __builtin_amdgcn_s_setprio(0); } while (0)
#define PG8_WAIT_V(n) asm volatile("s_waitcnt vmcnt(" #n ")" ::: "memory")
#define PG8_WAIT_L(n) asm volatile("s_waitcnt lgkmcnt(" #n ")" ::: "memory")
#define PG8_WAIT_VF do { if (relax_) asm volatile("s_waitcnt vmcnt(%0)" :: "n"(8 + Epi::NST) : "memory"); else PG8_WAIT_V(8); } while (0)
#define PG8_BAR __builtin_amdgcn_s_barrier()
#define PG8_SCHED __builtin_amdgcn_sched_barrier(0)
    Unit cur, nxt; int ui = 0;
    if (!S.next(0, cur)) return;
    f32x4 acc[2][2][4][2];
#pragma unroll
    for (int a = 0; a < 2; ++a)
#pragma unroll
        for (int b = 0; b < 2; ++b)
#pragma unroll
            for (int m = 0; m < 4; ++m)
#pragma unroll
                for (int n = 0; n < 2; ++n) acc[a][b][m][n] = (f32x4){0.f, 0.f, 0.f, 0.f};
    int sc127 = 127; asm volatile("" : "+v"(sc127));
    bf16x8 At[4][2], B0[2][2], B1[2][2]; i32x8_t At8[4], B08[2], B18[2];
    const char* cA = (const char*)g.A + (GATHER ? (size_t)0 : (size_t)cur.pm * tstep); const char* cB = (const char*)g.Bt + (size_t)cur.pn * tstep;
    S.a_ready(cur);
    if constexpr (GATHER) { PG8_GOFFS(cur, oC0, oC1); }
    if constexpr (SP2) {
        PG8_STAGE(PG8_SB(0, 0), cB, voffB); PG8_STAGE(PG8_SB(0, 1), cB + hstep, voffB); PG8_STAGE_A(PG8_SA(0, 0), cA, 0, oC0, oC1); PG8_STAGE_A(PG8_SA(0, 1), cA, 1, oC0, oC1);
        if (wr == 1) PG8_BAR;
        PG8_WAIT_V(2); PG8_BAR;
        PG8_STAGE(PG8_SB(1, 0), cB + kstep, voffB); PG8_STAGE_A(PG8_SA(1, 0), cA + kstep, 0, oC0, oC1); PG8_STAGE(PG8_SB(1, 1), cB + hstep + kstep, voffB);
        PG8_WAIT_V(6); PG8_BAR;
    } else {
        PG8_STAGE(PG8_SB(0, 0), cB, voffB); PG8_STAGE_A(PG8_SA(0, 0), cA, 0, oC0, oC1); PG8_STAGE(PG8_SB(0, 1), cB + hstep, voffB); PG8_STAGE_A(PG8_SA(0, 1), cA, 1, oC0, oC1);
        if (wr == 1) PG8_BAR;
        PG8_WAIT_V(4); PG8_BAR;
        PG8_STAGE(PG8_SB(1, 0), cB + kstep, voffB); PG8_STAGE_A(PG8_SA(1, 0), cA + kstep, 0, oC0, oC1); PG8_STAGE(PG8_SB(1, 1), cB + hstep + kstep, voffB);
        PG8_WAIT_V(6); PG8_BAR;
    }
    for (;;) {
        const bool has_next = S.next(ui + 1, nxt);
        const char* nA = (has_next && !GATHER) ? (const char*)g.A + (size_t)nxt.pm * tstep : cA;
        if constexpr (GATHER) { if (has_next) { PG8_GOFFS(nxt, oN0, oN1); } else { _Pragma("unroll") for (int _i = 0; _i < 2; ++_i) { oN0[_i] = oC0[_i]; oN1[_i] = oC1[_i]; } } } const char* nB = has_next ? (const char*)g.Bt + (size_t)nxt.pn * tstep : cB;
        for (int t = 0; t < nt; t += 2) {
            const bool last = (t == nt - 2); const bool relax_ = ((PG8_RELAX >> Epi::RID) & 1) && !GATHER && Epi::NST > 0 && t == 0 && ui > 0;
            const char* a1 = cA + (size_t)(t + 1) * kstep;
            const char* a2 = last ? nA : cA + (size_t)(t + 2) * kstep; const char* b2 = last ? nB : cB + (size_t)(t + 2) * kstep;
            const char* a3 = a2 + kstep; const char* b3 = b2 + kstep;
            unsigned oX0[2], oX1[2];
#pragma unroll
            for (int _i = 0; _i < 2; ++_i) { oX0[_i] = (GATHER && last) ? oN0[_i] : oC0[_i]; oX1[_i] = (GATHER && last) ? oN1[_i] : oC1[_i]; }
            if (last && has_next) S.a_ready(nxt);
            if constexpr (SP2) {
            PG8_LDB(B0, 0, 0); PG8_LDB(B1, 0, 1); PG8_SCHED; PG8_LDA(At, 0, 0); PG8_STAGE_A(PG8_SA(1, 1), a1, 1, oC0, oC1);
            PG8_WAIT_VF; PG8_WAIT_L(0); PG8_BAR; PG8_MMA(0, 0, At, B0); PG8_MMA(0, 1, At, B1); PG8_BAR; PG8_SCHED;
            PG8_LDA(At, 0, 1); PG8_STAGE(PG8_SB(0, 0), b2, voffB); PG8_STAGE(PG8_SB(0, 1), b2 + hstep, voffB); PG8_STAGE_A(PG8_SA(0, 0), a2, 0, oX0, oX1);
            PG8_WAIT_VF; PG8_WAIT_L(0); PG8_BAR; PG8_MMA(1, 0, At, B0); PG8_MMA(1, 1, At, B1); PG8_BAR; PG8_SCHED;
            PG8_LDB(B0, 1, 0); PG8_LDB(B1, 1, 1); PG8_SCHED; PG8_LDA(At, 1, 0); PG8_STAGE_A(PG8_SA(0, 1), a2, 1, oX0, oX1);
            PG8_WAIT_V(8); PG8_WAIT_L(0); PG8_BAR; PG8_MMA(0, 0, At, B0); PG8_MMA(0, 1, At, B1); PG8_BAR; PG8_SCHED;
            PG8_LDA(At, 1, 1); PG8_STAGE(PG8_SB(1, 0), b3, voffB); PG8_STAGE(PG8_SB(1, 1), b3 + hstep, voffB); PG8_STAGE_A(PG8_SA(1, 0), a3, 0, oX0, oX1);
            PG8_WAIT_V(8); PG8_WAIT_L(0); PG8_BAR; PG8_MMA(1, 0, At, B0); PG8_MMA(1, 1, At, B1); PG8_BAR; PG8_SCHED;
            } else {
            PG8_LDB(B0, 0, 0); PG8_SCHED; PG8_LDA(At, 0, 0); PG8_STAGE_A(PG8_SA(1, 1), a1, 1, oC0, oC1);
            PG8_WAIT_L(8); PG8_BAR; PG8_WAIT_L(0); PG8_MMA(0, 0, At, B0); PG8_BAR; PG8_SCHED;
            PG8_LDB(B1, 0, 1); PG8_STAGE(PG8_SB(0, 0), b2, voffB);
            PG8_BAR; PG8_WAIT_L(0); PG8_MMA(0, 1, At, B1); PG8_BAR;
            PG8_LDA(At, 0, 1); PG8_STAGE_A(PG8_SA(0, 0), a2, 0, oX0, oX1);
            PG8_BAR; PG8_WAIT_L(0); PG8_MMA(1, 0, At, B0); PG8_BAR; PG8_SCHED;
            PG8_STAGE(PG8_SB(0, 1), b2 + hstep, voffB);
            PG8_WAIT_V(6); PG8_BAR; PG8_MMA(1, 1, At, B1); PG8_BAR;
            PG8_LDB(B0, 1, 0); PG8_SCHED; PG8_LDA(At, 1, 0); PG8_STAGE_A(PG8_SA(0, 1), a2, 1, oX0, oX1);
            PG8_WAIT_L(8); PG8_BAR; PG8_WAIT_L(0); PG8_MMA(0, 0, At, B0); PG8_BAR; PG8_SCHED;
            PG8_LDB(B1, 1, 1); PG8_STAGE(PG8_SB(1, 0), b3, voffB);
            PG8_BAR; PG8_WAIT_L(0); PG8_MMA(0, 1, At, B1); PG8_BAR;
            PG8_LDA(At, 1, 1); PG8_STAGE_A(PG8_SA(1, 0), a3, 0, oX0, oX1);
            PG8_BAR; PG8_WAIT_L(0); PG8_MMA(1, 0, At, B0); PG8_BAR; PG8_SCHED;
            PG8_STAGE(PG8_SB(1, 1), b3 + hstep, voffB);
            PG8_WAIT_V(6); PG8_BAR; PG8_MMA(1, 1, At, B1); PG8_BAR;
            }
        }
        if constexpr (F8) asm volatile("s_nop 15\n\ts_nop 15" ::: "memory");
        if constexpr (ALIGN_EPI) { if (wr == 0) PG8_BAR; }
        if constexpr (!Epi::AFTER_DRAIN) { const int l_ = fresh_tid(0); E(acc, cur, wr, wc, l_ & 15, l_ >> 4); S.done(cur); }
        if (!has_next) break;
#pragma unroll
        for (int a = 0; a < 2; ++a)
#pragma unroll
            for (int b = 0; b < 2; ++b)
#pragma unroll
                for (int m = 0; m < 4; ++m)
#pragma unroll
                    for (int n = 0; n < 2; ++n) acc[a][b][m][n] = (f32x4){0.f, 0.f, 0.f, 0.f};
        cur = nxt; cA = nA; cB = nB; ++ui;
        if constexpr (GATHER) { _Pragma("unroll") for (int _i = 0; _i < 2; ++_i) { oC0[_i] = oN0[_i]; oC1[_i] = oN1[_i]; } }
        if constexpr (ALIGN_EPI) { if (wr == 1) PG8_BAR; }
    }
    PG8_WAIT_V(0);
    if constexpr (!ALIGN_EPI) { if (wr == 0) PG8_BAR; }
    PG8_BAR;
    if constexpr (Epi::AFTER_DRAIN) { E.fused(acc, cur, wr, wc, fr, fq, lds, wid, lane); S.done(cur); }
#undef PG8_SA
#undef PG8_GOFFS
#undef PG8_STAGE_A
#undef PG8_SB
#undef PG8_STAGE
#undef PG8_LDA
#undef PG8_LDB
#undef PG8_MMA
#undef PG8_WAIT_V
#undef PG8_WAIT_L
#undef PG8_BAR
#undef PG8_SCHED
}
}

namespace att {
typedef unsigned short bf16_t;
typedef short bf16x8 __attribute__((ext_vector_type(8)));
typedef short s16x4 __attribute__((ext_vector_type(4)));
typedef float f32x16 __attribute__((ext_vector_type(16)));
typedef float f32x4 __attribute__((ext_vector_type(4)));
typedef unsigned u32x4 __attribute__((ext_vector_type(4)));
constexpr int LDZ = 10752;
constexpr int WS_OFF = 98304, TAB_OFF = WS_OFF + 2048, TAB_N = 2304, ATT_LDS = TAB_OFF + TAB_N * 4;
constexpr float THR = 8.f;
#define SBAR() __builtin_amdgcn_sched_barrier(0)
__device__ __forceinline__ int crow(int r, int hi) { return (r & 3) + 8 * (r >> 2) + 4 * hi; }
__device__ __forceinline__ unsigned cvtpk(float lo, float hi) { unsigned r; asm volatile("v_cvt_pk_bf16_f32 %0, %1, %2" : "=v"(r) : "v"(lo), "v"(hi)); return r; }
template <int DH> __device__ __forceinline__ int kswz(int row, int colB) { return row * (DH * 2) + (colB ^ ((row & 7) << 4)); }
template <int DH> __device__ __forceinline__ int v_st(int k, int c) { const int kk = (k & ~0xC) | ((k & 4) << 1) | ((k & 8) >> 1); return ((kk >> 3) * (DH / 32) + (c >> 5)) * 512 + ((kk & 7) * 32 + (c & 31)) * 2; }
__device__ __forceinline__ int v_rd_base(int lane) { return ((lane & 3) << 3) | (((lane >> 2) & 3) << 6) | (((lane >> 4) & 1) << 5) | (((lane >> 5) & 1) << 8); }
__device__ __forceinline__ bf16x8 ld8(const bf16_t* p) { return *reinterpret_cast<const bf16x8*>(p); }
__device__ __forceinline__ size_t vrow_off(int v, int dil, int lgL) { return (size_t)((v & ((1 << lgL) - 1)) * dil + (v >> lgL)) * LDZ; }
__device__ __forceinline__ int vrow_tok(int v, int dil, int lgL) { return (v & ((1 << lgL) - 1)) * dil + (v >> lgL); }

__device__ __forceinline__ void bias_tile(f32x16& p0, f32x16& p1, const float* tb) {
#pragma unroll
    for (int r = 0; r < 16; ++r) { const int c = (r & 3) + 8 * (r >> 2); p0[r] += tb[59 - c]; p1[r] += tb[27 - c]; }
}
__device__ __forceinline__ void mask_tile(f32x16& p0, f32x16& p1, int dq, unsigned W) {
    const float NEG = -__builtin_inff();
#pragma unroll
    for (int r = 0; r < 16; ++r) { const int c = (r & 3) + 8 * (r >> 2);
        if ((unsigned)(dq - c) >= W) p0[r] = NEG;
        if ((unsigned)(dq - c - 32) >= W) p1[r] = NEG; }
}
template <int DH>
__device__ __forceinline__ void partialSM(f32x16& p0, f32x16& p1, float& m_reg, float& mn, float& alpha) {
    constexpr float SCALE = DH == 128 ? 0.08838834764831845f : 0.125f;
    float pmax = p0[0];
#pragma unroll
    for (int r = 1; r < 16; ++r) pmax = fmaxf(pmax, p0[r]);
#pragma unroll
    for (int r = 0; r < 16; ++r) pmax = fmaxf(pmax, p1[r]);
    { auto rr = __builtin_amdgcn_permlane32_swap(__float_as_uint(pmax), __float_as_uint(pmax), false, false);
      pmax = fmaxf(__uint_as_float(rr[0]), __uint_as_float(rr[1])); }
    constexpr float C2 = 1.4426950408889634f * SCALE;
    if (__builtin_expect(__all((pmax - m_reg) * SCALE <= THR), 1)) { mn = m_reg; alpha = 1.f; }
    else { mn = fmaxf(m_reg, pmax); alpha = __builtin_amdgcn_exp2f((m_reg - mn) * C2); m_reg = mn; }
    const float mnL = -mn * C2;
#pragma unroll
    for (int r = 0; r < 16; ++r) p0[r] = fmaf(p0[r], C2, mnL);
#pragma unroll
    for (int r = 0; r < 16; ++r) p1[r] = fmaf(p1[r], C2, mnL);
#pragma unroll
    for (int r = 0; r < 16; ++r) p0[r] = __builtin_amdgcn_exp2f(p0[r]);
}
__device__ __forceinline__ void finishSM(f32x16& p0, f32x16& p1, float alpha, float& l_reg, bf16x8& pa0, bf16x8& pa1, bf16x8& pa2, bf16x8& pa3) {
#pragma unroll
    for (int r = 0; r < 16; ++r) p1[r] = __builtin_amdgcn_exp2f(p1[r]);
    float ps = 0;
#pragma unroll
    for (int r = 0; r < 16; ++r) ps += p0[r];
#pragma unroll
    for (int r = 0; r < 16; ++r) ps += p1[r];
    { auto rr = __builtin_amdgcn_permlane32_swap(__float_as_uint(ps), __float_as_uint(ps), false, false);
      ps = __uint_as_float(rr[0]) + __uint_as_float(rr[1]); }
    l_reg = l_reg * alpha + ps;
#define PK4(P, B_, OUT) do { unsigned a0 = cvtpk(P[B_+0], P[B_+1]), a1 = cvtpk(P[B_+2], P[B_+3]);                          \
        unsigned b0 = cvtpk(P[B_+4], P[B_+5]), b1 = cvtpk(P[B_+6], P[B_+7]);                                             \
        auto r0 = __builtin_amdgcn_permlane32_swap(a0, b0, false, false); auto r1 = __builtin_amdgcn_permlane32_swap(a1, b1, false, false); \
        u32x4 w = {r0[0], r1[0], r0[1], r1[1]}; OUT = *reinterpret_cast<bf16x8*>(&w); } while (0)
    PK4(p0, 0, pa0); PK4(p0, 8, pa1); PK4(p1, 0, pa2); PK4(p1, 8, pa3);
#undef PK4
}
__device__ __forceinline__ void finishSM_ns(f32x16& p0, f32x16& p1, bf16x8& pa0, bf16x8& pa1, bf16x8& pa2, bf16x8& pa3) {
#pragma unroll
    for (int r = 0; r < 16; ++r) p1[r] = __builtin_amdgcn_exp2f(p1[r]);
#define PK4(P, B_, OUT) do { unsigned a0 = cvtpk(P[B_+0], P[B_+1]), a1 = cvtpk(P[B_+2], P[B_+3]);                          \
        unsigned b0 = cvtpk(P[B_+4], P[B_+5]), b1 = cvtpk(P[B_+6], P[B_+7]);                                             \
        auto r0 = __builtin_amdgcn_permlane32_swap(a0, b0, false, false); auto r1 = __builtin_amdgcn_permlane32_swap(a1, b1, false, false); \
        u32x4 w = {r0[0], r1[0], r0[1], r1[1]}; OUT = *reinterpret_cast<bf16x8*>(&w); } while (0)
    PK4(p0, 0, pa0); PK4(p0, 8, pa1); PK4(p1, 0, pa2); PK4(p1, 8, pa3);
#undef PK4
}
template <int DH, bool SK>
__device__ __forceinline__ void qkt(f32x16& p0, f32x16& p1, const char* K_slot, int r32, int hi, const bf16x8* qr, bool act, const float* tb = nullptr) {
    if (SK && !act) { const float NEG = -__builtin_inff();
#pragma unroll
        for (int r = 0; r < 16; ++r) { p0[r] = NEG; p1[r] = NEG; } return; }
    if (tb) {
#pragma unroll
        for (int r = 0; r < 16; ++r) { const int c = (r & 3) + 8 * (r >> 2); p0[r] = tb[59 - c]; p1[r] = tb[27 - c]; }
    } else { p0 = f32x16{}; p1 = f32x16{}; }
    const char* kb[4];
    if constexpr (DH == 128) {
#pragma unroll
        for (int dd = 0; dd < 4; ++dd) kb[dd] = K_slot + kswz<DH>(r32, (dd * 16 + hi * 8) * 2);
#pragma unroll
        for (int d0 = 0; d0 < 8; ++d0) { const char* a = kb[d0 & 3] + (d0 >> 2) * 128;
            bf16x8 b0 = *reinterpret_cast<const bf16x8*>(a);
            bf16x8 b1 = *reinterpret_cast<const bf16x8*>(a + 32 * 256);
            p0 = __builtin_amdgcn_mfma_f32_32x32x16_bf16(b0, qr[d0], p0, 0, 0, 0);
            p1 = __builtin_amdgcn_mfma_f32_32x32x16_bf16(b1, qr[d0], p1, 0, 0, 0); }
    } else {
#pragma unroll
        for (int dd = 0; dd < 4; ++dd) kb[dd] = K_slot + kswz<DH>(r32, (dd * 16 + hi * 8) * 2);
#pragma unroll
        for (int d0 = 0; d0 < 4; ++d0) { const char* a = kb[d0];
            bf16x8 b0 = *reinterpret_cast<const bf16x8*>(a);
            bf16x8 b1 = *reinterpret_cast<const bf16x8*>(a + 32 * 128);
            p0 = __builtin_amdgcn_mfma_f32_32x32x16_bf16(b0, qr[d0], p0, 0, 0, 0);
            p1 = __builtin_amdgcn_mfma_f32_32x32x16_bf16(b1, qr[d0], p1, 0, 0, 0); }
    }
}
__device__ __forceinline__ void qkt_bias128(f32x16& p0, f32x16& p1, const char* K_slot, int r32, int hi, const bf16x8* qr, const float* tb) {
#pragma unroll
    for (int r = 0; r < 16; ++r) { const int c = (r & 3) + 8 * (r >> 2); p0[r] = tb[59 - c]; p1[r] = tb[27 - c]; }
    const char* kb[4];
#pragma unroll
    for (int dd = 0; dd < 4; ++dd) kb[dd] = K_slot + kswz<128>(r32, (dd * 16 + hi * 8) * 2);
#pragma unroll
    for (int d0 = 0; d0 < 8; ++d0) { const char* a = kb[d0 & 3] + (d0 >> 2) * 128;
        bf16x8 b0 = *reinterpret_cast<const bf16x8*>(a);
        bf16x8 b1 = *reinterpret_cast<const bf16x8*>(a + 32 * 256);
        p0 = __builtin_amdgcn_mfma_f32_32x32x16_bf16(b0, qr[d0], p0, 0, 0, 0);
        p1 = __builtin_amdgcn_mfma_f32_32x32x16_bf16(b1, qr[d0], p1, 0, 0, 0); }
}
template <int DH, bool SK>
__device__ __forceinline__ void pv_tile(f32x16* o, int vb0, bf16x8 pa0, bf16x8 pa1, bf16x8 pa2, bf16x8 pa3, bool act) {
    constexpr int HF = (DH / 32) * 512, KS = 2 * HF;
    if (SK && !act) return;
#define TRRD(dst, off) asm volatile("ds_read_b64_tr_b16 %0, %1 offset:%2" : "=&v"(dst) : "v"(vb0), "i"(off) : "memory")
#define PV_D0(d0) do { s16x4 l0, l1, l2, l3, h0, h1, h2, h3; constexpr int b_ = (d0) * 512; \
        TRRD(l0, b_); TRRD(h0, b_ + HF); TRRD(l1, b_ + KS); TRRD(h1, b_ + KS + HF); TRRD(l2, b_ + 2 * KS); TRRD(h2, b_ + 2 * KS + HF); TRRD(l3, b_ + 3 * KS); TRRD(h3, b_ + 3 * KS + HF); \
        asm volatile("s_waitcnt lgkmcnt(0)" ::: "memory"); SBAR();   \
        o[d0] = __builtin_amdgcn_mfma_f32_32x32x16_bf16(pa0, (bf16x8){l0[0], l0[1], l0[2], l0[3], h0[0], h0[1], h0[2], h0[3]}, o[d0], 0, 0, 0);   \
        o[d0] = __builtin_amdgcn_mfma_f32_32x32x16_bf16(pa1, (bf16x8){l1[0], l1[1], l1[2], l1[3], h1[0], h1[1], h1[2], h1[3]}, o[d0], 0, 0, 0);   \
        o[d0] = __builtin_amdgcn_mfma_f32_32x32x16_bf16(pa2, (bf16x8){l2[0], l2[1], l2[2], l2[3], h2[0], h2[1], h2[2], h2[3]}, o[d0], 0, 0, 0);   \
        o[d0] = __builtin_amdgcn_mfma_f32_32x32x16_bf16(pa3, (bf16x8){l3[0], l3[1], l3[2], l3[3], h3[0], h3[1], h3[2], h3[3]}, o[d0], 0, 0, 0); } while (0)
    PV_D0(0); PV_D0(1);
    if constexpr (DH == 128) { PV_D0(2); PV_D0(3); }
#undef PV_D0
#undef TRRD
}

struct BlockRef { const bf16_t* Q; const bf16_t* K; const bf16_t* V; float* scr; bf16_t* O; float* lse; int P0, dil, lgL, mode, ldo, head; float lam; };
template <int DH> struct Seam { bf16x8 qr[DH / 16]; bf16x8 st_v0, st_v1, st_k0, st_k1; };

template <bool BANDED> __device__ __forceinline__ int blk_lowk(int P0, int lgL) { const int ss = P0 & ~((1 << lgL) - 1); int lk = BANDED ? P0 - 128 : 0; return lk < ss ? ss : lk; }

#define VMW() asm volatile("s_waitcnt vmcnt(0)" ::: "memory")
#define VMWN(n) asm volatile("s_waitcnt vmcnt(%0)" :: "i"(n) : "memory")
#define TBASE(v0, dl, lg) ((size_t)(BANDED ? vrow_tok((v0), (dl), (lg)) : (v0)) * LDZ)
#define LOFF(rr, dl) ((unsigned)((rr) * (BANDED ? (dl) : 1) * LDZ + sc))
#define SLOAD_H(Kp, Vp, k0, dl, lg) do { const bf16_t* kp_ = (Kp) + TBASE(k0, dl, lg); const bf16_t* vp_ = (Vp) + TBASE(k0, dl, lg); const unsigned l0_ = LOFF(sr, dl); \
        S.st_v0 = ld8(vp_ + l0_); if constexpr (DH == 128) S.st_v1 = ld8(vp_ + LOFF(32 + sr, dl)); \
        S.st_k0 = ld8(kp_ + l0_); if constexpr (DH == 128) S.st_k1 = ld8(kp_ + LOFF(32 + sr, dl)); } while (0)
#define SWRITE_HK(so) do { *(bf16x8*)(K_lds + (so) + kws) = S.st_k0; if constexpr (DH == 128) *(bf16x8*)(K_lds + (so) + kws + 32 * 256) = S.st_k1; } while (0)
#define SWRITE_HV(so) do { *(bf16x8*)(V_lds + (so) + vst0) = S.st_v0; if constexpr (DH == 128) *(bf16x8*)(V_lds + (so) + vst1) = S.st_v1; } while (0)
#define SWRITE_H(so) do { SWRITE_HV(so); SWRITE_HK(so); } while (0)
#define STAGE_IDX() int sr, sc, vst0, vst1, kws; \
    if constexpr (DH == 128) { sr = tid >> 4; sc = (tid & 15) * 8; vst0 = v_st<DH>(sr, sc); vst1 = v_st<DH>(32 + sr, sc); kws = kswz<DH>(sr, sc * 2); } \
    else { sr = tid >> 3; sc = (tid & 7) * 8; vst0 = v_st<DH>(sr, sc); vst1 = 0; kws = kswz<DH>(sr, sc * 2); } (void)vst1

#ifdef NO_BIAS
#define BIAS_CALL(a,b,c) do {} while (0)
#else
#define BIAS_CALL(a,b,c) bias_tile(a,b,c)
#endif
template <int DH, bool BANDED>
__device__ __forceinline__ void attn_prime(const BlockRef& cur, char* lds, Seam<DH>& S, const int tid) {
    constexpr int SHM = 64 * DH * 2;
    const int wid = __builtin_amdgcn_readfirstlane(tid >> 6), lane = tid & 63, r32 = lane & 31, hi = lane >> 5;
    STAGE_IDX(); (void)vst0;
    char* K_lds = lds + 3 * SHM;
    const int kb0 = blk_lowk<BANDED>(cur.P0, cur.lgL) & ~63;
    const bf16_t* qp = cur.Q + TBASE(cur.P0 + wid * 32, cur.dil, cur.lgL) + (unsigned)(r32 * (BANDED ? cur.dil : 1) * LDZ + hi * 8);
#pragma unroll
    for (int d0 = 0; d0 < DH / 16; ++d0) S.qr[d0] = ld8(qp + d0 * 16);
    SLOAD_H(cur.K, cur.V, kb0, cur.dil, cur.lgL); VMW(); SWRITE_HK(0);
    __syncthreads();
}
template <int DH, bool BANDED>
__device__ __forceinline__ void attn_block(const BlockRef& cur, const BlockRef& nxt, char* lds, Seam<DH>& S, const int tid) {
    constexpr int SHM = 64 * DH * 2, NQ = DH / 16, ND = DH / 32;
    constexpr float SCALE = DH == 128 ? 0.08838834764831845f : 0.125f;
    constexpr bool SK = BANDED;
    const int wid = __builtin_amdgcn_readfirstlane(tid >> 6), lane = tid & 63, r32 = lane & 31, hi = lane >> 5;
    const int dil = cur.dil, lgL = cur.lgL, Lm = (1 << lgL) - 1;
    const int j_lo = blk_lowk<BANDED>(cur.P0, lgL) >> 6;
    const int NT = (cur.P0 >> 6) + 4 - j_lo;
    const int kbn = blk_lowk<BANDED>(nxt.P0, nxt.lgL) & ~63;
    const int qlo = cur.P0 + wid * 32, qv = qlo + r32, qm = qv - 4 * hi;
    unsigned Wl = 0x40000000u; int wlow = 0;
    if constexpr (BANDED) { const int l1 = (qv & Lm) + 1; Wl = (unsigned)(l1 < 129 ? l1 : 129); wlow = qlo - 128; const int ss = qlo & ~Lm; if (wlow < ss) wlow = ss; }
    char* V_lds = lds; char* K_lds = lds + 3 * SHM;
    float* ws = (float*)(lds + WS_OFF) + wid * 64; float* li_l = ws; float* al_l = ws + 32;
    const float* tab = (const float*)(lds + TAB_OFF) + (256 - 59);
    float m_reg = -1e30f, l_reg = 0; f32x16 o[ND];
#pragma unroll
    for (int d_ = 0; d_ < ND; ++d_) o[d_] = f32x16{};
    STAGE_IDX();
    const int vb0 = (int)(uintptr_t)V_lds + v_rd_base(lane);
    const bf16_t* Kh = cur.K; const bf16_t* Vh = cur.V;
#define RESC(a) do { if (__any((a) < 1.f)) { if (hi == 0) al_l[r32] = (a); asm volatile("s_waitcnt lgkmcnt(0)" ::: "memory");              \
                     _Pragma("unroll") for (int d_ = 0; d_ < ND; ++d_) _Pragma("unroll") for (int r = 0; r < 16; ++r) o[d_][r] *= al_l[crow(r, hi)]; } } while (0)
#define KBASE(t) ((j_lo + (t)) * 64)
#define ACT(t) (KBASE(t) <= qlo + 31 && KBASE(t) + 63 >= wlow)
#define MASKT(P0_, P1_, t) do { const int kb_ = KBASE(t); if (!SK || ACT(t)) { if (BANDED || kb_ + 63 > qlo) mask_tile(P0_, P1_, qm - kb_, Wl); } } while (0)
#define TBT(t) (tab + (qm - KBASE(t)))
#define SEAM_K0() do { VMWN(NQ); SWRITE_HK(0); SBAR(); } while (0)
    f32x16 pA0, pA1, pB0, pB1; float mnA, mnB, alA, alB; bf16x8 pa0, pa1, pa2, pa3;
    int s_prev = 0, s_cur = 0, s_next = SHM;
#define ROT() do { s_prev = s_cur; s_cur = s_next; s_next = (s_next == 2 * SHM) ? 0 : s_next + SHM; } while (0)
    SWRITE_HV(0); SBAR();
    if (NT > 1) SLOAD_H(Kh, Vh, KBASE(1), dil, lgL);
    SBAR(); qkt<DH, SK>(pA0, pA1, K_lds, r32, hi, S.qr, ACT(0), TBT(0));
    MASKT(pA0, pA1, 0); partialSM<DH>(pA0, pA1, m_reg, mnA, alA);
    if (NT > 1) { VMW(); SWRITE_H(SHM); }
    __syncthreads();
#define HALF_STEP(PX0, PX1, mnX, alX, PY0, PY1, alY, t) do {                                                                   \
        ROT();                                                                   \
        if ((t) + 1 < NT) { SLOAD_H(Kh, Vh, KBASE((t) + 1), dil, lgL); }                                                      \
        SBAR(); qkt<DH, SK>(PX0, PX1, K_lds + s_cur, r32, hi, S.qr, ACT(t), TBT(t));                                           \
        finishSM(PY0, PY1, alY, l_reg, pa0, pa1, pa2, pa3); SBAR();                                                           \
        pv_tile<DH, SK>(o, vb0 + s_prev, pa0, pa1, pa2, pa3, ACT((t) - 1)); MASKT(PX0, PX1, (t)); partialSM<DH>(PX0, PX1, m_reg, mnX, alX); \
        if ((t) + 1 < NT) { VMW(); SWRITE_H(s_next); }                                                                        \
        RESC(alX); __syncthreads(); } while (0)
    for (int t = 1; t + 1 < NT; t += 2) {
        HALF_STEP(pB0, pB1, mnB, alB, pA0, pA1, alA, t);
        HALF_STEP(pA0, pA1, mnA, alA, pB0, pB1, alB, t + 1);
    }
    const bool even = (NT & 1) == 0;
    if (even) { ROT(); SBAR(); qkt<DH, SK>(pB0, pB1, K_lds + s_cur, r32, hi, S.qr, ACT(NT - 1), TBT(NT - 1)); SBAR(); }
    SLOAD_H(nxt.K, nxt.V, kbn, nxt.dil, nxt.lgL); SBAR();
    { const bf16_t* qp = nxt.Q + TBASE(nxt.P0 + wid * 32, nxt.dil, nxt.lgL) + (unsigned)(r32 * (BANDED ? nxt.dil : 1) * LDZ + hi * 8);
#pragma unroll
      for (int d0 = 0; d0 < NQ; ++d0) S.qr[d0] = ld8(qp + d0 * 16); }
    SBAR();
    finishSM(pA0, pA1, alA, l_reg, pa0, pa1, pa2, pa3); SBAR();
    pv_tile<DH, SK>(o, vb0 + (even ? s_prev : s_cur), pa0, pa1, pa2, pa3, ACT(even ? NT - 2 : NT - 1));
    if (even) { MASKT(pB0, pB1, NT - 1); partialSM<DH>(pB0, pB1, m_reg, mnB, alB); __syncthreads();
        RESC(alB);
        finishSM(pB0, pB1, alB, l_reg, pa0, pa1, pa2, pa3); SBAR(); pv_tile<DH, SK>(o, vb0 + s_cur, pa0, pa1, pa2, pa3, ACT(NT - 1)); }
    SBAR(); SEAM_K0();
    if (hi == 0) li_l[r32] = l_reg; asm volatile("s_waitcnt lgkmcnt(0)" ::: "memory");
    float rli[16];
#pragma unroll
    for (int r = 0; r < 16; ++r) rli[r] = __builtin_amdgcn_rcpf(li_l[crow(r, hi)]);
    int lo_ = r32, hh_ = hi, ln_ = lane; asm volatile("" : "+v"(lo_), "+v"(hh_), "+v"(ln_));
    if constexpr (BANDED) {
        bf16_t* ob = cur.O + lo_;
#pragma unroll
        for (int r = 0; r < 16; ++r) { const int tokr = vrow_tok(qlo + (r & 3) + 8 * (r >> 2) + 4 * hh_, dil, lgL); bf16_t* op = ob + (size_t)tokr * cur.ldo;
            const float v0 = o[0][r] * rli[r], v1 = o[1][r] * rli[r]; const float n0 = __shfl_xor(v0, 1), n1 = __shfl_xor(v1, 1);
            if ((lo_ & 1) == 0) { *(unsigned*)(op) = cvtpk(v0, n0); *(unsigned*)(op + 32) = cvtpk(v1, n1); } }
        if (hh_ == 0) cur.lse[(size_t)vrow_tok(qlo + lo_, dil, lgL) * 24] = m_reg * SCALE + 0.6931471805599453f * __builtin_amdgcn_logf(l_reg);
    } else {
        float* sw = cur.scr + (size_t)(wid * 32) * DH + ln_;
        if (cur.mode == 0) {
#pragma unroll
            for (int r = 0; r < 16; ++r)
#pragma unroll
                for (int d0 = 0; d0 < ND; ++d0) sw[(r * ND + d0) * 64] = o[d0][r] * rli[r];
        } else {
            const float lam = cur.lam; bf16_t* ob = cur.O + (size_t)(qlo + 4 * hh_) * cur.ldo + lo_;
#pragma unroll
            for (int r = 0; r < 16; ++r) { bf16_t* op = ob + (size_t)((r & 3) + 8 * (r >> 2)) * cur.ldo;
                float v[ND], n[ND];
#pragma unroll
                for (int d0 = 0; d0 < ND; ++d0) { v[d0] = sw[(r * ND + d0) * 64] - lam * (o[d0][r] * rli[r]); n[d0] = __shfl_xor(v[d0], 1); }
                if ((lo_ & 1) == 0) {
#pragma unroll
                    for (int d0 = 0; d0 < ND; ++d0) *(unsigned*)(op + d0 * 32) = cvtpk(v[d0], n[d0]); }
                if (r & 1) asm volatile("" ::: "memory"); }
        }
    }
    __syncthreads();
#undef RESC
#undef KBASE
#undef ACT
#undef MASKT
#undef TBT
#undef SEAM_K0
#undef HALF_STEP
#undef ROT
}

#ifndef A3_OLDPV
#define A3_OLDPV 0
#endif
constexpr int A2_V = 0, A2_K = 65536, A2_P = 98304, A2_WS = 139264, A2_TAB = 141312, A2_LDS_END = A2_TAB + TAB_N * 4;
#ifndef A3VAR
#define A3VAR 0
#endif
__device__ __forceinline__ void attn_block2(const BlockRef& cur, char* lds, const int tid, const float* tabsrc  , const int var = 0) {
    constexpr int DH = 128, SHMK = 16384, SHMV = 32768;
    const int wid = __builtin_amdgcn_readfirstlane(tid >> 6), lane = tid & 63, r32 = lane & 31, hi = lane >> 5;
    const bool isS = wid < 4; const int pw = wid & 3;
    const int NT = (cur.P0 >> 6) + 2;
    const int qlo = cur.P0 + pw * 32, qv = qlo + r32, qm = qv - 4 * hi;
    char* V_lds = lds + A2_V; char* K_lds = lds + A2_K; char* P_lds = lds + A2_P;
    float* wsA = (float*)(lds + A2_WS);
    if (isS) {
        const float* tab = (const float*)(lds + A2_TAB) + (256 - 59);
        bf16x8 qr[8]; bf16x8 stk[4]; bf16x8 pa0, pa1, pa2, pa3;
        const int sr = tid >> 4, sc = (tid & 15) * 8;
        unsigned lk = (unsigned)(sr * LDZ + sc); asm volatile("" : "+v"(lk));
        const int kws = kswz<DH>(sr, sc * 2);
        { const bf16_t* qp = cur.Q + (size_t)qlo * LDZ + (unsigned)(r32 * LDZ + hi * 8);
#pragma unroll
          for (int d0 = 0; d0 < 8; ++d0) qr[d0] = ld8(qp + d0 * 16); }
#define KLOAD(t_) do { const bf16_t* kp_ = cur.K + (size_t)((t_) * 64) * LDZ; _Pragma("unroll") for (int i_ = 0; i_ < 4; ++i_) stk[i_] = ld8((kp_ + (size_t)(16 * i_) * LDZ) + lk); } while (0)
#define KWRITE(so) do { _Pragma("unroll") for (int i_ = 0; i_ < 4; ++i_) *(bf16x8*)(K_lds + (so) + kws + i_ * 16 * 256) = stk[i_]; } while (0)
        { bf16x8 stk2[4];
          const bf16_t* kp_ = cur.K;
#pragma unroll
          for (int i_ = 0; i_ < 4; ++i_) { stk[i_] = ld8((kp_ + (size_t)(16 * i_) * LDZ) + lk); stk2[i_] = ld8((kp_ + (size_t)(64 + 16 * i_) * LDZ) + lk); }
          if (tabsrc) { float* td = (float*)(lds + A2_TAB); for (int i_ = tid; i_ < TAB_N; i_ += 256) td[i_] = tabsrc[i_]; }
          VMW(); KWRITE(0);
#pragma unroll
          for (int i_ = 0; i_ < 4; ++i_) *(bf16x8*)(K_lds + SHMK + kws + i_ * 16 * 256) = stk2[i_]; }
        __syncthreads();
        float m_reg = -1e30f; f32x16 pA0, pA1, pB0, pB1; f32x16 lacc = f32x16{};
        const bf16x8 ones = (bf16x8){0x3F80, 0x3F80, 0x3F80, 0x3F80, 0x3F80, 0x3F80, 0x3F80, 0x3F80};
        qkt_bias128(pA0, pA1, K_lds, r32, hi, qr, tab + qm);
        __syncthreads();
#define SSTEP(PX0, PX1, PN0, PN1, t) do {                                                                                      \
            if ((t) + 2 < NT && !(var & 1)) KLOAD((t) + 2);                                                                     \
            SBAR(); if ((t) + 1 < NT) qkt_bias128(PN0, PN1, K_lds + (((t) + 1) & 1) * SHMK, r32, hi, qr, tab + (qm - ((t) + 1) * 64)); \
            float mn_, al_ = 1.f;                                                                                               \
            if (!(var & 2)) { { const int kb_ = (t) * 64; if (kb_ + 63 > qlo) mask_tile(PX0, PX1, qm - kb_, 0x40000000u); } \
            partialSM<DH>(PX0, PX1, m_reg, mn_, al_); }                                                                         \
            if (hi == 0) wsA[(((t) & 1) * 4 + pw) * 32 + r32] = al_;                                                            \
            if (!(var & 2)) { finishSM_ns(PX0, PX1, pa0, pa1, pa2, pa3);                                                        \
                if (__any(al_ < 1.f)) { const float* alw_ = wsA + (((t) & 1) * 4 + pw) * 32; asm volatile("s_waitcnt lgkmcnt(0)" ::: "memory"); _Pragma("unroll") for (int r = 0; r < 16; ++r) lacc[r] *= alw_[crow(r, hi)]; } \
                lacc = __builtin_amdgcn_mfma_f32_32x32x16_bf16(pa0, ones, lacc, 0, 0, 0); lacc = __builtin_amdgcn_mfma_f32_32x32x16_bf16(pa1, ones, lacc, 0, 0, 0); \
                lacc = __builtin_amdgcn_mfma_f32_32x32x16_bf16(pa2, ones, lacc, 0, 0, 0); lacc = __builtin_amdgcn_mfma_f32_32x32x16_bf16(pa3, ones, lacc, 0, 0, 0); } \
            else { lacc[0] += PX0[0] + PX1[0]; pa0 = (bf16x8){}; pa1 = pa0; pa2 = pa0; pa3 = pa0; }                             \
            { bf16x8* pp = (bf16x8*)(P_lds + ((t) & 1) * 16384 + pw * 4096) + lane; pp[0] = pa0; pp[64] = pa1; pp[128] = pa2; pp[192] = pa3; } \
            if ((t) + 2 < NT) { VMW(); KWRITE(((t) & 1) * SHMK); }                                                              \
            __syncthreads(); } while (0)
        for (int t = 0; t < NT; t += 2) {
            SSTEP(pA0, pA1, pB0, pB1, t);
            SSTEP(pB0, pB1, pA0, pA1, t + 1);
        }
        if (r32 == 0) {
#pragma unroll
            for (int r = 0; r < 16; ++r) wsA[256 + pw * 32 + crow(r, hi)] = lacc[r]; }
        __syncthreads();
#undef SSTEP
#undef KLOAD
#undef KWRITE
    } else {
        bf16x8 stv[8]; bf16x8 pa0, pa1, pa2, pa3;
        f32x16 o[8];
#pragma unroll
        for (int d_ = 0; d_ < 8; ++d_) o[d_] = f32x16{};
        const int vb0 = (int)(uintptr_t)V_lds + v_rd_base(lane);
        const int t2 = tid - 256, vr = t2 >> 5, vc = (t2 & 31) * 8;
        unsigned lv = (unsigned)(vr * LDZ + vc); asm volatile("" : "+v"(lv));
        const int vhalf = (vc >> 7) * 16384, vcc = vc & 127;
#define VLOAD(t_) do { const bf16_t* vp_ = cur.V + (size_t)((t_) * 64) * LDZ; _Pragma("unroll") for (int i_ = 0; i_ < 8; ++i_) stv[i_] = ld8((vp_ + (size_t)(8 * i_) * LDZ) + lv); } while (0)
#define VWRITE(so) do { _Pragma("unroll") for (int i_ = 0; i_ < 8; ++i_) *(bf16x8*)(V_lds + (so) + vhalf + v_st<DH>(vr + 8 * i_, vcc)) = stv[i_]; } while (0)
#define TR2(dl, dh, off) do { asm volatile("ds_read_b64_tr_b16 %0, %1 offset:%2" : "=&v"(dl) : "v"(vbx), "i"(off) : "memory"); asm volatile("ds_read_b64_tr_b16 %0, %1 offset:%2" : "=&v"(dh) : "v"(vbx), "i"((off) + 2048) : "memory"); } while (0)
#define LDD(fl, fh, d0) do { TR2(fl[0], fh[0], ((d0) >> 2) * 16384 + ((d0) & 3) * 512); TR2(fl[1], fh[1], ((d0) >> 2) * 16384 + ((d0) & 3) * 512 + 4096); \
                             TR2(fl[2], fh[2], ((d0) >> 2) * 16384 + ((d0) & 3) * 512 + 8192); TR2(fl[3], fh[3], ((d0) >> 2) * 16384 + ((d0) & 3) * 512 + 12288); } while (0)
#define FR(fl, fh, j) (bf16x8){fl[j][0], fl[j][1], fl[j][2], fl[j][3], fh[j][0], fh[j][1], fh[j][2], fh[j][3]}
#define MMD(fl, fh, d0) do { o[d0] = __builtin_amdgcn_mfma_f32_32x32x16_bf16(pa0, FR(fl, fh, 0), o[d0], 0, 0, 0); o[d0] = __builtin_amdgcn_mfma_f32_32x32x16_bf16(pa1, FR(fl, fh, 1), o[d0], 0, 0, 0); \
                             o[d0] = __builtin_amdgcn_mfma_f32_32x32x16_bf16(pa2, FR(fl, fh, 2), o[d0], 0, 0, 0); o[d0] = __builtin_amdgcn_mfma_f32_32x32x16_bf16(pa3, FR(fl, fh, 3), o[d0], 0, 0, 0); } while (0)
#define WL(n) asm volatile("s_waitcnt lgkmcnt(" #n ")" ::: "memory")
#define PVALL(slot_) do { const int vbx = vb0 + (slot_); s16x4 al_[4], ah_[4], bl_[4], bh_[4];                                   \
            LDD(al_, ah_, 0); LDD(bl_, bh_, 1);                                                                                 \
            WL(8); SBAR(); MMD(al_, ah_, 0); SBAR(); LDD(al_, ah_, 2);                                                           \
            WL(8); SBAR(); MMD(bl_, bh_, 1); SBAR(); LDD(bl_, bh_, 3);                                                           \
            WL(8); SBAR(); MMD(al_, ah_, 2); SBAR(); LDD(al_, ah_, 4);                                                           \
            WL(8); SBAR(); MMD(bl_, bh_, 3); SBAR(); LDD(bl_, bh_, 5);                                                           \
            WL(8); SBAR(); MMD(al_, ah_, 4); SBAR(); LDD(al_, ah_, 6);                                                           \
            WL(8); SBAR(); MMD(bl_, bh_, 5); SBAR(); LDD(bl_, bh_, 7);                                                           \
            WL(8); SBAR(); MMD(al_, ah_, 6); SBAR();                                                                             \
            WL(0); SBAR(); MMD(bl_, bh_, 7); SBAR();                                                                             \
            asm volatile("" :: "v"(pa0), "v"(pa1), "v"(pa2), "v"(pa3)); } while (0)
#define APPLY(tt) do { const float* alw = wsA + (((tt) & 1) * 4 + pw) * 32;                                                     \
            const bf16x8* pp = (const bf16x8*)(P_lds + ((tt) & 1) * 16384 + pw * 4096) + lane; pa0 = pp[0]; pa1 = pp[64]; pa2 = pp[128]; pa3 = pp[192]; \
            const float al = alw[r32];                                                                                          \
            if (__any(al < 1.f)) { _Pragma("unroll") for (int d_ = 0; d_ < 8; ++d_) _Pragma("unroll") for (int r = 0; r < 16; ++r) o[d_][r] *= alw[crow(r, hi)]; } \
            asm volatile("s_waitcnt lgkmcnt(0)" ::: "memory"); SBAR();                                                          \
            if (var & 4) { o[0][0] += alw[0]; } else if (A3_OLDPV) { pv_tile<DH, false>(o, vb0 + ((tt) & 1) * SHMV, pa0, pa1, pa2, pa3, true); pv_tile<DH, false>(o + 4, vb0 + ((tt) & 1) * SHMV + 16384, pa0, pa1, pa2, pa3, true); } else { PVALL(((tt) & 1) * SHMV); } } while (0)
        VLOAD(0);
        __syncthreads();
        __syncthreads();
        for (int t = 0; t < NT; ++t) {
            if (t > 0) APPLY(t - 1);
            VMW(); VWRITE((t & 1) * SHMV);
            if (t + 1 < NT && !(var & 1)) VLOAD(t + 1);
            __syncthreads();
        }
        APPLY(NT - 1);
        __syncthreads();
#undef APPLY
#undef PVALL
#undef WL
#undef MMD
#undef FR
#undef LDD
#undef TR2
#undef VLOAD
#undef VWRITE
        const float* li_l = wsA + 256 + pw * 32;
        float rli[16];
#pragma unroll
        for (int r = 0; r < 16; ++r) rli[r] = __builtin_amdgcn_rcpf(li_l[crow(r, hi)]);
        int lo_ = r32, hh_ = hi, ln_ = lane; asm volatile("" : "+v"(lo_), "+v"(hh_), "+v"(ln_));
        float* sw = cur.scr + (size_t)pw * 8192 + ln_;
        if (cur.mode == 3) {
            bf16_t* ob = cur.O + (size_t)(qlo + 4 * hh_) * cur.ldo + lo_;
#pragma unroll
            for (int r = 0; r < 16; ++r) { bf16_t* op = ob + (size_t)((r & 3) + 8 * (r >> 2)) * cur.ldo;
                float v[8], n[8];
#pragma unroll
                for (int d0 = 0; d0 < 8; ++d0) { v[d0] = o[d0][r] * rli[r]; n[d0] = __shfl_xor(v[d0], 1); }
                if ((lo_ & 1) == 0) {
#pragma unroll
                    for (int d0 = 0; d0 < 8; ++d0) *(unsigned*)(op + d0 * 32) = cvtpk(v[d0], n[d0]); } }
        } else if (cur.mode == 0) {
#pragma unroll
            for (int r = 0; r < 16; ++r)
#pragma unroll
                for (int d0 = 0; d0 < 8; ++d0) sw[(r * 8 + d0) * 64] = o[d0][r] * rli[r];
        } else {
            const float lam = cur.lam; bf16_t* ob = cur.O + (size_t)(qlo + 4 * hh_) * cur.ldo + lo_;
#pragma unroll
            for (int r = 0; r < 16; ++r) { bf16_t* op = ob + (size_t)((r & 3) + 8 * (r >> 2)) * cur.ldo;
                float v[8], n[8];
#pragma unroll
                for (int d0 = 0; d0 < 8; ++d0) { v[d0] = sw[(r * 8 + d0) * 64] - lam * (o[d0][r] * rli[r]); n[d0] = __shfl_xor(v[d0], 1); }
                if ((lo_ & 1) == 0) {
#pragma unroll
                    for (int d0 = 0; d0 < 8; ++d0) *(unsigned*)(op + d0 * 32) = cvtpk(v[d0], n[d0]); }
                asm volatile("" ::: "memory"); }
        }
    }
}

struct A3Ctx { const bf16_t* Z; bf16_t* O1; bf16_t* O2; const float* tabs; int vcu; };
__device__ __forceinline__ void a3_ref(const A3Ctx& c, int bi, const bf16_t*& Q, const bf16_t*& K, const bf16_t*& V, bf16_t*& O, int& P0, int& head) {
    const int x = c.vcu >> 5, w = c.vcu & 31, r = bi >> 1, k = bi & 1, bh = x * 16 + 2 * r + (w >> 4), j = w & 15, map = j >> 3, y = j & 7, b = bh >> 3, h = bh & 7;
    const int qb = k == 0 ? y : 15 - y; const bf16_t* Zb = c.Z + (size_t)b * 2048 * LDZ;
    Q = Zb + h * 256 + map * 128; K = Zb + 2048 + h * 256 + map * 128; V = Zb + 4096 + h * 256; O = (map == 0 ? c.O1 : c.O2) + (size_t)b * 2048 * 2048 + h * 256; P0 = qb * 128; head = h;
}
__device__ __forceinline__ void a3_S_loop(const A3Ctx& c, char* lds, const int wave) {
    constexpr int DH = 128, SHMK = 16384;
    char* K_lds = lds + A2_K; char* P_lds = lds + A2_P; float* wsA = (float*)(lds + A2_WS);
    const float* tab = (const float*)(lds + A2_TAB) + (256 - 59);
    const bf16x8 ones = (bf16x8){0x3F80, 0x3F80, 0x3F80, 0x3F80, 0x3F80, 0x3F80, 0x3F80, 0x3F80};
    int head = -1;
    for (int bi = 0; bi < 16; ++bi) {
        const bf16_t* Qp; const bf16_t* Kp; const bf16_t* Vp; bf16_t* Op; int P0, hd; a3_ref(c, bi, Qp, Kp, Vp, Op, P0, hd); (void)Vp; (void)Op;
        const int tid = pg8::fresh_tid(wave), lane = tid & 63, r32 = lane & 31, hi = lane >> 5, pw = wave;
        const int NT = (P0 >> 6) + 2, qlo = P0 + pw * 32, qv = qlo + r32, qm = qv - 4 * hi;
        bf16x8 qr[8]; bf16x8 stk[4]; bf16x8 pa0, pa1, pa2, pa3;
        const int sr = tid >> 4, sc = (tid & 15) * 8;
        unsigned lk = (unsigned)(sr * LDZ + sc); asm volatile("" : "+v"(lk));
        const int kws = kswz<DH>(sr, sc * 2);
        { const bf16_t* qp = Qp + (size_t)qlo * LDZ + (unsigned)(r32 * LDZ + hi * 8);
#pragma unroll
          for (int d0 = 0; d0 < 8; ++d0) qr[d0] = ld8(qp + d0 * 16); }
#define KLOAD(t_) do { const bf16_t* kp_ = Kp + (size_t)((t_) * 64) * LDZ; _Pragma("unroll") for (int i_ = 0; i_ < 4; ++i_) stk[i_] = ld8((kp_ + (size_t)(16 * i_) * LDZ) + lk); } while (0)
#define KWRITE(so) do { _Pragma("unroll") for (int i_ = 0; i_ < 4; ++i_) *(bf16x8*)(K_lds + (so) + kws + i_ * 16 * 256) = stk[i_]; } while (0)
        { bf16x8 stk2[4];
#pragma unroll
          for (int i_ = 0; i_ < 4; ++i_) { stk[i_] = ld8((Kp + (size_t)(16 * i_) * LDZ) + lk); stk2[i_] = ld8((Kp + (size_t)(64 + 16 * i_) * LDZ) + lk); }
          if (hd != head) { head = hd; const float* ts = c.tabs + (size_t)hd * TAB_N; float* td = (float*)(lds + A2_TAB); for (int i_ = tid; i_ < TAB_N; i_ += 256) td[i_] = ts[i_]; }
          VMW(); KWRITE(0);
#pragma unroll
          for (int i_ = 0; i_ < 4; ++i_) *(bf16x8*)(K_lds + SHMK + kws + i_ * 16 * 256) = stk2[i_]; }
        __syncthreads();
        float m_reg = -1e30f; f32x16 pA0, pA1, pB0, pB1; f32x16 lacc = f32x16{};
        qkt_bias128(pA0, pA1, K_lds, r32, hi, qr, tab + qm);
        __syncthreads();
#define SSTEP(PX0, PX1, PN0, PN1, t) do {                                                                                      \
            if ((t) + 2 < NT) KLOAD((t) + 2);                                                                                   \
            SBAR(); if ((t) + 1 < NT) qkt_bias128(PN0, PN1, K_lds + (((t) + 1) & 1) * SHMK, r32, hi, qr, tab + (qm - ((t) + 1) * 64)); \
            float mn_, al_;                                                                                                     \
            { const int kb_ = (t) * 64; if (kb_ + 63 > qlo) mask_tile(PX0, PX1, qm - kb_, 0x40000000u); }                       \
            partialSM<DH>(PX0, PX1, m_reg, mn_, al_);                                                                           \
            if (hi == 0) wsA[(((t) & 1) * 4 + pw) * 32 + r32] = al_;                                                            \
            finishSM_ns(PX0, PX1, pa0, pa1, pa2, pa3);                                                                          \
            if (__any(al_ < 1.f)) { const float* alw_ = wsA + (((t) & 1) * 4 + pw) * 32; asm volatile("s_waitcnt lgkmcnt(0)" ::: "memory"); _Pragma("unroll") for (int r = 0; r < 16; ++r) lacc[r] *= alw_[crow(r, hi)]; } \
            lacc = __builtin_amdgcn_mfma_f32_32x32x16_bf16(pa0, ones, lacc, 0, 0, 0); lacc = __builtin_amdgcn_mfma_f32_32x32x16_bf16(pa1, ones, lacc, 0, 0, 0); \
            lacc = __builtin_amdgcn_mfma_f32_32x32x16_bf16(pa2, ones, lacc, 0, 0, 0); lacc = __builtin_amdgcn_mfma_f32_32x32x16_bf16(pa3, ones, lacc, 0, 0, 0); \
            { bf16x8* pp = (bf16x8*)(P_lds + ((t) & 1) * 16384 + pw * 4096) + lane; pp[0] = pa0; pp[64] = pa1; pp[128] = pa2; pp[192] = pa3; } \
            if ((t) + 2 < NT) { VMW(); KWRITE(((t) & 1) * SHMK); }                                                              \
            __syncthreads(); } while (0)
        for (int t = 0; t < NT; t += 2) {
            SSTEP(pA0, pA1, pB0, pB1, t);
            SSTEP(pB0, pB1, pA0, pA1, t + 1);
        }
        if (r32 == 0) {
#pragma unroll
            for (int r = 0; r < 16; ++r) wsA[256 + pw * 32 + crow(r, hi)] = lacc[r]; }
        __syncthreads();
#undef SSTEP
#undef KLOAD
#undef KWRITE
    }
}
__device__ __forceinline__ void a3_V_loop(const A3Ctx& c, char* lds, const int wave) {
    constexpr int DH = 128, SHMV = 32768;
    char* V_lds = lds + A2_V; char* P_lds = lds + A2_P; float* wsA = (float*)(lds + A2_WS);
    const int pw = wave & 3;
    f32x16 o[8]; float rli[16]; bf16_t* Oprev = nullptr; int qlo_prev = 0;
#pragma unroll
    for (int d_ = 0; d_ < 8; ++d_) o[d_] = f32x16{};
#pragma unroll
    for (int r = 0; r < 16; ++r) rli[r] = 0.f;
#define A3_EPI() do { int lo_ = r32, hh_ = hi; asm volatile("" : "+v"(lo_), "+v"(hh_));                                          \
        bf16_t* ob = Oprev + (size_t)(qlo_prev + 4 * hh_) * 2048 + lo_;                                                        \
        _Pragma("unroll") for (int r = 0; r < 16; ++r) { bf16_t* op = ob + (size_t)((r & 3) + 8 * (r >> 2)) * 2048; float v[8], n[8]; \
            _Pragma("unroll") for (int d0 = 0; d0 < 8; ++d0) { v[d0] = o[d0][r] * rli[r]; n[d0] = __shfl_xor(v[d0], 1); }        \
            if ((lo_ & 1) == 0) { _Pragma("unroll") for (int d0 = 0; d0 < 8; ++d0) *(unsigned*)(op + d0 * 32) = cvtpk(v[d0], n[d0]); } } \
        _Pragma("unroll") for (int d_ = 0; d_ < 8; ++d_) o[d_] = f32x16{}; } while (0)
    for (int bi = 0; bi < 16; ++bi) {
        const bf16_t* Qp; const bf16_t* Kp; const bf16_t* Vp; bf16_t* Op; int P0, hd; a3_ref(c, bi, Qp, Kp, Vp, Op, P0, hd); (void)Qp; (void)Kp; (void)hd;
        const int tid = pg8::fresh_tid(wave), lane = tid & 63, r32 = lane & 31, hi = lane >> 5;
        const int NT = (P0 >> 6) + 2, qlo = P0 + pw * 32;
        bf16x8 stv[8]; bf16x8 pa0, pa1, pa2, pa3;
        const int vb0 = (int)(uintptr_t)V_lds + v_rd_base(lane);
        const int t2 = tid - 256, vr = t2 >> 5, vc = (t2 & 31) * 8;
        unsigned lv = (unsigned)(vr * LDZ + vc); asm volatile("" : "+v"(lv));
        const int vhalf = (vc >> 7) * 16384, vcc = vc & 127;
#define VLOAD(t_) do { const bf16_t* vp_ = Vp + (size_t)((t_) * 64) * LDZ; _Pragma("unroll") for (int i_ = 0; i_ < 8; ++i_) stv[i_] = ld8((vp_ + (size_t)(8 * i_) * LDZ) + lv); } while (0)
#define VWRITE(so) do { _Pragma("unroll") for (int i_ = 0; i_ < 8; ++i_) *(bf16x8*)(V_lds + (so) + vhalf + v_st<DH>(vr + 8 * i_, vcc)) = stv[i_]; } while (0)
#define TR2(dl, dh, off) do { asm volatile("ds_read_b64_tr_b16 %0, %1 offset:%2" : "=&v"(dl) : "v"(vbx), "i"(off) : "memory"); asm volatile("ds_read_b64_tr_b16 %0, %1 offset:%2" : "=&v"(dh) : "v"(vbx), "i"((off) + 2048) : "memory"); } while (0)
#define LDD(fl, fh, d0) do { TR2(fl[0], fh[0], ((d0) >> 2) * 16384 + ((d0) & 3) * 512); TR2(fl[1], fh[1], ((d0) >> 2) * 16384 + ((d0) & 3) * 512 + 4096); \
                             TR2(fl[2], fh[2], ((d0) >> 2) * 16384 + ((d0) & 3) * 512 + 8192); TR2(fl[3], fh[3], ((d0) >> 2) * 16384 + ((d0) & 3) * 512 + 12288); } while (0)
#define FR(fl, fh, j) (bf16x8){fl[j][0], fl[j][1], fl[j][2], fl[j][3], fh[j][0], fh[j][1], fh[j][2], fh[j][3]}
#define MMD(fl, fh, d0) do { o[d0] = __builtin_amdgcn_mfma_f32_32x32x16_bf16(pa0, FR(fl, fh, 0), o[d0], 0, 0, 0); o[d0] = __builtin_amdgcn_mfma_f32_32x32x16_bf16(pa1, FR(fl, fh, 1), o[d0], 0, 0, 0); \
                             o[d0] = __builtin_amdgcn_mfma_f32_32x32x16_bf16(pa2, FR(fl, fh, 2), o[d0], 0, 0, 0); o[d0] = __builtin_amdgcn_mfma_f32_32x32x16_bf16(pa3, FR(fl, fh, 3), o[d0], 0, 0, 0); } while (0)
#define WL(n) asm volatile("s_waitcnt lgkmcnt(" #n ")" ::: "memory")
#define PVALL(slot_) do { const int vbx = vb0 + (slot_); s16x4 al_[4], ah_[4], bl_[4], bh_[4];                                   \
            LDD(al_, ah_, 0); LDD(bl_, bh_, 1);                                                                                 \
            WL(8); SBAR(); MMD(al_, ah_, 0); SBAR(); LDD(al_, ah_, 2);                                                           \
            WL(8); SBAR(); MMD(bl_, bh_, 1); SBAR(); LDD(bl_, bh_, 3);                                                           \
            WL(8); SBAR(); MMD(al_, ah_, 2); SBAR(); LDD(al_, ah_, 4);                                                           \
            WL(8); SBAR(); MMD(bl_, bh_, 3); SBAR(); LDD(bl_, bh_, 5);                                                           \
            WL(8); SBAR(); MMD(al_, ah_, 4); SBAR(); LDD(al_, ah_, 6);                                                           \
            WL(8); SBAR(); MMD(bl_, bh_, 5); SBAR(); LDD(bl_, bh_, 7);                                                           \
            WL(8); SBAR(); MMD(al_, ah_, 6); SBAR();                                                                             \
            WL(0); SBAR(); MMD(bl_, bh_, 7); SBAR();                                                                             \
            asm volatile("" :: "v"(pa0), "v"(pa1), "v"(pa2), "v"(pa3)); } while (0)
#define APPLY(tt) do { const float* alw = wsA + (((tt) & 1) * 4 + pw) * 32;                                                     \
            const bf16x8* pp = (const bf16x8*)(P_lds + ((tt) & 1) * 16384 + pw * 4096) + lane; pa0 = pp[0]; pa1 = pp[64]; pa2 = pp[128]; pa3 = pp[192]; \
            const float al = alw[r32];                                                                                          \
            if (__any(al < 1.f)) { _Pragma("unroll") for (int d_ = 0; d_ < 8; ++d_) _Pragma("unroll") for (int r = 0; r < 16; ++r) o[d_][r] *= alw[crow(r, hi)]; } \
            asm volatile("s_waitcnt lgkmcnt(0)" ::: "memory"); SBAR();                                                          \
            PVALL(((tt) & 1) * SHMV); } while (0)
        VLOAD(0);
        __syncthreads();
        __syncthreads();
        if (bi > 0) A3_EPI();
        for (int t = 0; t < NT; ++t) {
            if (t > 0) APPLY(t - 1);
            VMW(); VWRITE((t & 1) * SHMV);
            if (t + 1 < NT) VLOAD(t + 1);
            __syncthreads();
        }
        APPLY(NT - 1);
        __syncthreads();
        { const float* li_l = wsA + 256 + pw * 32;
#pragma unroll
          for (int r = 0; r < 16; ++r) rli[r] = __builtin_amdgcn_rcpf(li_l[crow(r, hi)]); }
        Oprev = Op; qlo_prev = qlo;
        if (bi == 15) A3_EPI();
#undef APPLY
#undef PVALL
#undef WL
#undef MMD
#undef FR
#undef LDD
#undef TR2
#undef VLOAD
#undef VWRITE
    }
#undef A3_EPI
}
#undef VMW
#undef VMWN
#undef TBASE
#undef LOFF
#undef SLOAD_H
#undef SWRITE_HK
#undef SWRITE_HV
#undef SWRITE_H
#undef STAGE_IDX
#undef SBAR
}
#define GAS __attribute__((address_space(1)))
#define LAS __attribute__((address_space(3)))
typedef unsigned short bf16;
typedef unsigned v4u __attribute__((ext_vector_type(4)));
typedef float f32x4 __attribute__((ext_vector_type(4)));
typedef short bf16x8 __attribute__((ext_vector_type(8)));
typedef GAS unsigned gu32;
typedef GAS unsigned long long gu64;
#define RLX_AGENT __ATOMIC_RELAXED, __HIP_MEMORY_SCOPE_AGENT
#define LDS_WAIT() asm volatile("s_waitcnt lgkmcnt(0)" ::: "memory")
#define VM_WAIT() asm volatile("s_waitcnt vmcnt(0)" ::: "memory")
__device__ __forceinline__ unsigned long long rt() { return __builtin_amdgcn_s_memrealtime(); }
__device__ __forceinline__ unsigned f2bf(float f) { unsigned u = __builtin_bit_cast(unsigned, f); return (u + 0x7fffu + ((u >> 16) & 1u)) >> 16; }
__device__ __forceinline__ unsigned pk2(float lo, float hi) { return f2bf(lo) | (f2bf(hi) << 16); }

#define XB_TMO      128
#define XB_XCNT(j)  (256  + 64 * (j))
#define XB_XSUB(j)  (1280 + 64 * (j))
#define XB_XGEN(j)  (2304 + 64 * (j))
#define XB_TOP      3328
#define XB_TOPGEN   3392
#define XCD_BAR_WORDS 3456
#define XB_SPIN_CAP (1u << 18)

__device__ __forceinline__ unsigned xb_ld(unsigned* p)              { return __hip_atomic_load(p, __ATOMIC_RELAXED, __HIP_MEMORY_SCOPE_AGENT); }
__device__ __forceinline__ unsigned xb_add(unsigned* p, unsigned v) { return __hip_atomic_fetch_add(p, v, __ATOMIC_RELAXED, __HIP_MEMORY_SCOPE_AGENT); }
__device__ __forceinline__ unsigned xb_xcc_id() { return (unsigned)__builtin_amdgcn_s_getreg((3 << 11) | 20) & 0xFu; }
#define XB_SPIN(cond, bar) do { unsigned _sp = 0; while (cond) { __builtin_amdgcn_s_sleep(1); \
    if ((++_sp & 255u) == 0u) { if (xb_ld(&(bar)[XB_TMO])) break; if (_sp > XB_SPIN_CAP) { atomicAdd(&(bar)[XB_TMO], 1u); break; } } } } while (0)

struct XcdBarrier {
    unsigned* bar; unsigned x;
    volatile LAS unsigned* st;
};

__device__ __forceinline__ XcdBarrier xcd_barrier_post(unsigned* bar, volatile LAS unsigned* st) {
    XcdBarrier b; b.bar = bar; b.x = xb_xcc_id(); b.st = st;
    if (threadIdx.x == 0) (void)xb_add(&bar[XB_XCNT(b.x)], 1u);
    return b;
}
__device__ __forceinline__ void xcd_barrier_complete(unsigned* bar, unsigned x, unsigned& nloc, unsigned& nx) {
    const unsigned G = gridDim.x * gridDim.y * gridDim.z;
    unsigned sum, cnt, mine, sp = 0u;
    for (;;) {
        sum = 0u; cnt = 0u; mine = 0u;
#pragma unroll
        for (unsigned j = 0; j < 16; ++j) { const unsigned c = xb_ld(&bar[XB_XCNT(j)]); sum += c; cnt += (c > 0u) ? 1u : 0u; mine = (j == x) ? c : mine; }
        if (sum == G) break;
        __builtin_amdgcn_s_sleep(1);
        if ((++sp & 255u) == 0u) { if (xb_ld(&bar[XB_TMO])) break; if (sp > XB_SPIN_CAP) { atomicAdd(&bar[XB_TMO], 1u); break; } }
    }
    nloc = mine > 0u ? mine : 1u; nx = cnt > 0u ? cnt : 1u;
}

__device__ __forceinline__ void xcd_barrier(const XcdBarrier& b) {
    asm volatile("s_waitcnt vmcnt(0)" ::: "memory");
    __syncthreads();
    if (threadIdx.x == 0) {
        unsigned* bar = b.bar;
        __builtin_amdgcn_s_waitcnt(0);
        unsigned nloc = b.st[0], nx = b.st[1];
        if (nloc == 0u) { xcd_barrier_complete(bar, b.x, nloc, nx); b.st[0] = nloc; b.st[1] = nx; }
        const unsigned old = xb_add(&bar[XB_XSUB(b.x)], 1u);
        const unsigned gen = old / nloc;
        if (old + 1u == (gen + 1u) * nloc) {
            __builtin_amdgcn_fence(__ATOMIC_RELEASE, "agent");
            asm volatile("s_waitcnt vmcnt(0)" ::: "memory");
            const unsigned og = xb_add(&bar[XB_TOP], 1u);
            const unsigned tg = og / nx;
            if (og + 1u == (tg + 1u) * nx) xb_add(&bar[XB_TOPGEN], 1u);
            else XB_SPIN(xb_ld(&bar[XB_TOPGEN]) == tg, bar);
            __builtin_amdgcn_fence(__ATOMIC_ACQUIRE, "agent");
            xb_add(&bar[XB_XGEN(b.x)], 1u);
            asm volatile("s_waitcnt vmcnt(0)" ::: "memory");
        } else {
            XB_SPIN(xb_ld(&bar[XB_XGEN(b.x)]) == gen, bar);
            __builtin_amdgcn_fence(__ATOMIC_ACQUIRE, "agent");
            asm volatile("s_waitcnt vmcnt(0)" ::: "memory");
        }
    }
    __syncthreads();
}


constexpr int NWAVES = 8;
#ifndef MK_N_LAUNCHES
#define MK_N_LAUNCHES 1
#endif
#ifndef ATT_A2
#define ATT_A2 1
#endif
#ifndef P1_NOEPI
#define P1_NOEPI 0
#endif
#ifndef P5F8
#define P5F8 1
#endif
#ifndef P4_SWAP
#define P4_SWAP 0
#endif
#ifndef P1_SWAP
#define P1_SWAP 1
#endif
#ifndef P1_ALIGN
#define P1_ALIGN true
#endif
constexpr int NPH = 13;
constexpr int T = 32768, DM = 2048, SEQ = 2048, NZ = 10752, NCAT = 14848, PLED = 256, NEXP = 32, DE = 1024, MAXROWS = 2 * T + NEXP * 256;
constexpr size_t MiB = 1u << 20;
constexpr size_t WS_CTL = 0, CTL_ZERO_BYTES = 1 * MiB;
constexpr size_t WS_TAB = 1 * MiB, WS_LAM = WS_TAB + 512 * 1024, WS_RINV1 = WS_TAB + 640 * 1024, WS_RINV2 = WS_TAB + 768 * 1024;
constexpr size_t WS_X3 = 378 * MiB;
constexpr size_t WS_H38 = 234 * MiB + 76 * MiB;
constexpr size_t WS_H8 = 538 * MiB + 384 * MiB;
constexpr size_t WS_TOKE = 2 * MiB, WS_TOKW = WS_TOKE + 256 * 1024, WS_ROWT = WS_TOKE + 512 * 1024, WS_ROWW = WS_TOKE + 832 * 1024, WS_TILE = WS_TOKE + 1152 * 1024, WS_TOKP = WS_TOKE + 1280 * 1024, WS_WRT = WS_TOKE + 1536 * 1024;
constexpr size_t WS_WCAT = 4 * MiB, WS_PA = 62 * MiB, WS_PB = 70 * MiB, WS_WOUT = 72 * MiB, WS_WPG = 80 * MiB, WS_WPP = 88 * MiB;
#ifndef P1F8
#define P1F8 1
#endif
constexpr size_t WS_WB8 = P1F8 == 2 ? 4 * MiB : 4 * MiB + 40 * MiB;
constexpr size_t WS_HP8 = 234 * MiB;
constexpr size_t WS_PBF = 90 * MiB;
constexpr size_t WS_R1 = 106 * MiB;
constexpr size_t WS_R2 = 234 * MiB;
constexpr size_t WS_OG = WS_R2, WS_LSE = WS_R2 + 96 * MiB, WS_SCRA = WS_R2 + 100 * MiB, WS_HDN = WS_R2;
constexpr size_t WS_R3 = 378 * MiB;
constexpr size_t WS_OA = WS_R3, WS_OB = WS_R3 + 128 * MiB;
constexpr size_t WS_Z = 538 * MiB;
constexpr size_t WS_WE13 = WS_Z, WS_WE2 = WS_Z + 256 * MiB, WS_SP = WS_Z + 384 * MiB;
constexpr size_t WS_RT = 1210 * MiB;
constexpr size_t WS_END = 1218 * MiB;
constexpr int CW_BAR = 4096, CW_CUR = 16384;
constexpr int RING_OFF = 0, RING_BYTES = 131072, LDSCTL_OFF = RING_BYTES, MISC_OFF = LDSCTL_OFF + 320, LDS_BYTES = 163840;
static_assert(att::ATT_LDS <= RING_BYTES && att::A2_P + 32768 <= LDSCTL_OFF && att::A2_WS >= MISC_OFF + 4096 && att::A2_LDS_END <= LDS_BYTES, "attention LDS");
constexpr int MOE_TS = MISC_OFF + 1024, MOE_CN = MISC_OFF + 1280, MOE_TE = MISC_OFF + 2048;

struct Frame { LAS unsigned char* lds; volatile LAS unsigned* MISC; gu32* ctl; int tid, lane, wave, vcu, G; };

__device__ __forceinline__ float wave_sum(float v) {
#pragma unroll
    for (int o = 1; o < 64; o <<= 1) v += __shfl_xor(v, o);
    return v;
}
__device__ __forceinline__ float dot4(f32x4 a, f32x4 b) { return (a.x * b.x + a.y * b.y) + (a.z * b.z + a.w * b.w); }
__device__ __forceinline__ void rms_row_bf16(const float* xrow, const f32x4 (&g)[8], bf16* orow, float eps, int lane, unsigned char* o8row = nullptr  ) {
    const GAS f32x4* xr = (const GAS f32x4*)xrow + lane;
    f32x4 v[8]; float s = 0.f;
#pragma unroll
    for (int j = 0; j < 8; ++j) { v[j] = xr[64 * j]; s += dot4(v[j], v[j]); }
    const float r = 1.0f / sqrtf(wave_sum(s) * (1.f / 2048.f) + eps);
    GAS unsigned long long* o8 = (GAS unsigned long long*)orow + lane;
#pragma unroll
    for (int j = 0; j < 8; ++j) { const f32x4 y = v[j] * r * g[j]; o8[64 * j] = (unsigned long long)pk2(y.x, y.y) | ((unsigned long long)pk2(y.z, y.w) << 32);
        if (o8row) ((GAS unsigned*)o8row)[lane + 64 * j] = (unsigned)__builtin_amdgcn_cvt_pk_fp8_f32(y.z, y.w, __builtin_amdgcn_cvt_pk_fp8_f32(y.x, y.y, 0, false), true); }
}
__device__ __forceinline__ int t5_bucket(int d) {
    if (d < 16) return d;
    return 16 + (d >= 22) + (d >= 30) + (d >= 40) + (d >= 54) + (d >= 73) + (d >= 99) + (d >= 134) + (d >= 182) + (d >= 246) + (d >= 332) + (d >= 450) + (d >= 609) + (d >= 825) + (d >= 1117) + (d >= 1513);
}

struct Args { const float* in[24]; float* out; unsigned char* ws; int ph_lo, ph_hi; };
enum { I_X = 0, I_P, I_RELB, I_NMIXG, I_WIN, I_WGATE, I_LQ1, I_LK1, I_LQ2, I_LK2, I_SUBLN, I_WPA, I_WPB, I_WOUT, I_NFFNG, I_WCOARSE, I_WFINE, I_W1, I_W3, I_W2, I_NPLEG, I_WPLEG, I_WPLEP, I_FNG };

__device__ __forceinline__ void conv64_f8(const float* W, int ldw, int k0, int n0, unsigned char* WT, int ldt, size_t rbase, int il, int lane) {
    const int ng = lane & 15, kg = lane >> 4;
    const GAS f32x4* src = (const GAS f32x4*)(W + (size_t)(k0 + 16 * kg) * ldw + n0) + ng; const size_t rs = (size_t)(ldw >> 2);
    f32x4 v[16];
#pragma unroll
    for (int kk = 0; kk < 16; ++kk) v[kk] = src[kk * rs] * 32.f;
#pragma unroll
    for (int j = 0; j < 4; ++j) { const int n = n0 + 4 * ng + j; const size_t r = rbase + (il ? (size_t)((n >> 7) * 256 + (n & 127)) : (size_t)n);
        v4u o;
        o.x = (unsigned)__builtin_amdgcn_cvt_pk_fp8_f32(v[2][j], v[3][j], __builtin_amdgcn_cvt_pk_fp8_f32(v[0][j], v[1][j], 0, false), true);
        o.y = (unsigned)__builtin_amdgcn_cvt_pk_fp8_f32(v[6][j], v[7][j], __builtin_amdgcn_cvt_pk_fp8_f32(v[4][j], v[5][j], 0, false), true);
        o.z = (unsigned)__builtin_amdgcn_cvt_pk_fp8_f32(v[10][j], v[11][j], __builtin_amdgcn_cvt_pk_fp8_f32(v[8][j], v[9][j], 0, false), true);
        o.w = (unsigned)__builtin_amdgcn_cvt_pk_fp8_f32(v[14][j], v[15][j], __builtin_amdgcn_cvt_pk_fp8_f32(v[12][j], v[13][j], 0, false), true);
        *(GAS v4u*)(WT + r * ldt + k0 + 16 * kg) = o; }
}
__device__ __forceinline__ void conv64_bf16(const float* W, int ldw, int k0, int n0, bf16* WT, int ldt, size_t rbase, int lane) {
    const int ng = lane & 15, kg = lane >> 4;
    const GAS f32x4* src = (const GAS f32x4*)(W + (size_t)(k0 + 16 * kg) * ldw + n0) + ng; const size_t rs = (size_t)(ldw >> 2);
    f32x4 v[16];
#pragma unroll
    for (int kk = 0; kk < 16; ++kk) v[kk] = src[kk * rs];
#pragma unroll
    for (int j = 0; j < 4; ++j) { const size_t r = rbase + (size_t)(n0 + 4 * ng + j);
        v4u lo, hi; lo.x = pk2(v[0][j], v[1][j]); lo.y = pk2(v[2][j], v[3][j]); lo.z = pk2(v[4][j], v[5][j]); lo.w = pk2(v[6][j], v[7][j]);
        hi.x = pk2(v[8][j], v[9][j]); hi.y = pk2(v[10][j], v[11][j]); hi.z = pk2(v[12][j], v[13][j]); hi.w = pk2(v[14][j], v[15][j]);
        GAS v4u* d = (GAS v4u*)(WT + r * ldt + k0 + 16 * kg); d[0] = lo; d[1] = hi; }
}
__device__ __forceinline__ void conv_item(const Args& a, int id, int lane) {
    unsigned char* ws = a.ws; const int which = id >> 13, e = (id >> 8) & 31, r = id & 255;
    if (which < 2) { const int nb = r & 15, kb = r >> 4; const float* W = (which == 0 ? a.in[I_W1] : a.in[I_W3]) + (size_t)e * DM * DE;
        conv64_f8(W, DE, 128 * kb, 64 * nb, ws + WS_WE13, DM, (size_t)e * 2048 + (which ? 128 : 0), 1, lane); conv64_f8(W, DE, 128 * kb + 64, 64 * nb, ws + WS_WE13, DM, (size_t)e * 2048 + (which ? 128 : 0), 1, lane); }
    else { const int nb = r & 31, kb = r >> 5; const float* W = a.in[I_W2] + (size_t)e * DE * DM;
        conv64_f8(W, DM, 128 * kb, 64 * nb, ws + WS_WE2, DE, (size_t)e * 2048, 0, lane); conv64_f8(W, DM, 128 * kb + 64, 64 * nb, ws + WS_WE2, DE, (size_t)e * 2048, 0, lane); }
}
constexpr int CONV_ITEMS = 3 * 8192;
struct ConvCall { const float* W; unsigned char* WT; int ldw, ldt, k0, n0, il; size_t rbase; };
__device__ __forceinline__ ConvCall conv_call(const Args& a, int id, int half) {
    unsigned char* ws = a.ws; const int which = id >> 13, e = (id >> 8) & 31, r = id & 255; ConvCall c;
    if (which < 2) { const int nb = r & 15, kb = r >> 4; c.W = (which == 0 ? a.in[I_W1] : a.in[I_W3]) + (size_t)e * DM * DE; c.ldw = DE; c.k0 = 128 * kb + 64 * half; c.n0 = 64 * nb; c.WT = ws + WS_WE13; c.ldt = DM; c.rbase = (size_t)e * 2048 + (which ? 128 : 0); c.il = 1; }
    else { const int nb = r & 31, kb = r >> 5; c.W = a.in[I_W2] + (size_t)e * DE * DM; c.ldw = DM; c.k0 = 128 * kb + 64 * half; c.n0 = 64 * nb; c.WT = ws + WS_WE2; c.ldt = DE; c.rbase = (size_t)e * 2048; c.il = 0; }
    return c;
}
__device__ __forceinline__ void conv64_load(f32x4 (&v)[16], const ConvCall& c, int lane) {
    const int ng = lane & 15, kg = lane >> 4;
    const GAS f32x4* src = (const GAS f32x4*)(c.W + (size_t)(c.k0 + 16 * kg) * c.ldw + c.n0) + ng; const size_t rs = (size_t)(c.ldw >> 2);
#pragma unroll
    for (int kk = 0; kk < 16; ++kk) v[kk] = src[kk * rs];
}
__device__ __forceinline__ void conv64_store(const f32x4 (&v)[16], const ConvCall& c, int lane) {
    const int ng = lane & 15, kg = lane >> 4;
#pragma unroll
    for (int j = 0; j < 4; ++j) { const int n = c.n0 + 4 * ng + j; const size_t r = c.rbase + (c.il ? (size_t)((n >> 7) * 256 + (n & 127)) : (size_t)n);
        v4u o;
        o.x = (unsigned)__builtin_amdgcn_cvt_pk_fp8_f32(v[2][j] * 32.f, v[3][j] * 32.f, __builtin_amdgcn_cvt_pk_fp8_f32(v[0][j] * 32.f, v[1][j] * 32.f, 0, false), true);
        o.y = (unsigned)__builtin_amdgcn_cvt_pk_fp8_f32(v[6][j] * 32.f, v[7][j] * 32.f, __builtin_amdgcn_cvt_pk_fp8_f32(v[4][j] * 32.f, v[5][j] * 32.f, 0, false), true);
        o.z = (unsigned)__builtin_amdgcn_cvt_pk_fp8_f32(v[10][j] * 32.f, v[11][j] * 32.f, __builtin_amdgcn_cvt_pk_fp8_f32(v[8][j] * 32.f, v[9][j] * 32.f, 0, false), true);
        o.w = (unsigned)__builtin_amdgcn_cvt_pk_fp8_f32(v[14][j] * 32.f, v[15][j] * 32.f, __builtin_amdgcn_cvt_pk_fp8_f32(v[12][j] * 32.f, v[13][j] * 32.f, 0, false), true);
        *(GAS v4u*)(c.WT + r * c.ldt + c.k0 + 16 * kg) = o; }
}

__device__ __forceinline__ void p0_prologue(Frame& F, const Args& a) {
    unsigned char* ws = a.ws;
    const int gw = F.vcu * NWAVES + F.wave, NGW = F.G * NWAVES;
    static_assert(P1F8 == 1, "the prologue converts the weights for the P1F8 == 1 split");
    constexpr int F_DIL = 72 * 16, F_G = 64 * 16, F_PG = 32 * 16, F_OUT = P5F8 ? 32 * 16 : 0, NF = F_DIL + F_G + F_PG + F_OUT;
    constexpr int B_A = 96 * 32, B_PA = 32 * 32, B_PB = 32 * 8, B_OUT = P5F8 ? 0 : 32 * 32, B_PP = 32 * 4, NB = B_A + B_PA + B_PB + B_OUT + B_PP;
    for (int it = gw; it < NF + NB; it += NGW) {
        int r = it;
        if (r < NF) { const float* W; int ldw, nbn; unsigned char* dst; size_t rbase;
            if (r < F_DIL) { W = a.in[I_WIN] + 6144; ldw = NZ; nbn = 72; dst = ws + WS_WB8; rbase = 0; }
            else if ((r -= F_DIL) < F_G) { W = a.in[I_WGATE]; ldw = 4096; nbn = 64; dst = ws + WS_WB8; rbase = 4608; }
            else if ((r -= F_G) < F_PG) { W = a.in[I_WPLEG]; ldw = DM; nbn = 32; dst = ws + WS_WPG; rbase = 0; }
            else { r -= F_PG; W = a.in[I_WOUT]; ldw = DM; nbn = 32; dst = ws + WS_WOUT; rbase = 0; }
            const int nb = r % nbn, kb = r / nbn;
            conv64_f8(W, ldw, 128 * kb, 64 * nb, dst, DM, rbase, 0, F.lane); conv64_f8(W, ldw, 128 * kb + 64, 64 * nb, dst, DM, rbase, 0, F.lane);
        } else { r -= NF; const float* W; int ldw, nbn, ldt; bf16* dst;
            if (r < B_A) { W = a.in[I_WIN]; ldw = NZ; nbn = 96; dst = (bf16*)(ws + WS_WCAT); ldt = DM; }
            else if ((r -= B_A) < B_PA) { W = a.in[I_WPA]; ldw = DM; nbn = 32; dst = (bf16*)(ws + WS_PA); ldt = DM; }
            else if ((r -= B_PA) < B_PB) { W = a.in[I_WPB]; ldw = DM; nbn = 32; dst = (bf16*)(ws + WS_PB); ldt = 512; }
            else if ((r -= B_PB) < B_OUT) { W = a.in[I_WOUT]; ldw = DM; nbn = 32; dst = (bf16*)(ws + WS_WOUT); ldt = DM; }
            else { r -= B_OUT; W = a.in[I_WPLEP]; ldw = DM; nbn = 32; dst = (bf16*)(ws + WS_WPP); ldt = PLED; }
            const int nb = r % nbn, kb = r / nbn;
            conv64_bf16(W, ldw, 64 * kb, 64 * nb, dst, ldt, 0, F.lane);
        }
    }
    { f32x4 g[8];
#pragma unroll
      for (int j = 0; j < 8; ++j) g[j] = ((const f32x4*)a.in[I_NMIXG])[F.lane + 64 * j];
      auto ld = [&](f32x4 (&v)[8], int m) { const GAS f32x4* xr = (const GAS f32x4*)(a.in[I_X] + (size_t)m * DM) + F.lane;
#pragma unroll
          for (int j = 0; j < 8; ++j) v[j] = xr[64 * j]; };
      auto fin = [&](const f32x4 (&v)[8], int m) { float s = 0.f;
#pragma unroll
          for (int j = 0; j < 8; ++j) s += dot4(v[j], v[j]);
          const float r = 1.0f / sqrtf(wave_sum(s) * (1.f / 2048.f) + 1e-6f);
          GAS unsigned long long* o8 = (GAS unsigned long long*)((bf16*)(ws + WS_R1) + (size_t)m * DM) + F.lane; GAS unsigned* q8 = (GAS unsigned*)(ws + WS_HP8 + (size_t)m * DM) + F.lane;
#pragma unroll
          for (int j = 0; j < 8; ++j) { const f32x4 y = v[j] * r * g[j]; o8[64 * j] = (unsigned long long)pk2(y.x, y.y) | ((unsigned long long)pk2(y.z, y.w) << 32);
              q8[64 * j] = (unsigned)__builtin_amdgcn_cvt_pk_fp8_f32(y.z, y.w, __builtin_amdgcn_cvt_pk_fp8_f32(y.x, y.y, 0, false), true); } };
      f32x4 va[8], vb[8];
      if (gw < T) ld(va, gw);
      for (int m = gw; m < T; m += 2 * NGW) {
          const bool hb = m + NGW < T; if (hb) ld(vb, m + NGW);
          asm volatile("" ::: "memory"); fin(va, m);
          if (m + 2 * NGW < T) ld(va, m + 2 * NGW);
          asm volatile("" ::: "memory"); if (hb) fin(vb, m + NGW);
      } }
    { const f32x4* p4 = (const f32x4*)a.in[I_P]; v4u* o = (v4u*)(ws + WS_PBF); const size_t n8 = (size_t)T * PLED / 8, st = (size_t)NGW * 64;
      for (size_t i0 = (size_t)gw * 64 + F.lane; i0 < n8; i0 += 8 * st) { f32x4 u0[8], u1[8];
#pragma unroll
          for (int j = 0; j < 8; ++j) { const size_t i = i0 + j * st; if (i < n8) { u0[j] = p4[2 * i]; u1[j] = p4[2 * i + 1]; } }
#pragma unroll
          for (int j = 0; j < 8; ++j) { const size_t i = i0 + j * st; if (i < n8) { v4u w; w.x = pk2(u0[j].x, u0[j].y); w.y = pk2(u0[j].z, u0[j].w); w.z = pk2(u1[j].x, u1[j].y); w.w = pk2(u1[j].z, u1[j].w); o[i] = w; } } } }
    { float* tabs = (float*)(ws + WS_TAB); const float* rb = a.in[I_RELB];
      for (int e = (F.vcu * NWAVES * 64) + F.tid; e < 32 * att::TAB_N; e += F.G * NWAVES * 64) {
          const int head = e / att::TAB_N, d = e % att::TAB_N - 256; float v = 0.f;
          if (head < 8) { if (d >= 0 && d < 2048) v = rb[t5_bucket(d) * 32 + head] * 11.313708498984761f; }
          else { const int g = (head - 8) >> 3, dil = g == 0 ? 1 : (g == 1 ? 4 : 16); if (d >= 0 && d <= 128) v = rb[t5_bucket(d * dil) * 32 + head] * 8.0f; }
          tabs[e] = v; } }
    { float* wrt = (float*)(ws + WS_WRT); const float* wc = a.in[I_WCOARSE]; const float* wf = a.in[I_WFINE]; const float* gf = a.in[I_NFFNG];
      for (int e = (F.vcu * NWAVES * 64) + F.tid; e < 48 * DM; e += F.G * NWAVES * 64) { const int i = e & 7, ln = (e >> 3) & 63, cb = e >> 9, b = cb % 3, c = cb / 3, n = ln & 15, kq = ln >> 4, k = 32 * c + 8 * kq + i, col = 16 * b + n;
          const float w = col < 4 ? wc[k * 4 + col] : (col < 36 ? wf[(size_t)((col - 4) >> 3) * DM * 8 + k * 8 + ((col - 4) & 7)] : 0.f);
          wrt[e] = w * gf[k]; } }
    if (F.vcu == 0 && F.wave == 0) {
        const float* q1 = a.in[I_LQ1]; const float* k1 = a.in[I_LK1]; const float* q2 = a.in[I_LQ2]; const float* k2 = a.in[I_LK2];
        const float s1 = wave_sum(q1[F.lane] * k1[F.lane] + q1[F.lane + 64] * k1[F.lane + 64]), s2 = wave_sum(q2[F.lane] * k2[F.lane] + q2[F.lane + 64] * k2[F.lane + 64]);
        if (F.lane == 0) *(float*)(ws + WS_LAM) = expf(s1) - expf(s2) + 0.2f;
    }
}
__device__ __forceinline__ void p3_post_attn(Frame& F, const Args& a) {
    unsigned char* ws = a.ws;
    const int gw = F.vcu * NWAVES + F.wave, NGW = F.G * NWAVES, lane = F.lane;
    const bf16* Cb = (const bf16*)(ws + WS_R1); const bf16* C2 = (const bf16*)(ws + WS_OA); const float lam = *(const float*)(ws + WS_LAM); const bf16* OG = (const bf16*)(ws + WS_OG); const float* LSE = (const float*)(ws + WS_LSE);
    bf16* OA = (bf16*)(ws + WS_OA); bf16* OB = (bf16*)(ws + WS_OB);
    const f32x4 ga = ((const f32x4*)a.in[I_SUBLN])[2 * (lane & 31)], gb = ((const f32x4*)a.in[I_SUBLN])[2 * (lane & 31) + 1];
    struct Row { v4u w[4], w2[4], og[3]; float l0, l1, l2; };
    auto ld = [&](Row& R, int row) { const v4u* cp = (const v4u*)(Cb + (size_t)row * DM); const v4u* cp2 = (const v4u*)(C2 + (size_t)row * DM);
#pragma unroll
        for (int j = 0; j < 4; ++j) { R.w[j] = cp[lane + 64 * j]; R.w2[j] = cp2[lane + 64 * j]; }
        const int hh = lane >> 3; R.l0 = LSE[(size_t)row * 24 + hh]; R.l1 = LSE[(size_t)row * 24 + 8 + hh]; R.l2 = LSE[(size_t)row * 24 + 16 + hh];
        const v4u* gp = (const v4u*)(OG + (size_t)row * 1536); R.og[0] = gp[lane]; R.og[1] = gp[64 + lane]; R.og[2] = gp[128 + lane]; };
    auto fin = [&](const Row& R, int row) { v4u* op = (v4u*)(OA + (size_t)row * DM);
#pragma unroll
        for (int j = 0; j < 4; ++j) { pg8::F8 v = pg8::unpk8(R.w[j]); const pg8::F8 u2 = pg8::unpk8(R.w2[j]); v.a = v.a - u2.a * lam; v.b = v.b - u2.b * lam; float s = dot4(v.a, v.a) + dot4(v.b, v.b);
            s += __shfl_xor(s, 1); s += __shfl_xor(s, 2); s += __shfl_xor(s, 4); s += __shfl_xor(s, 8); s += __shfl_xor(s, 16);
            const float r = 0.8f / sqrtf(s * (1.f / 256.f) + 1e-5f);
            op[lane + 64 * j] = pg8::pk8(v.a * r * ga, v.b * r * gb); }
        const float l0 = R.l0, l1 = R.l1, l2 = R.l2;
        const float mx = fmaxf(l0, fmaxf(l1, l2)); const float e0 = __expf(l0 - mx), e1 = __expf(l1 - mx), e2 = __expf(l2 - mx); const float inv = 1.f / (e0 + e1 + e2);
        const pg8::F8 o0 = pg8::unpk8(R.og[0]), o1 = pg8::unpk8(R.og[1]), o2 = pg8::unpk8(R.og[2]);
        const float a0 = e0 * inv, a1 = e1 * inv, a2 = e2 * inv;
        ((v4u*)(OB + (size_t)row * 512))[lane] = pg8::pk8(o0.a * a0 + o1.a * a1 + o2.a * a2, o0.b * a0 + o1.b * a1 + o2.b * a2); };
    { Row RA, RB;
      if (gw < T) ld(RA, gw);
      for (int row = gw; row < T; row += 2 * NGW) {
          const bool hb = row + NGW < T; if (hb) ld(RB, row + NGW);
          asm volatile("" ::: "memory"); fin(RA, row);
          if (row + 2 * NGW < T) ld(RA, row + 2 * NGW);
          asm volatile("" ::: "memory"); if (hb) fin(RB, row + NGW);
      } }
    { constexpr int NQ = 2 * (CONV_ITEMS / (256 * NWAVES));
      if (NGW == 256 * NWAVES) { f32x4 va[16], vb[16]; ConvCall ca = conv_call(a, gw, 0), cb; conv64_load(va, ca, lane);
          for (int q = 0; q < NQ; q += 2) { cb = conv_call(a, gw + (q >> 1) * NGW, 1); conv64_load(vb, cb, lane); asm volatile("" ::: "memory"); conv64_store(va, ca, lane);
              if (q + 2 < NQ) { ca = conv_call(a, gw + ((q + 2) >> 1) * NGW, 0); conv64_load(va, ca, lane); } asm volatile("" ::: "memory"); conv64_store(vb, cb, lane); } }
      else for (int id = gw; id < CONV_ITEMS; id += NGW) conv_item(a, id, lane); }
}
__device__ __forceinline__ void p6_route(Frame& F, const Args& a, int rep) {
    typedef unsigned u32x2 __attribute__((ext_vector_type(2)));
    unsigned char* ws = a.ws;
    const int gw = F.vcu * NWAVES + F.wave, lane = F.lane, r16 = lane & 15, kq = lane >> 4;
    int* toke = (int*)(ws + WS_TOKE); float* tokw = (float*)(ws + WS_TOKW); int* toki = (int*)(ws + WS_TOKP); int* RT = (int*)(ws + WS_RT); unsigned* cur = (unsigned*)(F.ctl + CW_CUR) + 64 * rep;
    float* r1 = (float*)(ws + WS_RINV1);
    LAS unsigned* lcnt = (LAS unsigned*)(F.lds + RING_OFF); LAS int* lbase = (LAS int*)(F.lds + RING_OFF + 256);
    LAS float* lg = (LAS float*)(F.lds + RING_OFF + 1024 + F.wave * 4096); LAS float* rr = lg + 16 * 48; LAS int* rec = (LAS int*)(rr + 16);
    if (F.tid < 32) lcnt[F.tid] = 0u;
    __syncthreads();
    if (F.G * NWAVES * 16 == T) {
        const int row0 = gw * 16;
        const float* xrow = a.out + (size_t)(row0 + r16) * DM + kq * 8;
        const float* wb = (const float*)(ws + WS_WRT) + lane * 8;
        const float* gk = a.in[I_NFFNG] + kq * 8;
        bf16* hrow = (bf16*)(ws + WS_R1) + (size_t)(row0 + r16) * DM + kq * 8;
        unsigned char* h8row = ws + WS_H8 + (size_t)(row0 + r16) * DM + kq * 8;
        f32x4 D0 = {0.f, 0.f, 0.f, 0.f}, D1 = D0, D2 = D0; float ss = 0.f;
        struct XL { f32x4 a, b; };
        struct WL { f32x4 b0a, b0b, b1a, b1b, b2a, b2b, ga, gb; };
#define XLOAD(L, c_) do { L.a = *(const GAS f32x4*)(xrow + 32 * (c_)); L.b = *(const GAS f32x4*)(xrow + 32 * (c_) + 4); } while (0)
#define WLOAD(L, c_) do { const float* w_ = wb + (size_t)(3 * (c_)) * 512; L.b0a = *(const GAS f32x4*)(w_); L.b0b = *(const GAS f32x4*)(w_ + 4); L.b1a = *(const GAS f32x4*)(w_ + 512); L.b1b = *(const GAS f32x4*)(w_ + 516); \
            L.b2a = *(const GAS f32x4*)(w_ + 1024); L.b2b = *(const GAS f32x4*)(w_ + 1028); L.ga = *(const GAS f32x4*)(gk + 32 * (c_)); L.gb = *(const GAS f32x4*)(gk + 32 * (c_) + 4); } while (0)
#define RCOMP(X, L, c_) do { ss += dot4(X.a, X.a) + dot4(X.b, X.b); const f32x4 ya_ = X.a * L.ga, yb_ = X.b * L.gb; v4u o_; o_.x = pk2(ya_.x, ya_.y); o_.y = pk2(ya_.z, ya_.w); o_.z = pk2(yb_.x, yb_.y); o_.w = pk2(yb_.z, yb_.w); \
            *(GAS v4u*)(hrow + 32 * (c_)) = o_; u32x2 q_; q_.x = (unsigned)__builtin_amdgcn_cvt_pk_fp8_f32(ya_.z, ya_.w, __builtin_amdgcn_cvt_pk_fp8_f32(ya_.x, ya_.y, 0, false), true); \
            q_.y = (unsigned)__builtin_amdgcn_cvt_pk_fp8_f32(yb_.z, yb_.w, __builtin_amdgcn_cvt_pk_fp8_f32(yb_.x, yb_.y, 0, false), true); *(GAS u32x2*)(h8row + 32 * (c_)) = q_; \
            _Pragma("unroll") for (int i = 0; i < 4; ++i) { D0 = __builtin_amdgcn_mfma_f32_16x16x4f32(X.a[i], L.b0a[i], D0, 0, 0, 0); D1 = __builtin_amdgcn_mfma_f32_16x16x4f32(X.a[i], L.b1a[i], D1, 0, 0, 0); D2 = __builtin_amdgcn_mfma_f32_16x16x4f32(X.a[i], L.b2a[i], D2, 0, 0, 0); } \
            _Pragma("unroll") for (int i = 0; i < 4; ++i) { D0 = __builtin_amdgcn_mfma_f32_16x16x4f32(X.b[i], L.b0b[i], D0, 0, 0, 0); D1 = __builtin_amdgcn_mfma_f32_16x16x4f32(X.b[i], L.b1b[i], D1, 0, 0, 0); D2 = __builtin_amdgcn_mfma_f32_16x16x4f32(X.b[i], L.b2b[i], D2, 0, 0, 0); } } while (0)
        XL xq[4];
#pragma unroll
        for (int j = 0; j < 4; ++j) XLOAD(xq[j], j);
        WL WA, WB; WLOAD(WA, 0); WLOAD(WB, 1);
        for (int c = 0; c < 64; c += 4) {
#pragma unroll
            for (int j = 0; j < 4; ++j) {
                WL NC = WB;
                if (c + j + 2 < 64) WLOAD(NC, c + j + 2);
                const XL x0 = xq[j];
                if (c + 4 < 64) XLOAD(xq[j], c + 4 + j);
                asm volatile("" ::: "memory");
                RCOMP(x0, WA, c + j);
                WA = WB; WB = NC;
            }
        }
#undef XLOAD
#undef WLOAD
#undef RCOMP
        ss += __shfl_xor(ss, 16); ss += __shfl_xor(ss, 32);
        const float rsq = sqrtf(ss * (1.f / 2048.f) + 1e-6f), rv = 1.0f / rsq;
        if (kq == 0) { rr[r16] = rv; r1[row0 + r16] = rv; }
        LDS_WAIT(); asm volatile("" ::: "memory");
#pragma unroll
        for (int i = 0; i < 4; ++i) { const int m = 4 * kq + i; const float rm = rr[m]; lg[m * 48 + r16] = D0[i] * rm; lg[m * 48 + 16 + r16] = D1[i] * rm; lg[m * 48 + 32 + r16] = D2[i] * rm; }
        LDS_WAIT(); asm volatile("" ::: "memory");
        if (lane < 16) { const LAS float* L = lg + lane * 48; const int m = row0 + lane;
            const float c0 = L[0], c1 = L[1], c2 = L[2], c3 = L[3];
            float cm = c0; int gs = 0; if (c1 > cm) { cm = c1; gs = 1; } if (c2 > cm) { cm = c2; gs = 2; } if (c3 > cm) { cm = c3; gs = 3; }
            const float pg = 1.0f / (expf(c0 - cm) + expf(c1 - cm) + expf(c2 - cm) + expf(c3 - cm));
            const LAS float* Fp = L + 4 + 8 * gs;
            const float f0 = Fp[0], f1 = Fp[1], f2 = Fp[2], f3 = Fp[3], f4 = Fp[4], f5 = Fp[5], f6 = Fp[6], f7 = Fp[7];
            float v0 = f0; int i0 = 0;
            if (f1 > v0) { v0 = f1; i0 = 1; } if (f2 > v0) { v0 = f2; i0 = 2; } if (f3 > v0) { v0 = f3; i0 = 3; } if (f4 > v0) { v0 = f4; i0 = 4; } if (f5 > v0) { v0 = f5; i0 = 5; } if (f6 > v0) { v0 = f6; i0 = 6; } if (f7 > v0) { v0 = f7; i0 = 7; }
            float v1 = -3.0e38f; int i1 = 0;
            if (i0 != 0 && f0 > v1) { v1 = f0; i1 = 0; } if (i0 != 1 && f1 > v1) { v1 = f1; i1 = 1; } if (i0 != 2 && f2 > v1) { v1 = f2; i1 = 2; } if (i0 != 3 && f3 > v1) { v1 = f3; i1 = 3; }
            if (i0 != 4 && f4 > v1) { v1 = f4; i1 = 4; } if (i0 != 5 && f5 > v1) { v1 = f5; i1 = 5; } if (i0 != 6 && f6 > v1) { v1 = f6; i1 = 6; } if (i0 != 7 && f7 > v1) { v1 = f7; i1 = 7; }
            const float ee = expf(v1 - v0), w0 = pg / (1.f + ee), w1 = pg * ee / (1.f + ee);
            const int e0 = gs * 8 + i0, e1 = gs * 8 + i1; toke[2 * m] = e0; toke[2 * m + 1] = e1; tokw[2 * m] = w0; tokw[2 * m + 1] = w1;
            LAS int* rc = rec + lane * 8; rc[0] = e0; rc[1] = (int)atomicAdd((unsigned*)(lcnt + e0), 1u); rc[2] = e1; rc[3] = (int)atomicAdd((unsigned*)(lcnt + e1), 1u); }
    }
    __syncthreads();
    if (F.tid < 32) lbase[F.tid] = (int)__hip_atomic_fetch_add(cur + F.tid, lcnt[F.tid], RLX_AGENT);
    __syncthreads();
    if (lane < 16 && F.G * NWAVES * 16 == T) { const int m = gw * 16 + lane; const LAS int* rc = rec + lane * 8; const int e0 = rc[0], e1 = rc[2], j0 = lbase[e0] + rc[1], j1 = lbase[e1] + rc[3];
        toki[2 * m] = j0; toki[2 * m + 1] = j1; RT[e0 * 65536 + j0] = m; RT[e1 * 65536 + j1] = m; }
    __syncthreads();
}
__device__ __forceinline__ int moe_tables(Frame& F, int rep) {
    volatile LAS int* TS = (volatile LAS int*)(F.lds + MOE_TS); volatile LAS int* CN = (volatile LAS int*)(F.lds + MOE_CN); volatile LAS int* TE = (volatile LAS int*)(F.lds + MOE_TE);
    __syncthreads();
    if (F.wave == 0) { const unsigned* cur = (const unsigned*)(F.ctl + CW_CUR) + 64 * rep; const int l = pg8::fresh_tid(0);
        const int c = l < NEXP ? (int)__hip_atomic_load(cur + l, RLX_AGENT) : 0, nt = (c + 255) >> 8;
        int incl = nt;
#pragma unroll
        for (int o = 1; o < 32; o <<= 1) { const int t = __shfl_up(incl, o); if (l >= o) incl += t; }
        const int excl = incl - nt;
        if (l < NEXP) { TS[l] = excl; CN[l] = c; for (int t = 0; t < nt; ++t) TE[excl + t] = l; }
        if (l == NEXP - 1) TS[32] = incl; }
    __syncthreads();
    return __builtin_amdgcn_readfirstlane(TS[32]);
}
__device__ __forceinline__ void p10_combine(Frame& F, const Args& a, float sc) {
    typedef unsigned u32x2 __attribute__((ext_vector_type(2)));
    unsigned char* ws = a.ws;
    const int gw = F.vcu * NWAVES + F.wave, NGW = F.G * NWAVES, lane = F.lane;
    f32x4 g[8], gi[8];
#pragma unroll
    for (int j = 0; j < 8; ++j) { g[j] = ((const f32x4*)a.in[I_NPLEG])[lane + 64 * j]; const f32x4 gf = ((const f32x4*)a.in[I_NFFNG])[lane + 64 * j]; gi[j] = (f32x4){1.f / gf.x, 1.f / gf.y, 1.f / gf.z, 1.f / gf.w}; }
    const int* toki = (const int*)(ws + WS_TOKP); const int* toke = (const int*)(ws + WS_TOKE); const float* tokw = (const float*)(ws + WS_TOKW); const bf16* Y = (const bf16*)(ws + WS_SP);
    float* rinv2 = (float*)(ws + WS_RINV2);
    volatile LAS int* TS = (volatile LAS int*)(F.lds + MOE_TS);
    struct Rec { int p0, p1; float w0, w1; };
    auto rec = [&](int m) { Rec r; const int e0 = toke[2 * m], e1 = toke[2 * m + 1], i0 = toki[2 * m], i1 = toki[2 * m + 1]; r.w0 = tokw[2 * m] * sc; r.w1 = tokw[2 * m + 1] * sc; r.p0 = TS[e0] * 256 + i0; r.p1 = TS[e1] * 256 + i1; return r; };
    auto ld = [&](u32x2 (&hx)[8], u32x2 (&a0)[8], u32x2 (&a1)[8], const Rec& r, int m) {
        const GAS u32x2* hr = (const GAS u32x2*)((const bf16*)(ws + WS_R1) + (size_t)m * DM) + lane;
        const GAS u32x2* y0 = (const GAS u32x2*)(Y + (size_t)r.p0 * DM) + lane; const GAS u32x2* y1 = (const GAS u32x2*)(Y + (size_t)r.p1 * DM) + lane;
#pragma unroll
        for (int j = 0; j < 8; ++j) { hx[j] = hr[64 * j]; a0[j] = y0[64 * j]; a1[j] = y1[64 * j]; } };
    auto fin = [&](const u32x2 (&hx)[8], const u32x2 (&a0)[8], const u32x2 (&a1)[8], const Rec& rc, int m) {
        GAS u32x2* hr = (GAS u32x2*)((bf16*)(ws + WS_R1) + (size_t)m * DM) + lane;
        f32x4 v[8]; float s = 0.f;
#pragma unroll
        for (int j = 0; j < 8; ++j) {
            const f32x4 x = (f32x4){pg8::bflo(hx[j].x), pg8::bfhi(hx[j].x), pg8::bflo(hx[j].y), pg8::bfhi(hx[j].y)} * gi[j];
            const f32x4 ya = {pg8::bflo(a0[j].x), pg8::bfhi(a0[j].x), pg8::bflo(a0[j].y), pg8::bfhi(a0[j].y)}, yb = {pg8::bflo(a1[j].x), pg8::bfhi(a1[j].x), pg8::bflo(a1[j].y), pg8::bfhi(a1[j].y)};
            v[j] = x + ya * rc.w0 + yb * rc.w1; s += dot4(v[j], v[j]); }
        const float rsq = sqrtf(wave_sum(s) * (1.f / 2048.f) + 1e-6f), r = 1.0f / rsq;
        if (lane == 0) rinv2[m] = rsq;
        GAS unsigned* h8 = (GAS unsigned*)(ws + WS_H38 + (size_t)m * DM) + lane;
#pragma unroll
        for (int j = 0; j < 8; ++j) { const f32x4 y = v[j] * r * g[j]; u32x2 o; o.x = pk2(y.x, y.y); o.y = pk2(y.z, y.w); hr[64 * j] = o;
            h8[64 * j] = (unsigned)__builtin_amdgcn_cvt_pk_fp8_f32(y.z, y.w, __builtin_amdgcn_cvt_pk_fp8_f32(y.x, y.y, 0, false), true); } };
    u32x2 ha[8], ya0[8], ya1[8], hb[8], yb0[8], yb1[8]; Rec ra{}, rb{}, rn{};
    if (gw < T) { ra = rec(gw); ld(ha, ya0, ya1, ra, gw); if (gw + NGW < T) rb = rec(gw + NGW); }
    for (int m = gw; m < T; m += 2 * NGW) {
        const bool h1 = m + NGW < T, h2 = m + 2 * NGW < T, h3 = m + 3 * NGW < T;
        if (h1) ld(hb, yb0, yb1, rb, m + NGW);
        if (h2) rn = rec(m + 2 * NGW);
        asm volatile("" ::: "memory"); fin(ha, ya0, ya1, ra, m);
        if (h2) { ra = rn; ld(ha, ya0, ya1, ra, m + 2 * NGW); }
        Rec rn2{}; if (h3) rn2 = rec(m + 3 * NGW);
        asm volatile("" ::: "memory"); if (h1) fin(hb, yb0, yb1, rb, m + NGW);
        rb = rn2;
    }
}
__device__ __forceinline__ void p12_final(Frame& F, const Args& a, bool dry) {
    typedef unsigned u32x2 __attribute__((ext_vector_type(2)));
    const int gw = F.vcu * NWAVES + F.wave, NGW = F.G * NWAVES, lane = F.lane;
    f32x4 g[8];
#pragma unroll
    for (int j = 0; j < 8; ++j) g[j] = ((const f32x4*)a.in[I_FNG])[lane + 64 * j];
    auto ld = [&](u32x2 (&w)[8], int m) {
#pragma unroll
        for (int j = 0; j < 8; ++j) w[j] = ((const GAS u32x2*)((const bf16*)(a.ws + WS_X3) + (size_t)m * DM) + lane)[64 * j]; };
    auto fin = [&](const u32x2 (&w)[8], int m) { GAS f32x4* orow = (GAS f32x4*)(a.out + (size_t)m * DM) + lane;
        f32x4 v[8]; float s = 0.f;
#pragma unroll
        for (int j = 0; j < 8; ++j) { v[j] = (f32x4){pg8::bflo(w[j].x), pg8::bfhi(w[j].x), pg8::bflo(w[j].y), pg8::bfhi(w[j].y)}; s += dot4(v[j], v[j]); }
        const float r = 1.0f / sqrtf(wave_sum(s) * (1.f / 2048.f) + 1e-6f);
#pragma unroll
        for (int j = 0; j < 8; ++j) orow[64 * j] = dry ? v[j] : v[j] * r * g[j]; };
    u32x2 wa[8], wb[8];
    if (gw < T) ld(wa, gw);
    for (int m = gw; m < T; m += 2 * NGW) {
        const bool hb = m + NGW < T; if (hb) ld(wb, m + NGW);
        asm volatile("" ::: "memory"); fin(wa, m);
        if (m + 2 * NGW < T) ld(wa, m + 2 * NGW);
        asm volatile("" ::: "memory"); if (hb) fin(wb, m + NGW);
    }
}
__device__ __forceinline__ att::BlockRef ref_a(const Args& a, int vcu, int bi, float lam) {
    const int u = vcu * 4 + (bi >> 2), k = bi & 3, bh = u >> 3, b = bh >> 3, h = bh & 7, sub = u & 7, vh = sub >> 2, y = sub & 3;
    const int qb = (k < 2) ? y : 7 - y, map = k & 1;
    const att::bf16_t* Z = (const att::bf16_t*)(a.ws + WS_Z) + (size_t)b * SEQ * NZ;
    att::BlockRef r;
    r.Q = Z + h * 256 + map * 128; r.K = Z + 2048 + h * 256 + map * 128; r.V = Z + 4096 + h * 256 + vh * 128;
    r.scr = (float*)(a.ws + WS_SCRA) + (size_t)blockIdx.x * 256 * 128;
    r.O = (att::bf16_t*)(a.ws + WS_R1) + (size_t)b * SEQ * DM + h * 256 + vh * 128; r.lse = nullptr;
    r.P0 = qb * 256; r.dil = 1; r.lgL = 11; r.mode = map; r.ldo = DM; r.head = h; r.lam = lam;
    return r;
}
__device__ __forceinline__ att::BlockRef ref_a2(const Args& a, int vcu, int bi, float lam) {
    const int u = (bi >> 2) * 256 + vcu, k = bi & 3, bh = u >> 3, b = bh >> 3, h = bh & 7, y = u & 7;
    const int qb = (k < 2) ? y : 15 - y, map = k & 1;
    const att::bf16_t* Z = (const att::bf16_t*)(a.ws + WS_Z) + (size_t)b * SEQ * NZ;
    att::BlockRef r;
    r.Q = Z + h * 256 + map * 128; r.K = Z + 2048 + h * 256 + map * 128; r.V = Z + 4096 + h * 256;
    r.scr = (float*)(a.ws + WS_SCRA) + (size_t)blockIdx.x * 256 * 128;
    r.O = (att::bf16_t*)(a.ws + WS_R1) + (size_t)b * SEQ * DM + h * 256; r.lse = nullptr;
    r.P0 = qb * 128; r.dil = 1; r.lgL = 11; r.mode = map; r.ldo = DM; r.head = h; r.lam = lam;
    return r;
}
__device__ __forceinline__ att::BlockRef ref_a3(const Args& a, int vcu, int bi) {
    const int x = vcu >> 5, w = vcu & 31, r = bi >> 1, k = bi & 1, bh = x * 16 + 2 * r + (w >> 4), j = w & 15, map = j >> 3, y = j & 7, b = bh >> 3, h = bh & 7;
    const int qb = k == 0 ? y : 15 - y;
    const att::bf16_t* Z = (const att::bf16_t*)(a.ws + WS_Z) + (size_t)b * SEQ * NZ;
    att::BlockRef rr;
    rr.Q = Z + h * 256 + map * 128; rr.K = Z + 2048 + h * 256 + map * 128; rr.V = Z + 4096 + h * 256;
    rr.scr = nullptr; rr.O = (att::bf16_t*)(a.ws + (map == 0 ? WS_R1 : WS_OA)) + (size_t)b * SEQ * DM + h * 256; rr.lse = nullptr;
    rr.P0 = qb * 128; rr.dil = 1; rr.lgL = 11; rr.mode = 3; rr.ldo = DM; rr.head = h; rr.lam = 0.f;
    return rr;
}
__device__ __forceinline__ att::BlockRef ref_b(const Args& a, int vcu, int bi) {
    const int u = vcu * 12 + bi, qb = u & 7, bgh = u >> 3, hh = bgh & 7, bg = bgh >> 3, g = bg % 3, b = bg / 3;
    const att::bf16_t* Z = (const att::bf16_t*)(a.ws + WS_Z) + (size_t)b * SEQ * NZ;
    att::BlockRef r;
    r.Q = Z + 6144 + g * 512 + hh * 64; r.K = Z + 7680 + g * 512 + hh * 64; r.V = Z + 9216 + g * 512 + hh * 64;
    r.scr = nullptr; r.O = (att::bf16_t*)(a.ws + WS_OG) + (size_t)b * SEQ * 1536 + g * 512 + hh * 64; r.lse = (float*)(a.ws + WS_LSE) + (size_t)b * SEQ * 24 + g * 8 + hh;
    r.P0 = qb * 256; r.dil = g == 0 ? 1 : (g == 1 ? 4 : 16); r.lgL = g == 0 ? 11 : (g == 1 ? 9 : 7); r.mode = 2; r.ldo = 1536; r.head = 8 + g * 8 + hh; r.lam = 0.f;
    return r;
}
__device__ __forceinline__ void fill_tab(const Args& a, char* lds, int head, int tid, int tab_off = att::TAB_OFF) {
    const float* src = (const float*)(a.ws + WS_TAB) + (size_t)head * att::TAB_N; float* dst = (float*)(lds + tab_off);
    for (int i = tid; i < att::TAB_N; i += NWAVES * 64) dst[i] = src[i];
}

__global__ void __launch_bounds__(NWAVES * 64, 2) mk_fwd(Args args) {
    extern __shared__ __attribute__((aligned(16))) unsigned char lds[];
    Frame F;
    F.lds = (LAS unsigned char*)lds;
    F.MISC = (volatile LAS unsigned*)(F.lds + MISC_OFF);
    F.tid = threadIdx.x; F.lane = F.tid & 63; F.wave = __builtin_amdgcn_readfirstlane(F.tid >> 6);
    F.G = gridDim.x; { const int bx = blockIdx.x; F.vcu = (F.G % 8 == 0) ? (bx % 8) * (F.G / 8) + bx / 8 : bx; }
    unsigned char* ws = args.ws;
    F.ctl = (gu32*)(ws + WS_CTL);
    for (int u = F.tid; u < (LDS_BYTES - LDSCTL_OFF) / 4; u += NWAVES * 64) ((LAS unsigned*)(F.lds + LDSCTL_OFF))[u] = 0u;
    __syncthreads();
    XcdBarrier bar; bar.bar = (unsigned*)(F.ctl + CW_BAR); bar.x = 0; bar.st = nullptr;
    if (MK_N_LAUNCHES == 1) bar = xcd_barrier_post((unsigned*)(F.ctl + CW_BAR), F.MISC + 8);
    const int lo = args.ph_lo, hi = args.ph_hi;
#ifndef PHMASK
#define PHMASK 0x1fff
#endif
#define IN(k) (((PHMASK >> (k)) & 1) && lo <= (k) && (k) < hi)
#ifndef REPM
#define REPM 0
#endif
#ifndef NREPN
#define NREPN 2
#endif
#define NREP(k) (((REPM >> (k)) & 1) ? NREPN : 1)
#if defined(PROBE_A) || defined(PROBE_T)
#define STAMP(k) do { if (F.wave == 0) { if (pg8::fresh_tid(0) == 0) { const unsigned long long t_ = rt(); F.MISC[32 + 2 * (k)] = (unsigned)t_; F.MISC[33 + 2 * (k)] = (unsigned)(t_ >> 32); } } } while (0)
#define SEAM(k) do { if (IN(k) && IN((k) + 1)) xcd_barrier(bar); STAMP((k) + 1); } while (0)
#else
#define STAMP(k) do {} while (0)
#define SEAM(k) do { if (IN(k) && IN((k) + 1)) xcd_barrier(bar); } while (0)
#endif
    const int G = F.G, bx = (int)blockIdx.x;

    STAMP(0);
#ifdef PROBE_BARX
    for (int i_ = 0; i_ < PROBE_BARX; ++i_) xcd_barrier(bar);
#endif
    _Pragma("unroll") for (int rep = 0; rep < NREP(0); ++rep) if (IN(0)) { F.tid = pg8::fresh_tid(F.wave); F.lane = F.tid & 63; p0_prologue(F, args); SEAM(0); }

    _Pragma("unroll") for (int rep = 0; rep < NREP(1); ++rep) if (IN(1)) {
        constexpr int NB16 = P1F8 == 0 ? 10240 : (P1F8 == 1 ? 6144 : 0), NF8 = NCAT - NB16;
        const int par_ = P1_SWAP ? (bx & 1) : 0;
        _Pragma("nounroll") for (int s_ = 0; s_ < 2; ++s_) {
          if ((s_ ^ par_) == 0) {
            if constexpr (NB16 > 0) { pg8::Gemm g{(const pg8::bf16_t*)(ws + WS_R1), (const pg8::bf16_t*)(ws + WS_WCAT), T, NB16, DM}; pg8::StaticOrder S; S.init(T, NB16, G, bx);
              pg8::EpiZG E{(pg8::bf16_t*)(ws + WS_Z), (pg8::bf16_t*)args.out, 0};
              pg8::gemm_phase<pg8::EpiZG, pg8::StaticOrder, P1_ALIGN, true>(F.lds + RING_OFF, g, S, E, F.wave); }
          } else {
            pg8::Gemm g{(const pg8::bf16_t*)(ws + WS_HP8), (const pg8::bf16_t*)(ws + WS_WB8), T, NF8, DM}; pg8::StaticOrder S; S.init(T, NF8, G, bx);
            pg8::EpiZB E{(pg8::bf16_t*)(ws + WS_Z), (pg8::bf16_t*)args.out, 0};
            pg8::gemm_phase<pg8::EpiZB, pg8::StaticOrder, true, true, false, true>(F.lds + RING_OFF, g, S, E, F.wave);
          }
          __syncthreads();
        }
        SEAM(1);
    }
    _Pragma("unroll") for (int rep = 0; rep < NREP(2); ++rep) if (IN(2)) {
        char* al = (char*)lds + RING_OFF;
        const float lam = *(const float*)(ws + WS_LAM);
        if (G == 256) {
#ifndef NO_ATT_A
#if ATT_A2
#ifndef REPA
#define REPA 1
#endif
            _Pragma("unroll") for (int ra = 0; ra < REPA; ++ra)
            { att::A3Ctx cx{(const att::bf16_t*)(args.ws + WS_Z), (att::bf16_t*)(args.ws + WS_R1), (att::bf16_t*)(args.ws + WS_OA), (const float*)(args.ws + WS_TAB), F.vcu};
              if (F.wave < 4) att::a3_S_loop(cx, al, F.wave); else att::a3_V_loop(cx, al, F.wave);
              __syncthreads(); }
#else
            { const int ta = pg8::fresh_tid(F.wave); att::Seam<128> S; att::BlockRef cur = ref_a(args, F.vcu, 0, lam);
              fill_tab(args, al, cur.head, ta); __syncthreads();
              att::attn_prime<128, false>(cur, al, S, ta);
              for (int bi = 0; bi < 16; ++bi) { const att::BlockRef nxt = (bi + 1 < 16) ? ref_a(args, F.vcu, bi + 1, lam) : cur;
                  att::attn_block<128, false>(cur, nxt, al, S, ta); cur = nxt; } }
#endif
#endif
            __syncthreads();
#ifndef NO_ATT_B
#ifndef REPB
#define REPB 1
#endif
            _Pragma("unroll") for (int rb = 0; rb < REPB; ++rb)
            { const int tb = pg8::fresh_tid(F.wave);
              att::Seam<64> S; att::BlockRef cur = ref_b(args, F.vcu, 0); int head = cur.head;
              fill_tab(args, al, head, tb); __syncthreads();
              att::attn_prime<64, true>(cur, al, S, tb);
              for (int bi = 0; bi < 12; ++bi) { const att::BlockRef nxt = (bi + 1 < 12) ? ref_b(args, F.vcu, bi + 1) : cur;
                  att::attn_block<64, true>(cur, nxt, al, S, tb);
                  if (nxt.head != head) { head = nxt.head; fill_tab(args, al, head, tb); __syncthreads(); }
                  cur = nxt; } }
#endif
        }
        SEAM(2);
    }
    _Pragma("unroll") for (int rep = 0; rep < NREP(3); ++rep) if (IN(3)) { F.tid = pg8::fresh_tid(F.wave); F.lane = F.tid & 63; p3_post_attn(F, args); SEAM(3); }
    _Pragma("unroll") for (int rep = 0; rep < NREP(4); ++rep) if (IN(4)) {
        { pg8::Gemm g{(const pg8::bf16_t*)(ws + WS_OA), (const pg8::bf16_t*)(ws + WS_PA), T, DM, DM}; pg8::StaticOrder S; S.init(T, DM, G, bx);
          pg8::EpiGateA E{(const pg8::bf16_t*)args.out, (pg8::bf16_t*)(ws + WS_SP)};
          pg8::gemm_phase<pg8::EpiGateA, pg8::StaticOrder, true, true>(F.lds + RING_OFF, g, S, E, F.wave); }
        { pg8::Gemm g{(const pg8::bf16_t*)(ws + WS_OB), (const pg8::bf16_t*)(ws + WS_PB), T, DM, 512}; pg8::StaticOrder S; S.init(T, DM, G, bx);
          pg8::EpiMerge E{(const pg8::bf16_t*)args.out, (const pg8::bf16_t*)(ws + WS_SP), (pg8::bf16_t*)(ws + WS_R1), P5F8};
          pg8::gemm_phase<pg8::EpiMerge, pg8::StaticOrder, true, true>(F.lds + RING_OFF, g, S, E, F.wave); }
        SEAM(4);
    }
    _Pragma("unroll") for (int rep = 0; rep < NREP(5); ++rep) if (IN(5)) {
        pg8::Gemm g{(const pg8::bf16_t*)(ws + WS_R1), (const pg8::bf16_t*)(ws + WS_WOUT), T, DM, DM}; pg8::StaticOrder S; S.init(T, DM, G, bx);
        pg8::EpiRes E{args.in[I_X], args.out, P5F8 ? 0.03125f : 1.f};
        pg8::gemm_phase<pg8::EpiRes, pg8::StaticOrder, true, true, false, P5F8 != 0>(F.lds + RING_OFF, g, S, E, F.wave);
        SEAM(5);
    }
    _Pragma("unroll") for (int rep = 0; rep < NREP(6); ++rep) if (IN(6)) { F.tid = pg8::fresh_tid(F.wave); F.lane = F.tid & 63; p6_route(F, args, rep); if (IN(6) && IN(8)) xcd_barrier(bar); STAMP(7); }
    _Pragma("unroll") for (int rep = 0; rep < NREP(8); ++rep) if (IN(8)) {
        F.tid = pg8::fresh_tid(F.wave); const int nt = moe_tables(F, 0);
        pg8::Gemm g{(const pg8::bf16_t*)(ws + WS_H8), (const pg8::bf16_t*)(ws + WS_WE13), nt * 256, 2048, DM};
        pg8::MoeOrder S{(const volatile LAS int*)(F.lds + MOE_TE), (const volatile LAS int*)(F.lds + MOE_TS), (const volatile LAS int*)(F.lds + MOE_CN), nt * 8, G, bx};
        pg8::EpiSwiGLU E{(pg8::bf16_t*)(ws + WS_HDN), (const int*)(ws + WS_RT), (const float*)(ws + WS_RINV1)};
        pg8::gemm_phase<pg8::EpiSwiGLU, pg8::MoeOrder, true, true, true, true>(F.lds + RING_OFF, g, S, E, F.wave, (const int*)(ws + WS_RT));
        SEAM(8);
    }
    _Pragma("unroll") for (int rep = 0; rep < NREP(9); ++rep) if (IN(9)) {
        F.tid = pg8::fresh_tid(F.wave); const int nt = moe_tables(F, 0);
        pg8::Gemm g{(const pg8::bf16_t*)(ws + WS_HDN), (const pg8::bf16_t*)(ws + WS_WE2), nt * 256, 2048, DE};
        pg8::MoeOrder S{(const volatile LAS int*)(F.lds + MOE_TE), (const volatile LAS int*)(F.lds + MOE_TS), (const volatile LAS int*)(F.lds + MOE_CN), nt * 8, G, bx};
        pg8::EpiY E{(pg8::bf16_t*)(ws + WS_SP)};
        pg8::gemm_phase<pg8::EpiY, pg8::MoeOrder, true, true, false, true>(F.lds + RING_OFF, g, S, E, F.wave);
        SEAM(9);
    }
    _Pragma("unroll") for (int rep = 0; rep < NREP(10); ++rep) if (IN(10)) {
        F.tid = pg8::fresh_tid(F.wave); F.lane = F.tid & 63; (void)moe_tables(F, 0); p10_combine(F, args, rep == 0 ? 1.f : 0.f);
        SEAM(10);
    }
    _Pragma("unroll") for (int rep = 0; rep < NREP(11); ++rep) if (IN(11)) {
        { pg8::Gemm g{(const pg8::bf16_t*)(ws + WS_PBF), (const pg8::bf16_t*)(ws + WS_WPP), T, DM, PLED}; pg8::StaticOrder S; S.init(T, DM, G, bx);
          pg8::EpiBf E{(pg8::bf16_t*)(ws + WS_SP)};
          pg8::gemm_phase<pg8::EpiBf, pg8::StaticOrder, true, true>(F.lds + RING_OFF, g, S, E, F.wave); }
        { pg8::Gemm g{(const pg8::bf16_t*)(ws + WS_H38), (const pg8::bf16_t*)(ws + WS_WPG), T, DM, DM}; pg8::StaticOrder S; S.init(T, DM, G, bx);
          pg8::EpiPle E{(const pg8::bf16_t*)(ws + WS_SP), (const pg8::bf16_t*)(ws + WS_R1), (const float*)(ws + WS_RINV2), args.in[I_NPLEG], (pg8::bf16_t*)(ws + WS_X3), rep == 0 ? 1.f : 0.f};
          pg8::gemm_phase<pg8::EpiPle, pg8::StaticOrder, true, true, false, true>(F.lds + RING_OFF, g, S, E, F.wave); }
        SEAM(11);
    }
    _Pragma("unroll") for (int rep = 0; rep < NREP(12); ++rep) if (IN(12)) { F.tid = pg8::fresh_tid(F.wave); F.lane = F.tid & 63; p12_final(F, args, rep + 1 < NREP(12)); if (rep + 1 < NREP(12)) xcd_barrier(bar); }
#ifdef PROBE_T
    STAMP(13); __syncthreads();
    if (blockIdx.x == 0 && F.wave == 0 && pg8::fresh_tid(0) == 0) { auto tsv = [&](int k) { return (unsigned long long)F.MISC[32 + 2 * k] | ((unsigned long long)F.MISC[33 + 2 * k] << 32); };
      const unsigned long long w_ = (tsv(PROBE_U) - tsv(PROBE_T)) * PROBE_TMUL, t0_ = rt(); while (rt() - t0_ < w_) __builtin_amdgcn_s_sleep(8); }
#endif
#ifdef PROBE_A
    xcd_barrier(bar); STAMP(13); __syncthreads();
    { auto tsv = [&](int k) { return (unsigned long long)F.MISC[32 + 2 * k] | ((unsigned long long)F.MISC[33 + 2 * k] << 32); };
      const float da = (float)(tsv(PROBE_A + 1) - tsv(PROBE_A)) * 0.01f, db = (float)(tsv(PROBE_B + 1) - tsv(PROBE_B)) * 0.01f;
      const float c1 = 10.f + da * 0.04f, c2 = 200.f + db;
      for (size_t i = (size_t)blockIdx.x * 512 + threadIdx.x; i < (size_t)T * DM; i += (size_t)gridDim.x * 512) args.out[i] = c1;
      if (blockIdx.x == 0 && threadIdx.x == 0) args.out[0] = c2; }
#endif
#undef IN
#undef SEAM
}

extern "C" void kernel_launch(void* const* d_in, const int* in_sizes, int n_in, void* d_out, int out_size, void* d_ws, size_t ws_size, hipStream_t stream) {
    static int grid = 0;
    if (grid == 0) {
        if (n_in != 24 || out_size != T * DM || ws_size < WS_END) { fprintf(stderr, "kernel_launch: unexpected shapes (n_in %d, out %d, ws %zu)\n", n_in, out_size, ws_size); grid = -1; return; }
        int dev = 0, cus = 0, per_cu = 0;
        if (hipGetDevice(&dev) != hipSuccess || hipDeviceGetAttribute(&cus, hipDeviceAttributeMultiprocessorCount, dev) != hipSuccess) { grid = -1; return; }
        if (hipFuncSetAttribute((const void*)mk_fwd, hipFuncAttributeMaxDynamicSharedMemorySize, LDS_BYTES) != hipSuccess) { fprintf(stderr, "kernel_launch: hipFuncSetAttribute failed\n"); grid = -1; return; }
        if (hipOccupancyMaxActiveBlocksPerMultiprocessor(&per_cu, (const void*)mk_fwd, NWAVES * 64, LDS_BYTES) != hipSuccess || per_cu < 1) fprintf(stderr, "kernel_launch: occupancy query reports %d\n", per_cu);
        (void)hipGetLastError();
        grid = cus;
    }
    if (grid < 0) return;
    if (hipMemsetAsync((char*)d_ws + WS_CTL, 0, CTL_ZERO_BYTES, stream) != hipSuccess) return;
    Args a{};
    for (int i = 0; i < 24; ++i) a.in[i] = (const float*)d_in[i];
    a.out = (float*)d_out; a.ws = (unsigned char*)d_ws;
    if (MK_N_LAUNCHES == 1) { a.ph_lo = 0; a.ph_hi = NPH; hipLaunchKernelGGL(mk_fwd, dim3(grid), dim3(NWAVES * 64), LDS_BYTES, stream, a); }
    else for (int p = 0; p < NPH; ++p) { a.ph_lo = p; a.ph_hi = p + 1; hipLaunchKernelGGL(mk_fwd, dim3(grid), dim3(NWAVES * 64), LDS_BYTES, stream, a); }
}
```
